# Optimizing an MI355X kernel written in HIP

```python
import math
import jax, jax.numpy as jnp
from jax import lax
import numpy as np

D_MODEL = 2048
BATCH = 4
SEQ = 2048
DEPTH = 4

CHUNK = 64
Q_BLOCK = 128
MIX_W = D_MODEL // 2
N_BRANCH = 3
MLA_HEADS = 8
MLA_NOPE = 128
MLA_ROPE = 64
MLA_QK = MLA_NOPE + MLA_ROPE
MLA_V = MIX_W // MLA_HEADS
Q_LORA = D_MODEL // 4
KV_LORA = D_MODEL // 8
ROPE_THETA = 10000.0
FOX_DH = 128
FOX_HEADS = MIX_W // FOX_DH
CH_DH = 128
CH_HEADS = MIX_W // CH_DH
LEFT_CHUNKS = 8
BAND = (LEFT_CHUNKS + 1) * CHUNK
REL_CLIP = 128
N_REL = 2 * REL_CLIP + 1
MEM_LEN = 256
X_HEADS = 4
X_DH = 128
D_FF = 4 * D_MODEL
EPS = 1e-6
NEG = -1e30

SPLIT_SIZES = (Q_LORA, KV_LORA, MLA_ROPE, 3 * FOX_HEADS * FOX_DH, FOX_HEADS,
               3 * CH_HEADS * CH_DH, N_BRANCH * D_MODEL)
D_IN = sum(SPLIT_SIZES)
SPLIT_CUTS = tuple(int(c) for c in np.cumsum(SPLIT_SIZES)[:-1])

kernel_name = 'hybrid_mla_fox_chunkrel_gated_encoder'


def rms_norm(x, g):
    xf = x.astype(jnp.float32)
    y = xf * lax.rsqrt(jnp.mean(xf * xf, axis=-1, keepdims=True) + EPS)
    return (y * g.astype(jnp.float32)).astype(x.dtype)


def rope_tables(seq):
    pos = jnp.arange(seq, dtype=jnp.float32)
    inv = ROPE_THETA ** (-jnp.arange(0, MLA_ROPE, 2, dtype=jnp.float32) / MLA_ROPE)
    ang = pos[:, None] * inv[None, :]
    return jnp.cos(ang), jnp.sin(ang)


def apply_rope(x, cos, sin):
    x1, x2 = jnp.split(x, 2, axis=-1)
    c = cos.astype(x.dtype)[None, :, None, :]
    s = sin.astype(x.dtype)[None, :, None, :]
    return jnp.concatenate([x1 * c - x2 * s, x1 * s + x2 * c], axis=-1)


def block_sweep_attention(q, k, v, cum=None):
    B, S, H, Dk = q.shape
    scale = Dk ** -0.5
    nq = S // Q_BLOCK
    qb = jnp.moveaxis(q.reshape(B, nq, Q_BLOCK, H, Dk), 1, 0)
    k_pos = jnp.arange(S)
    if cum is None:
        xs = (jnp.arange(nq), qb)
    else:
        cb = jnp.moveaxis(cum.reshape(B, nq, Q_BLOCK, H), 1, 0)
        cum_k = jnp.transpose(cum, (0, 2, 1))[:, :, None, :]
        xs = (jnp.arange(nq), qb, cb)

    def body(xs_):
        i, q_i = xs_[0], xs_[1]
        q_pos = i * Q_BLOCK + jnp.arange(Q_BLOCK)
        s = jnp.einsum('bqhd,bkhd->bhqk', q_i, k).astype(jnp.float32) * scale
        if cum is None:
            allowed = (k_pos // CHUNK)[None, :] <= (q_pos // CHUNK)[:, None]
        else:
            allowed = k_pos[None, :] <= q_pos[:, None]
            s = s + jnp.transpose(xs_[2], (0, 2, 1))[..., None] - cum_k
        s = jnp.where(allowed[None, None], s, NEG)
        p = jax.nn.softmax(s, axis=-1).astype(v.dtype)
        return jnp.einsum('bhqk,bkhd->bqhd', p, v)

    out = lax.map(body, xs)
    return jnp.moveaxis(out, 0, 1).reshape(B, S, H, v.shape[-1])


def mla_branch(c_q_raw, c_kv_raw, k_r_raw, g_cq, w_uq, g_ckv, w_ukv, g_qn, g_kn, cos, sin):
    B, S, _ = c_q_raw.shape
    q = (rms_norm(c_q_raw, g_cq) @ w_uq).reshape(B, S, MLA_HEADS, MLA_QK)
    kv = (rms_norm(c_kv_raw, g_ckv) @ w_ukv).reshape(B, S, MLA_HEADS, MLA_NOPE + MLA_V)
    k_nope, v = kv[..., :MLA_NOPE], kv[..., MLA_NOPE:]
    k_rope = jnp.broadcast_to(k_r_raw[:, :, None, :], (B, S, MLA_HEADS, MLA_ROPE))
    k = jnp.concatenate([k_nope, k_rope], axis=-1)
    q = rms_norm(q, g_qn)
    k = rms_norm(k, g_kn)
    q = jnp.concatenate([q[..., :MLA_NOPE], apply_rope(q[..., MLA_NOPE:], cos, sin)], axis=-1)
    k = jnp.concatenate([k[..., :MLA_NOPE], apply_rope(k[..., MLA_NOPE:], cos, sin)], axis=-1)
    o = block_sweep_attention(q, k, v)
    return o.reshape(B, S, MIX_W)


def fox_branch(qkv, f_logit, b_f, g_qn, g_kn):
    B, S, _ = qkv.shape
    qkv = qkv.reshape(B, S, 3, FOX_HEADS, FOX_DH)
    q = rms_norm(qkv[:, :, 0], g_qn)
    k = rms_norm(qkv[:, :, 1], g_kn)
    v = qkv[:, :, 2]
    log_f = jax.nn.log_sigmoid(f_logit.astype(jnp.float32) + b_f.astype(jnp.float32))
    cum = jnp.cumsum(log_f, axis=1)
    o = block_sweep_attention(q, k, v, cum)
    return o.reshape(B, S, MIX_W)


def chunk_band_branch(qkv, rel_bias, g_qn, g_kn):
    B, S, _ = qkv.shape
    n_chunks = S // CHUNK
    pad = LEFT_CHUNKS * CHUNK
    qkv = qkv.reshape(B, S, 3, CH_HEADS, CH_DH)
    q = rms_norm(qkv[:, :, 0], g_qn)
    k = rms_norm(qkv[:, :, 1], g_kn)
    v = qkv[:, :, 2]
    band_idx = (jnp.arange(n_chunks) * CHUNK)[:, None] + jnp.arange(BAND)[None, :]
    kp = jnp.pad(k, ((0, 0), (pad, 0), (0, 0), (0, 0)))
    vp = jnp.pad(v, ((0, 0), (pad, 0), (0, 0), (0, 0)))
    kb = kp[:, band_idx]
    vb = vp[:, band_idx]
    qc = q.reshape(B, n_chunks, CHUNK, CH_HEADS, CH_DH)
    s = jnp.einsum('bcqhd,bckhd->bchqk', qc, kb).astype(jnp.float32) * (CH_DH ** -0.5)
    rel = (jnp.arange(CHUNK)[:, None] + pad) - jnp.arange(BAND)[None, :]
    bias = rel_bias.astype(jnp.float32)[:, jnp.clip(rel, -REL_CLIP, REL_CLIP) + REL_CLIP]
    valid = band_idx >= pad
    s = jnp.where(valid[None, :, None, None, :], s + bias[None, None], NEG)
    p = jax.nn.softmax(s, axis=-1).astype(v.dtype)
    o = jnp.einsum('bchqk,bckhd->bcqhd', p, vb)
    return o.reshape(B, S, MIX_W)


def memory_cross_attention(h, mem_n, w_xq, w_xkv, g_qn, g_kn, w_xo):
    B, S, _ = h.shape
    M = mem_n.shape[1]
    q = rms_norm((h @ w_xq).reshape(B, S, X_HEADS, X_DH), g_qn)
    kv = (mem_n @ w_xkv).reshape(B, M, 2, X_HEADS, X_DH)
    k = rms_norm(kv[:, :, 0], g_kn)
    v = kv[:, :, 1]
    s = jnp.einsum('bshd,bmhd->bhsm', q, k).astype(jnp.float32) * (X_DH ** -0.5)
    p = jax.nn.softmax(s, axis=-1).astype(v.dtype)
    o = jnp.einsum('bhsm,bmhd->bshd', p, v).reshape(B, S, X_HEADS * X_DH)
    return o @ w_xo


def setup_inputs(seed: int = 0) -> dict:
    key = jax.random.key(seed)
    ks = jax.random.split(key, 32)
    f32 = jnp.float32

    def nrm(k, shape, scale):
        return jax.random.normal(k, shape, f32) * scale

    def gain(k, shape):
        return 1.0 + 0.02 * jax.random.normal(k, shape, f32)

    L = DEPTH
    return {
        'x': nrm(ks[0], (BATCH, SEQ, D_MODEL), 1.0),
        'mem': nrm(ks[1], (BATCH, MEM_LEN, D_MODEL), 1.0),
        'g_mix': gain(ks[2], (L, D_MODEL)),
        'w_in': nrm(ks[3], (L, D_MODEL, D_IN), D_MODEL ** -0.5),
        'g_cq': gain(ks[4], (L, Q_LORA)),
        'w_uq': nrm(ks[5], (L, Q_LORA, MLA_HEADS * MLA_QK), Q_LORA ** -0.5),
        'g_ckv': gain(ks[6], (L, KV_LORA)),
        'w_ukv': nrm(ks[7], (L, KV_LORA, MLA_HEADS * (MLA_NOPE + MLA_V)), KV_LORA ** -0.5),
        'g_mla_q': gain(ks[8], (L, MLA_QK)),
        'g_mla_k': gain(ks[9], (L, MLA_QK)),
        'b_f': 3.0 + 0.1 * jax.random.normal(ks[10], (L, FOX_HEADS), f32),
        'g_fox_q': gain(ks[11], (L, FOX_DH)),
        'g_fox_k': gain(ks[12], (L, FOX_DH)),
        'rel_bias': nrm(ks[13], (L, CH_HEADS, N_REL), 0.5),
        'g_ch_q': gain(ks[14], (L, CH_DH)),
        'g_ch_k': gain(ks[15], (L, CH_DH)),
        'w_br': nrm(ks[16], (L, N_BRANCH, MIX_W, D_MODEL), MIX_W ** -0.5),
        'w_out': nrm(ks[17], (L, D_MODEL, D_MODEL), D_MODEL ** -0.5),
        'g_cross': gain(ks[18], (L, D_MODEL)),
        'g_mem': gain(ks[19], (L, D_MODEL)),
        'w_xq': nrm(ks[20], (L, D_MODEL, X_HEADS * X_DH), D_MODEL ** -0.5),
        'w_xkv': nrm(ks[21], (L, D_MODEL, 2 * X_HEADS * X_DH), D_MODEL ** -0.5),
        'g_x_q': gain(ks[22], (L, X_DH)),
        'g_x_k': gain(ks[23], (L, X_DH)),
        'w_xo': nrm(ks[24], (L, X_HEADS * X_DH, D_MODEL), (X_HEADS * X_DH) ** -0.5),
        'g_mlp': gain(ks[25], (L, D_MODEL)),
        'w_1': nrm(ks[26], (L, D_MODEL, D_FF), D_MODEL ** -0.5),
        'w_2': nrm(ks[27], (L, D_FF, D_MODEL), D_FF ** -0.5),
    }


def reference(x, mem, g_mix, w_in, g_cq, w_uq, g_ckv, w_ukv, g_mla_q, g_mla_k, b_f,
              g_fox_q, g_fox_k, rel_bias, g_ch_q, g_ch_k, w_br, w_out, g_cross, g_mem,
              w_xq, w_xkv, g_x_q, g_x_k, w_xo, g_mlp, w_1, w_2):
    B, S, _ = x.shape
    cos, sin = rope_tables(S)
    for l in range(DEPTH):
        h = rms_norm(x, g_mix[l])
        z = h @ w_in[l]
        c_q, c_kv, k_r, fox_qkv, fox_f, ch_qkv, gate_logits = jnp.split(z, SPLIT_CUTS, axis=-1)
        y_a = mla_branch(c_q, c_kv, k_r, g_cq[l], w_uq[l], g_ckv[l], w_ukv[l],
                         g_mla_q[l], g_mla_k[l], cos, sin)
        y_b = fox_branch(fox_qkv, fox_f, b_f[l], g_fox_q[l], g_fox_k[l])
        y_c = chunk_band_branch(ch_qkv, rel_bias[l], g_ch_q[l], g_ch_k[l])
        ys = jnp.stack([y_a, y_b, y_c], axis=2)
        proj = jnp.einsum('bsnc,ncd->bsnd', ys, w_br[l])
        gates = jax.nn.sigmoid(gate_logits.astype(jnp.float32)).astype(x.dtype)
        gates = gates.reshape(B, S, N_BRANCH, D_MODEL)
        merged = jnp.einsum('bsnd,bsnd->bsd', gates, proj)
        x = x + merged @ w_out[l]
        x = x + memory_cross_attention(rms_norm(x, g_cross[l]), rms_norm(mem, g_mem[l]),
                                       w_xq[l], w_xkv[l], g_x_q[l], g_x_k[l], w_xo[l])
        hm = rms_norm(x, g_mlp[l])
        x = x + jnp.square(jax.nn.relu(hm @ w_1[l])) @ w_2[l]
    return x
```

```cpp
#include <hip/hip_runtime.h>
#include <cstdio>
#include <cstdint>

#ifndef MK_PER_PHASE
#define MK_PER_PHASE 1
#endif

namespace pg8 {
#define PG8_LAS __attribute__((address_space(3)))
typedef unsigned short bf16_t;
typedef short bf16x8 __attribute__((ext_vector_type(8)));
typedef float f32x4 __attribute__((ext_vector_type(4)));
typedef unsigned u32x4 __attribute__((ext_vector_type(4)));
constexpr int BM = 256, BK = 64, HALF = 128, HTB = HALF * BK * 2  , STAGE_BYTES = 8 * HTB, NXCD = 8, WGM = 8;

__host__ __device__ __forceinline__ int lds_byte(int r, int c) { const int st = (r >> 4) * 2 + (c >> 5), rr = r & 15, cc = c & 31, ob = rr * 64 + cc * 2; return st * 1024 + (ob ^ (((ob >> 9) & 1) << 5)); }
__host__ __device__ __forceinline__ void stage_rc(int b, int& R, int& C) { const int st = b / 1024, sb = b % 1024, swz = sb ^ (((sb >> 9) & 1) << 5); R = (st >> 1) * 16 + swz / 64; C = (st & 1) * 32 + (swz % 64) / 2; }
__host__ __device__ __forceinline__ int perm32(int rho) { const int n = rho >> 4, i = rho & 15; return 8 * (i >> 2) + 4 * n + (i & 3); }

struct Unit { int pm, pn, z; };
struct Gemm { const bf16_t* A; const bf16_t* Bt; int M, N, K; size_t zA, zB; };

struct StaticOrder {
    int nM, nN, nwg, G, c;
    __host__ __device__ void init(int M, int N, int G_, int c_) { nM = M / BM; nN = N / BM; nwg = nM * nN; G = G_; c = c_; }
    __host__ __device__ bool next(int i, Unit& u) const {
        const long L = (long)i * G + c; if (L >= nwg) return false;
        int wgid = (int)L; { const int q = nwg / NXCD, r = nwg % NXCD, xcd = wgid % NXCD, off = wgid / NXCD; wgid = (xcd < r ? xcd * (q + 1) : r * (q + 1) + (xcd - r) * q) + off; }
        const int nig = WGM * nN, gid = wgid / nig, fm = gid * WGM, gsz = (nM - fm) < WGM ? (nM - fm) : WGM;
        u.pm = fm + ((wgid % nig) % gsz); u.pn = (wgid % nig) / gsz; u.z = 0; return true;
    }
    __device__ __forceinline__ void a_ready(const Unit&) const {}
    __device__ __forceinline__ void done(const Unit&) const {}
};

template <int NZ> struct ZOrder {
    StaticOrder so;
    __host__ __device__ void init(int M, int N, int G_, int c_) { so.init(M, N, G_, c_); }
    __host__ __device__ bool next(int i, Unit& u) const { if (!so.next(i / NZ, u)) return false; u.z = i % NZ; return true; }
    __device__ __forceinline__ void a_ready(const Unit&) const {}
    __device__ __forceinline__ void done(const Unit&) const {}
};

__device__ __forceinline__ unsigned cvt_pk_bf16(float lo, float hi) { unsigned r; asm volatile("v_cvt_pk_bf16_f32 %0, %1, %2" : "=v"(r) : "v"(lo), "v"(hi)); return r; }
typedef float f32x2 __attribute__((ext_vector_type(2)));
template <class Epi, class Sched, bool ALIGN_EPI = false, bool SP2 = false>
__device__ __forceinline__ void gemm_phase(PG8_LAS unsigned char* lds, const Gemm g, const Sched& S, const Epi& E) {
    int tid_ = threadIdx.x; asm volatile("" : "+v"(tid_));
    const int tid = tid_, wid = __builtin_amdgcn_readfirstlane(tid >> 6), lane = tid & 63, wr = wid >> 2, wc = wid & 3, fr = lane & 15, fq = lane >> 4;
    const int K = g.K, nt = K / BK;
    unsigned voffA[2], voffB[2];
#pragma unroll
    for (int i = 0; i < 2; ++i) { int R, C; stage_rc(tid * 16 + i * 8192, R, C); const int Rb = Epi::PERM ? ((R & ~31) + perm32(R & 31)) : R;
        voffA[i] = (unsigned)(R * K + C) * 2u; voffB[i] = (unsigned)(Rb * K + C) * 2u; }
    const size_t kstep = (size_t)(BK * 2);
    const size_t hstep = (size_t)HALF * K * 2;
    const size_t tstep = 2 * hstep;
    const unsigned ldsw = (unsigned)wid * 1024u;
    const int aoff = lds_byte(wr * 64 + fr, fq * 8), boff = lds_byte(wc * 32 + fr, fq * 8);
#define PG8_SA(b, h) (((b) * 2 + (h)) * HTB)
#define PG8_SB(b, h) ((4 + (b) * 2 + (h)) * HTB)
#define PG8_STAGE(bufoff, gbase, voff) do { _Pragma("unroll") for (int _i = 0; _i < 2; ++_i) \
        __builtin_amdgcn_global_load_lds((const unsigned*)((const char*)(gbase) + (voff)[_i]), (PG8_LAS unsigned*)(lds + (bufoff) + ldsw + _i * 8192), 16, 0, 0); } while (0)
#define PG8_LDA(dst, b, h) do { _Pragma("unroll") for (int m = 0; m < 4; ++m) _Pragma("unroll") for (int k = 0; k < 2; ++k) dst[m][k] = *(const PG8_LAS bf16x8*)(lds + PG8_SA(b, h) + aoff + m * 2048 + k * 1024); } while (0)
#define PG8_LDB(dst, b, h) do { _Pragma("unroll") for (int n = 0; n < 2; ++n) _Pragma("unroll") for (int k = 0; k < 2; ++k) dst[n][k] = *(const PG8_LAS bf16x8*)(lds + PG8_SB(b, h) + boff + n * 2048 + k * 1024); } while (0)
#define PG8_MMA(ai, bj, At, Bt) do { __builtin_amdgcn_s_setprio(1); _Pragma("unroll") for (int m = 0; m < 4; ++m) _Pragma("unroll") for (int n = 0; n < 2; ++n) _Pragma("unroll") for (int k = 0; k < 2; ++k) \
        acc[ai][bj][m][n] = __builtin_amdgcn_mfma_f32_16x16x32_bf16(Bt[n][k], At[m][k], acc[ai][bj][m][n], 0, 0, 0); __builtin_amdgcn_s_setprio(0); } while (0)
#define PG8_WAIT_V(n) asm volatile("s_waitcnt vmcnt(" #n ")" ::: "memory")
#define PG8_WAIT_L(n) asm volatile("s_waitcnt lgkmcnt(" #n ")" ::: "memory")
#define PG8_BAR __builtin_amdgcn_s_barrier()
#define PG8_SCHED __builtin_amdgcn_sched_barrier(0)
    Unit cur, nxt; int ui = 0;
    if (!S.next(0, cur)) return;
    f32x4 acc[2][2][4][2];
#pragma unroll
    for (int a = 0; a < 2; ++a)
#pragma unroll
        for (int b = 0; b < 2; ++b)
#pragma unroll
            for (int m = 0; m < 4; ++m)
#pragma unroll
                for (int n = 0; n < 2; ++n) acc[a][b][m][n] = (f32x4){0.f, 0.f, 0.f, 0.f};
    bf16x8 At[4][2], B0[2][2], B1[2][2];
    const char* cA = (const char*)g.A + (size_t)cur.pm * tstep + (size_t)cur.z * g.zA; const char* cB = (const char*)g.Bt + (size_t)cur.pn * tstep + (size_t)cur.z * g.zB;
    S.a_ready(cur);
    if constexpr (SP2) {
        PG8_STAGE(PG8_SB(0, 0), cB, voffB); PG8_STAGE(PG8_SB(0, 1), cB + hstep, voffB); PG8_STAGE(PG8_SA(0, 0), cA, voffA); PG8_STAGE(PG8_SA(0, 1), cA + hstep, voffA);
        if (wr == 1) PG8_BAR;
        PG8_WAIT_V(2); PG8_BAR;
        PG8_STAGE(PG8_SB(1, 0), cB + kstep, voffB); PG8_STAGE(PG8_SA(1, 0), cA + kstep, voffA); PG8_STAGE(PG8_SB(1, 1), cB + hstep + kstep, voffB);
        PG8_WAIT_V(6); PG8_BAR;
    } else {
        PG8_STAGE(PG8_SB(0, 0), cB, voffB); PG8_STAGE(PG8_SA(0, 0), cA, voffA); PG8_STAGE(PG8_SB(0, 1), cB + hstep, voffB); PG8_STAGE(PG8_SA(0, 1), cA + hstep, voffA);
        if (wr == 1) PG8_BAR;
        PG8_WAIT_V(4); PG8_BAR;
        PG8_STAGE(PG8_SB(1, 0), cB + kstep, voffB); PG8_STAGE(PG8_SA(1, 0), cA + kstep, voffA); PG8_STAGE(PG8_SB(1, 1), cB + hstep + kstep, voffB);
        PG8_WAIT_V(6); PG8_BAR;
    }
    for (;;) {
        const bool has_next = S.next(ui + 1, nxt);
        const char* nA = has_next ? (const char*)g.A + (size_t)nxt.pm * tstep + (size_t)nxt.z * g.zA : cA; const char* nB = has_next ? (const char*)g.Bt + (size_t)nxt.pn * tstep + (size_t)nxt.z * g.zB : cB;
#pragma unroll 1
        for (int t = 0; t < nt; t += 2) {
            const bool last = (t == nt - 2);
            const char* a1 = cA + (size_t)(t + 1) * kstep;
            const char* a2 = last ? nA : cA + (size_t)(t + 2) * kstep; const char* b2 = last ? nB : cB + (size_t)(t + 2) * kstep;
            const char* a3 = a2 + kstep; const char* b3 = b2 + kstep;
            if (last && has_next) S.a_ready(nxt);
            if constexpr (SP2) {
            PG8_LDB(B0, 0, 0); PG8_LDB(B1, 0, 1); PG8_SCHED; PG8_LDA(At, 0, 0); PG8_STAGE(PG8_SA(1, 1), a1 + hstep, voffA);
            PG8_WAIT_V(8); PG8_WAIT_L(0); PG8_BAR; PG8_MMA(0, 0, At, B0); PG8_MMA(0, 1, At, B1); PG8_BAR; PG8_SCHED;
            PG8_LDA(At, 0, 1); PG8_STAGE(PG8_SB(0, 0), b2, voffB); PG8_STAGE(PG8_SB(0, 1), b2 + hstep, voffB); PG8_STAGE(PG8_SA(0, 0), a2, voffA);
            PG8_WAIT_V(8); PG8_WAIT_L(0); PG8_BAR; PG8_MMA(1, 0, At, B0); PG8_MMA(1, 1, At, B1); PG8_BAR; PG8_SCHED;
            PG8_LDB(B0, 1, 0); PG8_LDB(B1, 1, 1); PG8_SCHED; PG8_LDA(At, 1, 0); PG8_STAGE(PG8_SA(0, 1), a2 + hstep, voffA);
            PG8_WAIT_V(8); PG8_WAIT_L(0); PG8_BAR; PG8_MMA(0, 0, At, B0); PG8_MMA(0, 1, At, B1); PG8_BAR; PG8_SCHED;
            PG8_LDA(At, 1, 1); PG8_STAGE(PG8_SB(1, 0), b3, voffB); PG8_STAGE(PG8_SB(1, 1), b3 + hstep, voffB); PG8_STAGE(PG8_SA(1, 0), a3, voffA);
            PG8_WAIT_V(8); PG8_WAIT_L(0); PG8_BAR; PG8_MMA(1, 0, At, B0); PG8_MMA(1, 1, At, B1); PG8_BAR; PG8_SCHED;
            } else {
            PG8_LDB(B0, 0, 0); PG8_SCHED; PG8_LDA(At, 0, 0); PG8_STAGE(PG8_SA(1, 1), a1 + hstep, voffA);
            PG8_WAIT_L(8); PG8_BAR; PG8_WAIT_L(0); PG8_MMA(0, 0, At, B0); PG8_BAR; PG8_SCHED;
            PG8_LDB(B1, 0, 1); PG8_STAGE(PG8_SB(0, 0), b2, voffB);
            PG8_BAR; PG8_WAIT_L(0); PG8_MMA(0, 1, At, B1); PG8_BAR;
            PG8_LDA(At, 0, 1); PG8_STAGE(PG8_SA(0, 0), a2, voffA);
            PG8_BAR; PG8_WAIT_L(0); PG8_MMA(1, 0, At, B0); PG8_BAR; PG8_SCHED;
            PG8_STAGE(PG8_SB(0, 1), b2 + hstep, voffB);
            PG8_WAIT_V(6); PG8_BAR; PG8_MMA(1, 1, At, B1); PG8_BAR;
            PG8_LDB(B0, 1, 0); PG8_SCHED; PG8_LDA(At, 1, 0); PG8_STAGE(PG8_SA(0, 1), a2 + hstep, voffA);
            PG8_WAIT_L(8); PG8_BAR; PG8_WAIT_L(0); PG8_MMA(0, 0, At, B0); PG8_BAR; PG8_SCHED;
            PG8_LDB(B1, 1, 1); PG8_STAGE(PG8_SB(1, 0), b3, voffB);
            PG8_BAR; PG8_WAIT_L(0); PG8_MMA(0, 1, At, B1); PG8_BAR;
            PG8_LDA(At, 1, 1); PG8_STAGE(PG8_SA(1, 0), a3, voffA);
            PG8_BAR; PG8_WAIT_L(0); PG8_MMA(1, 0, At, B0); PG8_BAR; PG8_SCHED;
            PG8_STAGE(PG8_SB(1, 1), b3 + hstep, voffB);
            PG8_WAIT_V(6); PG8_BAR; PG8_MMA(1, 1, At, B1); PG8_BAR;
            }
        }
        if constexpr (ALIGN_EPI) { if (wr == 0) PG8_BAR; }
        if constexpr (!Epi::AFTER_DRAIN) { E(acc, cur, wr, wc, fr, fq); S.done(cur); }
        if (!has_next) break;
#pragma unroll
        for (int a = 0; a < 2; ++a)
#pragma unroll
            for (int b = 0; b < 2; ++b)
#pragma unroll
                for (int m = 0; m < 4; ++m)
#pragma unroll
                    for (int n = 0; n < 2; ++n) acc[a][b][m][n] = (f32x4){0.f, 0.f, 0.f, 0.f};
        cur = nxt; cA = nA; cB = nB; ++ui;
        if constexpr (ALIGN_EPI) { if (wr == 1) PG8_BAR; }
    }
    PG8_WAIT_V(0);
    if constexpr (!ALIGN_EPI) { if (wr == 0) PG8_BAR; }
    PG8_BAR;
    if constexpr (Epi::AFTER_DRAIN) { E.fused(acc, cur, wr, wc, fr, fq, lds, wid, lane); S.done(cur); }
#undef PG8_SA
#undef PG8_SB
#undef PG8_STAGE
#undef PG8_LDA
#undef PG8_LDB
#undef PG8_MMA
#undef PG8_WAIT_V
#undef PG8_WAIT_L
#undef PG8_BAR
#undef PG8_SCHED
}
}

constexpr int NBATCH = 4, SEQ = 2048, DM = 2048, T = NBATCH * SEQ, NL = 4, FF = 8192;
constexpr int NIN = 13312;
constexpr int DIN_SRC = 13128;
constexpr float EPS = 1e-6f;
enum { IX = 0, IMEM, IG_MIX, IW_IN, IG_CQ, IW_UQ, IG_CKV, IW_UKV, IG_MLAQ, IG_MLAK, IB_F, IG_FOXQ, IG_FOXK, IRELB, IG_CHQ, IG_CHK, IW_BR, IW_OUT,
       IG_CROSS, IG_MEM, IW_XQ, IW_XKV, IG_XQ, IG_XK, IW_XO, IG_MLP, IW_1, IW_2, N_IN };

constexpr size_t MiB = 1u << 20;
constexpr size_t WS_CTL = 0, CTL_ZERO_BYTES = 1 * MiB;
constexpr size_t WS_COS = 1 * MiB, WS_SIN = WS_COS + 256 * 1024, WS_RSTDMEM = WS_SIN + 256 * 1024, WS_GT = WS_RSTDMEM + 4096;
constexpr size_t WS_W = 2 * MiB;
constexpr size_t WO_IN = 0, WO_UQ = WO_IN + (size_t)NIN * 2048 * 2, WO_UKV = WO_UQ + (size_t)2048 * 512 * 2, WO_BR = WO_UKV + (size_t)2048 * 256 * 2,
                 WO_OUT = WO_BR + (size_t)3 * 2048 * 1024 * 2, WO_XQ = WO_OUT + (size_t)2048 * 2048 * 2, WO_XKV = WO_XQ + (size_t)512 * 2048 * 2,
                 WO_XO = WO_XKV + (size_t)1024 * 2048 * 2, WO_1 = WO_XO + (size_t)2048 * 512 * 2, WO_2 = WO_1 + (size_t)8192 * 2048 * 2,
                 W_LAYER = WO_2 + (size_t)2048 * 8192 * 2;
static_assert(W_LAYER == 147 * MiB, "weight map");
constexpr size_t WS_ACT = WS_W + NL * W_LAYER;
constexpr size_t WS_XB = WS_ACT, WS_CQ = WS_XB + 32 * MiB, WS_CKV = WS_CQ + 8 * MiB, WS_KR = WS_CKV + 4 * MiB, WS_SMALL = WS_KR + 2 * MiB;
constexpr size_t WS_SSQX = WS_SMALL, WS_SSQCQ = WS_SSQX + 256 * 1024, WS_SSQCKV = WS_SSQCQ + 64 * 1024, WS_SSQKR = WS_SSQCKV + 32 * 1024,
                 WS_LOGF = WS_SSQKR + 32 * 1024, WS_CUM = WS_LOGF + 256 * 1024;
constexpr size_t WS_FQ = WS_SMALL + 2 * MiB, WS_FK = WS_FQ + 16 * MiB, WS_FV = WS_FK + 16 * MiB, WS_CHQ = WS_FV + 16 * MiB, WS_CHK = WS_CHQ + 16 * MiB, WS_CHV = WS_CHK + 16 * MiB;
constexpr size_t WS_GATES = WS_CHV + 16 * MiB, WS_MQ = WS_GATES + 96 * MiB, WS_MK = WS_MQ + 24 * MiB, WS_MV = WS_MK + 24 * MiB, WS_Y = WS_MV + 16 * MiB;
constexpr size_t WS_MERGED = WS_Y + 48 * MiB, WS_XQ = WS_MERGED + 32 * MiB, WS_MEMB = WS_XQ + 8 * MiB, WS_XK = WS_MEMB + 4 * MiB, WS_XV = WS_XK + 1 * MiB, WS_OX = WS_XV + 1 * MiB;
constexpr size_t WS_H = WS_OX + 8 * MiB, WS_END = WS_H + 128 * MiB;
static_assert(WS_CUM + 256 * 1024 <= WS_FQ, "small map");

constexpr int RING_BYTES = 131072;
constexpr int ESCR_OFF = RING_BYTES, ESCR_BYTES = 16384;
constexpr int MISC_OFF = ESCR_OFF + ESCR_BYTES;
constexpr int LDS_BYTES = MISC_OFF + 1024;

#define GAS __attribute__((address_space(1)))
#define LAS __attribute__((address_space(3)))
typedef unsigned short bf16;
typedef unsigned u32x4 __attribute__((ext_vector_type(4)));
typedef unsigned u32x2 __attribute__((ext_vector_type(2)));
typedef float f32x4 __attribute__((ext_vector_type(4)));
typedef float f32x2 __attribute__((ext_vector_type(2)));
typedef GAS unsigned gu32;
#define RLX_AGENT __ATOMIC_RELAXED, __HIP_MEMORY_SCOPE_AGENT
#define LDS_WAIT() asm volatile("s_waitcnt lgkmcnt(0)" ::: "memory")
#define VM_WAIT() asm volatile("s_waitcnt vmcnt(0)" ::: "memory")
using pg8::cvt_pk_bf16;
__device__ __forceinline__ float bf_lo(unsigned w) { return __uint_as_float(w << 16); }
__device__ __forceinline__ float bf_hi(unsigned w) { return __uint_as_float(w & 0xffff0000u); }
__device__ __forceinline__ float bf2f(bf16 h) { return __uint_as_float((unsigned)h << 16); }
__device__ __forceinline__ u32x4 pack8(f32x4 a, f32x4 b) { u32x4 w; w.x = cvt_pk_bf16(a[0], a[1]); w.y = cvt_pk_bf16(a[2], a[3]); w.z = cvt_pk_bf16(b[0], b[1]); w.w = cvt_pk_bf16(b[2], b[3]); return w; }
__device__ __forceinline__ void unpack8(u32x4 w, f32x4& a, f32x4& b) { a[0] = bf_lo(w.x); a[1] = bf_hi(w.x); a[2] = bf_lo(w.y); a[3] = bf_hi(w.y); b[0] = bf_lo(w.z); b[1] = bf_hi(w.z); b[2] = bf_lo(w.w); b[3] = bf_hi(w.w); }
__device__ __forceinline__ float sumsq4(f32x4 v) { return (v[0] * v[0] + v[1] * v[1]) + (v[2] * v[2] + v[3] * v[3]); }
__device__ __forceinline__ float rsq(float x) { return __builtin_amdgcn_rsqf(x); }
__device__ __forceinline__ float sigmoidf_(float x) { return __builtin_amdgcn_rcpf(1.0f + __expf(-x)); }
__device__ __forceinline__ float log_sigmoidf_(float x) { return fminf(x, 0.f) - log1pf(expf(-fabsf(x))); }

typedef f32x4 Acc[2][2][4][2];
using pg8::Unit;
#define EPI_BAR() do { asm volatile("s_waitcnt lgkmcnt(0)" ::: "memory"); __builtin_amdgcn_s_barrier(); asm volatile("" ::: "memory"); } while (0)
template <int NB> __device__ __forceinline__ void xwave_rowsum(float (&s)[2][4][NB], LAS float* P, int wr, int wc, int fr, int fq) {
    unsigned pw = (unsigned)(uintptr_t)P + (unsigned)(((wr * 64 + fr) * NB * 4 + wc) * 4), pr = (unsigned)(uintptr_t)P + (unsigned)((wr * 64 + fr) * NB * 16);
    asm volatile("" : "+v"(pw), "+v"(pr));
#pragma unroll
    for (int ai = 0; ai < 2; ++ai)
#pragma unroll
        for (int m = 0; m < 4; ++m)
#pragma unroll
            for (int b = 0; b < NB; ++b) { float v = s[ai][m][b]; v += __shfl_xor(v, 16); v += __shfl_xor(v, 32);
                if (fq == 0) *(LAS float*)(pw + (unsigned)(((ai * 128 + m * 16) * NB + b) * 16)) = v; }
    EPI_BAR();
#pragma unroll
    for (int ai = 0; ai < 2; ++ai)
#pragma unroll
        for (int m = 0; m < 4; ++m)
#pragma unroll
            for (int b = 0; b < NB; ++b) { const f32x4 t = *(const LAS f32x4*)(pr + (unsigned)(((ai * 128 + m * 16) * NB + b) * 16)); s[ai][m][b] = (t[0] + t[1]) + (t[2] + t[3]); }
}
__device__ __forceinline__ void fresh_lane(int& fr, int& fq) { int l; asm volatile("v_mbcnt_lo_u32_b32 %0, -1, 0\n\tv_mbcnt_hi_u32_b32 %0, -1, %0" : "=v"(l)); fr = l & 15; fq = l >> 4; }
template <class V> __device__ __forceinline__ V ldg(const void* base, unsigned boff) { return *(const V*)((const char*)base + boff); }
template <class V> __device__ __forceinline__ void stg(void* base, unsigned boff, V v) { *(V*)((char*)base + boff) = v; }
__device__ __forceinline__ float sum8(f32x4 a, f32x4 b) { return ((a[0] + a[1]) + (a[2] + a[3])) + ((b[0] + b[1]) + (b[2] + b[3])); }
__device__ __forceinline__ float rstd8(const float* base, unsigned row) { return rsq(sum8(ldg<f32x4>(base, row * 32u), ldg<f32x4>(base, row * 32u + 16u)) * (1.0f / DM) + EPS); }
#define ROWG(ai, m) ((unsigned)(row0 + (ai) * 128 + (m) * 16))
#define EPI_AM _Pragma("unroll") for (int ai = 0; ai < 2; ++ai) _Pragma("unroll") for (int m = 0; m < 4; ++m) if ((__builtin_amdgcn_sched_barrier(0), true))
#define EPI_BJ _Pragma("unroll") for (int bj = 0; bj < 2; ++bj)

struct EpiInProj {
    static constexpr bool PERM = true, AFTER_DRAIN = false;
    const float* ssqx; bf16* cq; float* ssqcq; bf16* ckv; float* ssqckv; float* kr; float* ssqkr; float* logf; const float* b_f;
    bf16* hm;
    const float* gt;
    bf16* gates; LAS float* scr;
    __device__ __forceinline__ void operator()(Acc& acc, const Unit& u, int wr, int wc, int fr, int fq) const {
        fresh_lane(fr, fq);
        int row0 = u.pm * 256 + wr * 64 + fr, c8 = wc * 32 + fq * 8;
        asm volatile("" : "+v"(row0), "+v"(c8), "+v"(fq));
        const int pn = u.pn;
        EPI_AM { const float rs = rstd8(ssqx, ROWG(ai, m));
            EPI_BJ { acc[ai][bj][m][0] *= rs; acc[ai][bj][m][1] *= rs; } }
        if (pn >= 28) {
            EPI_AM { const unsigned row = ROWG(ai, m);
                EPI_BJ { f32x4 a = acc[ai][bj][m][0], b = acc[ai][bj][m][1];
#pragma unroll
                    for (int e = 0; e < 4; ++e) { a[e] = sigmoidf_(a[e]); b[e] = sigmoidf_(b[e]); }
                    stg<u32x4>(gates, row * 12288u + ((pn - 28) * 256 + bj * 128 + c8) * 2u, pack8(a, b)); } }
            return;
        }
        float s[2][4][2];
        const bool kr_tile = pn == 3;
        EPI_AM { const float s0 = sumsq4(acc[ai][0][m][0]) + sumsq4(acc[ai][0][m][1]), s1 = sumsq4(acc[ai][1][m][0]) + sumsq4(acc[ai][1][m][1]);
            s[ai][m][0] = (kr_tile && wc >= 2) ? 0.f : s0; s[ai][m][1] = kr_tile ? 0.f : s1; }
        xwave_rowsum<2>(s, scr, wr, wc, fr, fq);
        if (pn < 3) {
            EPI_AM { const unsigned row = ROWG(ai, m); const float tot = s[ai][m][0] + s[ai][m][1];
                if (wc == 0 && fq == 0) { if (pn < 2) stg<float>(ssqcq, row * 8u + pn * 4u, tot); else stg<float>(ssqckv, row * 4u, tot); }
                EPI_BJ { const u32x4 w = pack8(acc[ai][bj][m][0], acc[ai][bj][m][1]);
                    if (pn < 2) stg<u32x4>(cq, row * 1024u + (pn * 256 + bj * 128 + c8) * 2u, w); else stg<u32x4>(ckv, row * 512u + (bj * 128 + c8) * 2u, w); } }
        } else if (pn == 3) {
            EPI_AM { const unsigned row = ROWG(ai, m);
                if (wc == 0 && fq == 0) stg<float>(ssqkr, row * 4u, s[ai][m][0]);
                if (wc < 2) { stg<f32x4>(kr, row * 256u + c8 * 4u, acc[ai][0][m][0]); stg<f32x4>(kr, row * 256u + c8 * 4u + 16u, acc[ai][0][m][1]); }
                if (wc == 2 && fq == 0) { f32x4 a = acc[ai][0][m][0], b = acc[ai][0][m][1]; const f32x4 b0 = *(const f32x4*)b_f, b1 = *(const f32x4*)(b_f + 4);
#pragma unroll
                    for (int e = 0; e < 4; ++e) { a[e] = log_sigmoidf_(a[e] + b0[e]); b[e] = log_sigmoidf_(b[e] + b1[e]); }
                    stg<f32x4>(logf, row * 32u, a); stg<f32x4>(logf, row * 32u + 16u, b); } }
        } else {
            const int t = pn - 4, seg = t >> 2, hp = t & 3; const bool isv = seg == 2 || seg == 5;
            const f32x4 g0 = ldg<f32x4>(gt, (seg * 128 + c8) * 4u), g1 = ldg<f32x4>(gt, (seg * 128 + c8) * 4u + 16u);
            bf16* dst = hm + (size_t)seg * (8u << 20);
            EPI_AM { const unsigned row = ROWG(ai, m), b = row >> 11, sp = row & 2047u;
                EPI_BJ { const float rh = isv ? 1.0f : rsq(s[ai][m][bj] * (1.0f / 128.0f) + EPS); const unsigned head = hp * 2 + bj;
                    stg<u32x4>(dst, (((b * 8u + head) * SEQ + sp) * 128u + c8) * 2u, pack8(acc[ai][bj][m][0] * rh * g0, acc[ai][bj][m][1] * rh * g1)); } }
        }
    }
};

struct EpiQUp {
    static constexpr bool PERM = true, AFTER_DRAIN = false;
    const float* ssqcq; const float* gq; const float* cosT; const float* sinT; bf16* mq; LAS float* scr;
    __device__ __forceinline__ void operator()(Acc& acc, const Unit& u, int wr, int wc, int fr, int fq) const {
        fresh_lane(fr, fq);
        int row0 = u.pm * 256 + wr * 64 + fr, c8 = wc * 32 + fq * 8;
        asm volatile("" : "+v"(row0), "+v"(c8), "+v"(fq));
        const unsigned head = u.pn;
        float s[2][4][1];
        EPI_AM { const f32x2 p = ldg<f32x2>(ssqcq, ROWG(ai, m) * 8u); const float rs = rsq((p[0] + p[1]) * (1.0f / 512.0f) + EPS);
            EPI_BJ { acc[ai][bj][m][0] *= rs; acc[ai][bj][m][1] *= rs; }
            s[ai][m][0] = (sumsq4(acc[ai][0][m][0]) + sumsq4(acc[ai][0][m][1])) + (sumsq4(acc[ai][1][m][0]) + sumsq4(acc[ai][1][m][1])); }
        xwave_rowsum<1>(s, scr, wr, wc, fr, fq);
        const f32x4 g0 = ldg<f32x4>(gq, c8 * 4u), g1 = ldg<f32x4>(gq, c8 * 4u + 16u);
        const unsigned gi = 4 * (wc & 1) + fq;
        const f32x4 gr1 = ldg<f32x4>(gq, (128 + 4 * gi) * 4u), gr2 = ldg<f32x4>(gq, (160 + 4 * gi) * 4u);
        EPI_AM { const unsigned row = ROWG(ai, m), b = row >> 11, sp = row & 2047u; const float rq = rsq(s[ai][m][0] * (1.0f / 192.0f) + EPS);
            const unsigned d = ((b * 8u + head) * SEQ + sp) * 384u;
            stg<u32x4>(mq, d + c8 * 2u, pack8(acc[ai][0][m][0] * rq * g0, acc[ai][0][m][1] * rq * g1));
            if (wc < 2) { const f32x4 x1 = acc[ai][1][m][0] * rq * gr1, x2 = acc[ai][1][m][1] * rq * gr2;
                const f32x4 c = ldg<f32x4>(cosT, (sp * 32u + 4 * gi) * 4u), sn = ldg<f32x4>(sinT, (sp * 32u + 4 * gi) * 4u);
                stg<u32x4>(mq, d + (128 + 8 * gi) * 2u, pack8(x1 * c - x2 * sn, x1 * sn + x2 * c)); } }
    }
};

struct EpiKvUp {
    static constexpr bool PERM = true, AFTER_DRAIN = false;
    const float* ssqckv; const float* ssqkr; const float* kr; const float* gk; const float* cosT; const float* sinT; bf16* mk; bf16* mv; LAS float* scr;
    __device__ __forceinline__ void operator()(Acc& acc, const Unit& u, int wr, int wc, int fr, int fq) const {
        fresh_lane(fr, fq);
        int row0 = u.pm * 256 + wr * 64 + fr, c8 = wc * 32 + fq * 8;
        asm volatile("" : "+v"(row0), "+v"(c8), "+v"(fq));
        const unsigned head = u.pn;
        float s[2][4][1];
        EPI_AM { const float rs = rsq(ldg<float>(ssqckv, ROWG(ai, m) * 4u) * (1.0f / 256.0f) + EPS);
            EPI_BJ { acc[ai][bj][m][0] *= rs; acc[ai][bj][m][1] *= rs; }
            s[ai][m][0] = sumsq4(acc[ai][0][m][0]) + sumsq4(acc[ai][0][m][1]); }
        xwave_rowsum<1>(s, scr, wr, wc, fr, fq);
        const f32x4 g0 = ldg<f32x4>(gk, c8 * 4u), g1 = ldg<f32x4>(gk, c8 * 4u + 16u);
        const unsigned qi = 4 * wc + fq, i0 = 2 * qi;
        const f32x2 gr1 = ldg<f32x2>(gk, (128 + i0) * 4u), gr2 = ldg<f32x2>(gk, (160 + i0) * 4u);
        const unsigned slot = 128 + 8 * (qi >> 1) + 2 * (qi & 1);
        EPI_AM { const unsigned row = ROWG(ai, m), b = row >> 11, sp = row & 2047u; const float rk = rsq((s[ai][m][0] + ldg<float>(ssqkr, row * 4u)) * (1.0f / 192.0f) + EPS);
            const unsigned tok = (b * 8u + head) * SEQ + sp, dk = tok * 384u;
            stg<u32x4>(mk, dk + c8 * 2u, pack8(acc[ai][0][m][0] * rk * g0, acc[ai][0][m][1] * rk * g1));
            stg<u32x4>(mv, tok * 256u + c8 * 2u, pack8(acc[ai][1][m][0], acc[ai][1][m][1]));
            const f32x2 x1 = ldg<f32x2>(kr, row * 256u + i0 * 4u) * rk * gr1, x2 = ldg<f32x2>(kr, row * 256u + (32 + i0) * 4u) * rk * gr2;
            const f32x2 c = ldg<f32x2>(cosT, (sp * 32u + i0) * 4u), sn = ldg<f32x2>(sinT, (sp * 32u + i0) * 4u);
            const f32x2 o1 = x1 * c - x2 * sn, o2 = x1 * sn + x2 * c;
            stg<unsigned>(mk, dk + slot * 2u, cvt_pk_bf16(o1[0], o1[1])); stg<unsigned>(mk, dk + (slot + 4) * 2u, cvt_pk_bf16(o2[0], o2[1])); }
    }
};

struct EpiBr {
    static constexpr bool PERM = true, AFTER_DRAIN = false;
    const bf16* gates; bf16* merged;
    __device__ __forceinline__ void operator()(Acc& acc, const Unit& u, int wr, int wc, int fr, int fq) const {
        fresh_lane(fr, fq);
        int row0 = u.pm * 256 + wr * 64 + fr, c8 = wc * 32 + fq * 8;
        asm volatile("" : "+v"(row0), "+v"(c8));
        const unsigned z = u.z;
        EPI_AM { const unsigned row = ROWG(ai, m);
            EPI_BJ { const unsigned col = u.pn * 256 + bj * 128 + c8;
                f32x4 ga, gb; unpack8(ldg<u32x4>(gates, row * 12288u + (z * 2048u + col) * 2u), ga, gb);
                f32x4 a = acc[ai][bj][m][0] * ga, b = acc[ai][bj][m][1] * gb;
                const unsigned d = row * 4096u + col * 2u;
                if (z > 0) { f32x4 pa, pb; unpack8(ldg<u32x4>(merged, d), pa, pb); a += pa; b += pb; }
                stg<u32x4>(merged, d, pack8(a, b)); } }
    }
};

struct EpiResid {
    static constexpr bool PERM = false, AFTER_DRAIN = false;
    const float* xin; float* xout; bf16* xb; float* ssqx; LAS float* scr;
    __device__ __forceinline__ void operator()(Acc& acc, const Unit& u, int wr, int wc, int fr, int fq) const {
        fresh_lane(fr, fq);
        int row0 = u.pm * 256 + wr * 64 + fr, c4 = wc * 32 + fq * 4;
        asm volatile("" : "+v"(row0), "+v"(c4), "+v"(fq));
        float s[2][4][1];
        EPI_AM { const unsigned row = ROWG(ai, m); float q = 0.f;
            EPI_BJ {
#pragma unroll
                for (int n = 0; n < 2; ++n) { const unsigned e = row * 2048u + u.pn * 256 + bj * 128 + n * 16 + c4;
                    const f32x4 v = ldg<f32x4>(xin, e * 4u) + acc[ai][bj][m][n];
                    stg<f32x4>(xout, e * 4u, v); q += sumsq4(v);
                    u32x2 w; w.x = cvt_pk_bf16(v[0], v[1]); w.y = cvt_pk_bf16(v[2], v[3]); stg<u32x2>(xb, e * 2u, w); } }
            s[ai][m][0] = q; }
        xwave_rowsum<1>(s, scr, wr, wc, fr, fq);
        if (wc == 0 && fq == 0) { EPI_AM { stg<float>(ssqx, ROWG(ai, m) * 32u + u.pn * 4u, s[ai][m][0]); } }
    }
};

struct EpiHeadNorm {
    static constexpr bool PERM = true, AFTER_DRAIN = false;
    const float* ssq8;
    const float* rstd1;
    const float* gg; bf16* dk; bf16* dv; int nk_tiles, rows_per_b, lg_rows_per_b; LAS float* scr;
    __device__ __forceinline__ void operator()(Acc& acc, const Unit& u, int wr, int wc, int fr, int fq) const {
        fresh_lane(fr, fq);
        int row0 = u.pm * 256 + wr * 64 + fr, c8 = wc * 32 + fq * 8;
        asm volatile("" : "+v"(row0), "+v"(c8), "+v"(fq));
        const int pn = u.pn;
        EPI_AM { const unsigned row = ROWG(ai, m); const float rs = ssq8 ? rstd8(ssq8, row) : ldg<float>(rstd1, row * 4u);
            EPI_BJ { acc[ai][bj][m][0] *= rs; acc[ai][bj][m][1] *= rs; } }
        const bool isk = pn < nk_tiles;
        if (isk) {
            float s[2][4][2];
            EPI_AM { EPI_BJ { s[ai][m][bj] = sumsq4(acc[ai][bj][m][0]) + sumsq4(acc[ai][bj][m][1]); } }
            xwave_rowsum<2>(s, scr, wr, wc, fr, fq);
            const f32x4 g0 = ldg<f32x4>(gg, c8 * 4u), g1 = ldg<f32x4>(gg, c8 * 4u + 16u);
            EPI_AM { EPI_BJ { const float rh = rsq(s[ai][m][bj] * (1.0f / 128.0f) + EPS); acc[ai][bj][m][0] = acc[ai][bj][m][0] * rh * g0; acc[ai][bj][m][1] = acc[ai][bj][m][1] * rh * g1; } }
        }
        bf16* dst = isk ? dk : dv; const unsigned hp = isk ? pn : pn - nk_tiles;
        EPI_AM { const unsigned row = ROWG(ai, m), b = row >> lg_rows_per_b, sp = row & (unsigned)(rows_per_b - 1);
            EPI_BJ { const unsigned head = hp * 2 + bj; stg<u32x4>(dst, (((b * 4u + head) * rows_per_b + sp) * 128u + c8) * 2u, pack8(acc[ai][bj][m][0], acc[ai][bj][m][1])); } }
    }
};

struct EpiMlp1 {
    static constexpr bool PERM = true, AFTER_DRAIN = false;
    const float* ssqx; bf16* h;
    __device__ __forceinline__ void operator()(Acc& acc, const Unit& u, int wr, int wc, int fr, int fq) const {
        fresh_lane(fr, fq);
        int row0 = u.pm * 256 + wr * 64 + fr, c8 = wc * 32 + fq * 8;
        asm volatile("" : "+v"(row0), "+v"(c8));
        EPI_AM { const unsigned row = ROWG(ai, m); const float rs = rstd8(ssqx, row);
            EPI_BJ { f32x4 a = acc[ai][bj][m][0] * rs, b = acc[ai][bj][m][1] * rs;
#pragma unroll
                for (int e = 0; e < 4; ++e) { a[e] = fmaxf(a[e], 0.f); a[e] *= a[e]; b[e] = fmaxf(b[e], 0.f); b[e] *= b[e]; }
                stg<u32x4>(h, row * 16384u + (u.pn * 256 + bj * 128 + c8) * 2u, pack8(a, b)); } }
    }
};

#define XB_TMO      128
#define XB_XCNT(j)  (256  + 64 * (j))
#define XB_XSUB(j)  (1280 + 64 * (j))
#define XB_XGEN(j)  (2304 + 64 * (j))
#define XB_TOP      3328
#define XB_TOPGEN   3392
#define XCD_BAR_WORDS 3456
#define XB_SPIN_CAP (1u << 18)
__device__ __forceinline__ unsigned xb_ld(unsigned* p)              { return __hip_atomic_load(p, __ATOMIC_RELAXED, __HIP_MEMORY_SCOPE_AGENT); }
__device__ __forceinline__ unsigned xb_add(unsigned* p, unsigned v) { return __hip_atomic_fetch_add(p, v, __ATOMIC_RELAXED, __HIP_MEMORY_SCOPE_AGENT); }
__device__ __forceinline__ unsigned xb_xcc_id() { return (unsigned)__builtin_amdgcn_s_getreg((3 << 11) | 20) & 0xFu; }
#define XB_SPIN(cond, bar) do { unsigned _sp = 0; while (cond) { __builtin_amdgcn_s_sleep(1); \
    if ((++_sp & 255u) == 0u) { if (xb_ld(&(bar)[XB_TMO])) break; if (_sp > XB_SPIN_CAP) { atomicAdd(&(bar)[XB_TMO], 1u); break; } } } } while (0)
struct XcdBarrier { unsigned* bar; unsigned x; volatile LAS unsigned* st; };
__device__ __forceinline__ XcdBarrier xcd_barrier_post(unsigned* bar, volatile LAS unsigned* st) {
    XcdBarrier b; b.bar = bar; b.x = xb_xcc_id(); b.st = st;
    if (threadIdx.x == 0) (void)xb_add(&bar[XB_XCNT(b.x)], 1u);
    return b;
}
__device__ __forceinline__ void xcd_barrier_complete(unsigned* bar, unsigned x, unsigned& nloc, unsigned& nx) {
    const unsigned G = gridDim.x * gridDim.y * gridDim.z;
    unsigned sum, cnt, mine, sp = 0u;
    for (;;) {
        sum = 0u; cnt = 0u; mine = 0u;
#pragma unroll
        for (unsigned j = 0; j < 16; ++j) { const unsigned c = xb_ld(&bar[XB_XCNT(j)]); sum += c; cnt += (c > 0u) ? 1u : 0u; mine = (j == x) ? c : mine; }
        if (sum == G) break;
        __builtin_amdgcn_s_sleep(1);
        if ((++sp & 255u) == 0u) { if (xb_ld(&bar[XB_TMO])) break; if (sp > XB_SPIN_CAP) { atomicAdd(&bar[XB_TMO], 1u); break; } }
    }
    nloc = mine > 0u ? mine : 1u; nx = cnt > 0u ? cnt : 1u;
}
__device__ __forceinline__ void xcd_barrier(const XcdBarrier& b) {
    asm volatile("s_waitcnt vmcnt(0)" ::: "memory");
    __syncthreads();
    if (threadIdx.x == 0) {
        unsigned* bar = b.bar;
        __builtin_amdgcn_s_waitcnt(0);
        unsigned nloc = b.st[0], nx = b.st[1];
        if (nloc == 0u) { xcd_barrier_complete(bar, b.x, nloc, nx); b.st[0] = nloc; b.st[1] = nx; }
        const unsigned old = xb_add(&bar[XB_XSUB(b.x)], 1u);
        const unsigned gen = old / nloc;
        if (old + 1u == (gen + 1u) * nloc) {
            __builtin_amdgcn_fence(__ATOMIC_RELEASE, "agent");
            asm volatile("s_waitcnt vmcnt(0)" ::: "memory");
            const unsigned og = xb_add(&bar[XB_TOP], 1u);
            const unsigned tg = og / nx;
            if (og + 1u == (tg + 1u) * nx) xb_add(&bar[XB_TOPGEN], 1u);
            else XB_SPIN(xb_ld(&bar[XB_TOPGEN]) == tg, bar);
            __builtin_amdgcn_fence(__ATOMIC_ACQUIRE, "agent");
            xb_add(&bar[XB_XGEN(b.x)], 1u);
            asm volatile("s_waitcnt vmcnt(0)" ::: "memory");
        } else {
            XB_SPIN(xb_ld(&bar[XB_XGEN(b.x)]) == gen, bar);
            __builtin_amdgcn_fence(__ATOMIC_ACQUIRE, "agent");
            asm volatile("s_waitcnt vmcnt(0)" ::: "memory");
        }
    }
    __syncthreads();
}

constexpr int NWAVES = 8;
__device__ __forceinline__ float wave_sum(float v) {
#pragma unroll
    for (int o = 1; o < 64; o <<= 1) v += __shfl_xor(v, o);
    return v;
}
__device__ __forceinline__ int colmap_inproj(int n) { if (n < 832) return n; if (n < 840) return 3904 + (n - 832); if (n < 1024) return -1; if (n < 4096) return n - 192; return n - 184; }
__device__ __forceinline__ int colmap_uq(int n) { const int h = n >> 8, j = n & 255; if (j < 128) return h * 192 + j; if (j >= 192) return -1;
    const int p = j - 128, g = p >> 3, w = p & 7; return h * 192 + 128 + (w < 4 ? 4 * g + w : 32 + 4 * g + (w - 4)); }
template <int MAP> __device__ __forceinline__ void transpose_item(const float* W, int K, int Nsrc, const float* gk, bf16* WT, int nblk, LAS float* scr, int item, int lane) {
    const int kb = item / nblk, nb = item % nblk, k0 = 64 * kb, n0 = 32 * nb;
    const int nd = n0 + (lane & 31); const int ns = MAP == 0 ? nd : MAP == 1 ? colmap_inproj(nd) : colmap_uq(nd);
#pragma unroll 8
    for (int i = 0; i < 32; ++i) { const int kk = 2 * i + (lane >> 5); float v = 0.f; if (ns >= 0) { v = W[(size_t)(k0 + kk) * Nsrc + ns]; if (gk) v *= gk[k0 + kk]; } scr[kk * 33 + (lane & 31)] = v; }
    LDS_WAIT(); asm volatile("" ::: "memory");
    const int c = lane & 7;
#pragma unroll
    for (int j = 0; j < 4; ++j) { const int n = (lane >> 3) + 8 * j; const LAS float* s = scr + (8 * c) * 33 + n;
        u32x4 o; o.x = cvt_pk_bf16(s[0 * 33], s[1 * 33]); o.y = cvt_pk_bf16(s[2 * 33], s[3 * 33]); o.z = cvt_pk_bf16(s[4 * 33], s[5 * 33]); o.w = cvt_pk_bf16(s[6 * 33], s[7 * 33]);
        *(u32x4*)(WT + (size_t)(n0 + n) * K + k0 + 8 * c) = o; }
    LDS_WAIT(); asm volatile("" ::: "memory");
}
__device__ __forceinline__ float row_to_bf16(const float* xrow, bf16* orow, int lane) {
    f32x4 v[8]; float s = 0.f;
#pragma unroll
    for (int j = 0; j < 8; ++j) { v[j] = ((const f32x4*)xrow)[lane + 64 * j]; s += sumsq4(v[j]); }
#pragma unroll
    for (int j = 0; j < 8; ++j) { u32x2 w; w.x = cvt_pk_bf16(v[j][0], v[j][1]); w.y = cvt_pk_bf16(v[j][2], v[j][3]); ((u32x2*)orow)[lane + 64 * j] = w; }
    return wave_sum(s);
}

struct Args { const float* in[N_IN]; float* out; unsigned char* ws; int g_lo, g_hi; };
constexpr size_t in_stride(int k) {
    return k == IG_MIX ? 2048 : k == IW_IN ? (size_t)2048 * DIN_SRC : k == IG_CQ ? 512 : k == IW_UQ ? (size_t)512 * 1536 : k == IG_CKV ? 256 : k == IW_UKV ? (size_t)256 * 2048 :
           k == IG_MLAQ ? 192 : k == IG_MLAK ? 192 : k == IB_F ? 8 : k == IG_FOXQ ? 128 : k == IG_FOXK ? 128 : k == IRELB ? 8 * 257 : k == IG_CHQ ? 128 : k == IG_CHK ? 128 :
           k == IW_BR ? (size_t)3 * 1024 * 2048 : k == IW_OUT ? (size_t)2048 * 2048 : k == IG_CROSS ? 2048 : k == IG_MEM ? 2048 : k == IW_XQ ? (size_t)2048 * 512 :
           k == IW_XKV ? (size_t)2048 * 1024 : k == IG_XQ ? 128 : k == IG_XK ? 128 : k == IW_XO ? (size_t)512 * 2048 : k == IG_MLP ? 2048 : k == IW_1 ? (size_t)2048 * 8192 :
           k == IW_2 ? (size_t)8192 * 2048 : 0;
}
#define LIN(k, l) (args.in[k] + (size_t)(l) * in_stride(k))

__device__ __forceinline__ void prologue(const Args& args, LAS unsigned char* lds, int lane, int wave) {
    unsigned char* ws = args.ws;
    LAS float* scr = (LAS float*)(lds + wave * 16384);
    const int gw = blockIdx.x * NWAVES + wave, NGW = gridDim.x * NWAVES;
    constexpr int I_IN = (2048 / 64) * (NIN / 32), I_UQ = (512 / 64) * (2048 / 32), I_UKV = (256 / 64) * (2048 / 32), I_BR1 = (1024 / 64) * (2048 / 32), I_OUT = (2048 / 64) * (2048 / 32),
                  I_XQ = (2048 / 64) * (512 / 32), I_XKV = (2048 / 64) * (1024 / 32), I_XO = (512 / 64) * (2048 / 32), I_1 = (2048 / 64) * (8192 / 32), I_2 = (8192 / 64) * (2048 / 32);
    constexpr int I_LAYER = I_IN + I_UQ + I_UKV + 3 * I_BR1 + I_OUT + I_XQ + I_XKV + I_XO + I_1 + I_2;
    for (int it = gw; it < NL * I_LAYER; it += NGW) {
        const int l = it / I_LAYER; int r = it % I_LAYER;
        unsigned char* wl = ws + WS_W + (size_t)l * W_LAYER;
        if (r < I_IN) { transpose_item<1>(LIN(IW_IN, l), 2048, DIN_SRC, LIN(IG_MIX, l), (bf16*)(wl + WO_IN), NIN / 32, scr, r, lane); continue; } r -= I_IN;
        if (r < I_UQ) { transpose_item<2>(LIN(IW_UQ, l), 512, 1536, LIN(IG_CQ, l), (bf16*)(wl + WO_UQ), 2048 / 32, scr, r, lane); continue; } r -= I_UQ;
        if (r < I_UKV) { transpose_item<0>(LIN(IW_UKV, l), 256, 2048, LIN(IG_CKV, l), (bf16*)(wl + WO_UKV), 2048 / 32, scr, r, lane); continue; } r -= I_UKV;
        if (r < 3 * I_BR1) { const int z = r / I_BR1; transpose_item<0>(LIN(IW_BR, l) + (size_t)z * 1024 * 2048, 1024, 2048, nullptr, (bf16*)(wl + WO_BR) + (size_t)z * 2048 * 1024, 2048 / 32, scr, r % I_BR1, lane); continue; } r -= 3 * I_BR1;
        if (r < I_OUT) { transpose_item<0>(LIN(IW_OUT, l), 2048, 2048, nullptr, (bf16*)(wl + WO_OUT), 2048 / 32, scr, r, lane); continue; } r -= I_OUT;
        if (r < I_XQ) { transpose_item<0>(LIN(IW_XQ, l), 2048, 512, LIN(IG_CROSS, l), (bf16*)(wl + WO_XQ), 512 / 32, scr, r, lane); continue; } r -= I_XQ;
        if (r < I_XKV) { transpose_item<0>(LIN(IW_XKV, l), 2048, 1024, LIN(IG_MEM, l), (bf16*)(wl + WO_XKV), 1024 / 32, scr, r, lane); continue; } r -= I_XKV;
        if (r < I_XO) { transpose_item<0>(LIN(IW_XO, l), 512, 2048, nullptr, (bf16*)(wl + WO_XO), 2048 / 32, scr, r, lane); continue; } r -= I_XO;
        if (r < I_1) { transpose_item<0>(LIN(IW_1, l), 2048, 8192, LIN(IG_MLP, l), (bf16*)(wl + WO_1), 8192 / 32, scr, r, lane); continue; } r -= I_1;
        transpose_item<0>(LIN(IW_2, l), 8192, 2048, nullptr, (bf16*)(wl + WO_2), 2048 / 32, scr, r, lane);
    }
    for (int m = gw; m < T; m += NGW) { const float s = row_to_bf16(args.in[IX] + (size_t)m * DM, (bf16*)(ws + WS_XB) + (size_t)m * DM, lane);
        if (lane < 8) ((float*)(ws + WS_SSQX))[(size_t)m * 8 + lane] = lane == 0 ? s : 0.f; }
    for (int m = gw; m < NBATCH * 256; m += NGW) { const float s = row_to_bf16(args.in[IMEM] + (size_t)m * DM, (bf16*)(ws + WS_MEMB) + (size_t)m * DM, lane);
        if (lane == 0) ((float*)(ws + WS_RSTDMEM))[m] = rsq(s * (1.0f / DM) + EPS); }
    for (int e = gw * 64 + lane; e < NL * 768; e += NGW * 64) { const int l = e / 768, k = (e % 768) >> 7, c = e & 127;
        ((float*)(ws + WS_GT))[e] = k == 0 ? LIN(IG_FOXQ, l)[c] : k == 1 ? LIN(IG_FOXK, l)[c] : k == 3 ? LIN(IG_CHQ, l)[c] : k == 4 ? LIN(IG_CHK, l)[c] : 1.0f; }
    for (int e = gw * 64 + lane; e < SEQ * 32; e += NGW * 64) { const int pos = e >> 5, i = e & 31;
        const float inv = exp2f(-(float)i * (13.287712379549449f / 32.0f)); const float ang = (float)pos * inv;
        ((float*)(ws + WS_COS))[e] = cosf(ang); ((float*)(ws + WS_SIN))[e] = sinf(ang); }
}

__device__ __forceinline__ void cumsum_phase(const float* logf, float* cum, int lane, int wave) {
    const int gw = blockIdx.x * NWAVES + wave;
    if (gw >= NBATCH * 8) return;
    const int b = gw >> 3, h = gw & 7;
    float v[32]; float run = 0.f;
#pragma unroll
    for (int j = 0; j < 32; ++j) { run += logf[((size_t)b * SEQ + lane * 32 + j) * 8 + h]; v[j] = run; }
    float incl = run;
#pragma unroll
    for (int o = 1; o < 64; o <<= 1) { const float t = __shfl_up(incl, o); if (lane >= o) incl += t; }
    const float excl = incl - run;
#pragma unroll
    for (int j = 0; j < 32; ++j) cum[((size_t)b * 8 + h) * SEQ + lane * 32 + j] = v[j] + excl;
}

struct AttnS { const bf16* Q; const bf16* K; const bf16* V; bf16* O; int mode, DK, NH, SK, ldo; const float* cum; const float* relb; };
__device__ __forceinline__ void attn_simple_unit(const AttnS& A, int b, int h, int qt, LAS unsigned char* lds, int tid) {
    const int DK = A.DK, DKP = DK + 1, KP = DK + 2;
    LAS float* qs = (LAS float*)lds;
    LAS bf16* Ks = (LAS bf16*)(lds + 64 * 193 * 4);
    LAS bf16* Vs = (LAS bf16*)(lds + 64 * 193 * 4 + 64 * 194 * 2);
    LAS float* Ps = (LAS float*)(lds + 64 * 193 * 4 + 64 * 194 * 2 + 64 * 130 * 2);
    const int r = tid >> 3, sub = tid & 7;
    const float scale = rsqrtf((float)DK);
    const size_t qbase = ((size_t)(b * A.NH + h) * SEQ + qt * 64) * DK, kvbase = (size_t)(b * A.NH + h) * A.SK;
    __syncthreads();
    for (int e = tid; e < 64 * DK; e += 512) { const int rr = e / DK, d = e % DK; qs[rr * DKP + d] = bf2f(A.Q[qbase + e]) * scale; }
    const int qpos = qt * 64 + r;
    float m_run = -3.0e38f, l_run = 0.f; float o[16];
#pragma unroll
    for (int d = 0; d < 16; ++d) o[d] = 0.f;
    int j_lo = 0, j_hi = qt + 1;
    if (A.mode == 2) j_lo = qt > 8 ? qt - 8 : 0;
    if (A.mode == 3) { j_lo = 0; j_hi = A.SK / 64; }
    const float cq = A.mode == 1 ? A.cum[(size_t)(b * 8 + h) * SEQ + qpos] : 0.f;
    for (int j = j_lo; j < j_hi; ++j) {
        __syncthreads();
        for (int e = tid; e < 64 * DK; e += 512) { const int kk = e / DK, d = e % DK; Ks[kk * KP + d] = A.K[(kvbase + j * 64 + kk) * DK + d]; }
        for (int e = tid; e < 64 * 128; e += 512) { const int kk = e >> 7, d = e & 127; Vs[kk * 130 + d] = A.V[(kvbase + j * 64 + kk) * 128 + d]; }
        __syncthreads();
        float sc[8]; float tmax = -3.0e38f;
#pragma unroll
        for (int kk = 0; kk < 8; ++kk) { const int key = sub + 8 * kk; float s = 0.f;
            for (int d = 0; d < DK; d += 2) { const unsigned w = *(const LAS unsigned*)(Ks + key * KP + d); s += qs[r * DKP + d] * bf_lo(w) + qs[r * DKP + d + 1] * bf_hi(w); }
            const int kpos = j * 64 + key; bool ok = true;
            if (A.mode == 1) { ok = kpos <= qpos; s += cq - A.cum[(size_t)(b * 8 + h) * SEQ + kpos]; }
            if (A.mode == 2) { int rel = qpos - kpos; rel = rel < -128 ? -128 : rel > 128 ? 128 : rel; s += A.relb[h * 257 + rel + 128]; }
            s = ok ? s : -1.0e30f; sc[kk] = s; tmax = fmaxf(tmax, s); }
        tmax = fmaxf(tmax, __shfl_xor(tmax, 1)); tmax = fmaxf(tmax, __shfl_xor(tmax, 2)); tmax = fmaxf(tmax, __shfl_xor(tmax, 4));
        const float m_new = fmaxf(m_run, tmax), alpha = __expf(m_run - m_new); float ps = 0.f;
#pragma unroll
        for (int kk = 0; kk < 8; ++kk) { const float p = __expf(sc[kk] - m_new); ps += p; Ps[r * 65 + sub + 8 * kk] = p; }
        ps += __shfl_xor(ps, 1); ps += __shfl_xor(ps, 2); ps += __shfl_xor(ps, 4);
        l_run = l_run * alpha + ps; m_run = m_new;
        __syncthreads();
#pragma unroll
        for (int d = 0; d < 16; ++d) o[d] *= alpha;
        for (int key = 0; key < 64; ++key) { const float p = Ps[r * 65 + key];
#pragma unroll
            for (int d = 0; d < 16; d += 2) { const unsigned w = *(const LAS unsigned*)(Vs + key * 130 + sub * 16 + d); o[d] += p * bf_lo(w); o[d + 1] += p * bf_hi(w); } }
    }
    const float il = 1.0f / l_run;
    bf16* op = A.O + (size_t)(b * SEQ + qt * 64 + r) * A.ldo + h * 128 + sub * 16;
    u32x4 w0, w1; w0.x = cvt_pk_bf16(o[0] * il, o[1] * il); w0.y = cvt_pk_bf16(o[2] * il, o[3] * il); w0.z = cvt_pk_bf16(o[4] * il, o[5] * il); w0.w = cvt_pk_bf16(o[6] * il, o[7] * il);
    w1.x = cvt_pk_bf16(o[8] * il, o[9] * il); w1.y = cvt_pk_bf16(o[10] * il, o[11] * il); w1.z = cvt_pk_bf16(o[12] * il, o[13] * il); w1.w = cvt_pk_bf16(o[14] * il, o[15] * il);
    *(u32x4*)op = w0; *(u32x4*)(op + 8) = w1;
}

constexpr int NPH = 10;
constexpr int NPHASE = 1 + NL * NPH;
__global__ void __launch_bounds__(NWAVES * 64, 2) fwd_kernel(Args args) {
    extern __shared__ __attribute__((aligned(16))) unsigned char lds_raw[];
    LAS unsigned char* lds = (LAS unsigned char*)lds_raw;
    volatile LAS unsigned* MISC = (volatile LAS unsigned*)(lds + MISC_OFF);
    const int tid0 = threadIdx.x, wave = __builtin_amdgcn_readfirstlane(tid0 >> 6);
    const int G = gridDim.x, bx = blockIdx.x;
    unsigned char* const ws0 = args.ws;
    unsigned* ctl = (unsigned*)(ws0 + WS_CTL);
    for (int u = tid0; u < 256; u += NWAVES * 64) MISC[u] = 0u;
    __syncthreads();
#if MK_PER_PHASE
#define SEAM(g) do { } while (0)
#else
    XcdBarrier bar = xcd_barrier_post(ctl + 4096, MISC + 8);
#define SEAM(g) do { if ((g) + 1 < g_hi) xcd_barrier(bar); } while (0)
#endif
    const int g_lo = args.g_lo, g_hi = args.g_hi;
#ifndef PH_MASK
#define PH_MASK 0x7ff
#endif
#define IN(g) (g_lo <= (g) && (g) < g_hi)
    LAS float* escr = (LAS float*)(lds + ESCR_OFF);

    if ((PH_MASK & 1) && IN(0)) { prologue(args, lds, tid0 & 63, wave); SEAM(0); }

#define OPAQUE_PTRS() unsigned char* ws = ws0; asm volatile("" : "+s"(ws)); int tid = tid0; asm volatile("" : "+v"(tid)); const int lane = tid & 63; (void)lane; unsigned char* wl = ws + WS_W + (size_t)l * W_LAYER; float* ssqx = (float*)(ws + WS_SSQX); bf16* xb = (bf16*)(ws + WS_XB); \
    const float* cosT = (const float*)(ws + WS_COS); const float* sinT = (const float*)(ws + WS_SIN); (void)wl; (void)ssqx; (void)xb; (void)cosT; (void)sinT
    for (int l = 0; l < NL; ++l) {
        const int gb = 1 + l * NPH;
        if ((PH_MASK & 2) && IN(gb + 0)) {
            OPAQUE_PTRS();
            pg8::Gemm g{xb, (const bf16*)(wl + WO_IN), T, NIN, 2048, 0, 0}; pg8::StaticOrder S; S.init(T, NIN, G, bx);
            EpiInProj E{ssqx, (bf16*)(ws + WS_CQ), (float*)(ws + WS_SSQCQ), (bf16*)(ws + WS_CKV), (float*)(ws + WS_SSQCKV), (float*)(ws + WS_KR), (float*)(ws + WS_SSQKR),
                        (float*)(ws + WS_LOGF), LIN(IB_F, l), (bf16*)(ws + WS_FQ), (const float*)(ws + WS_GT) + l * 768, (bf16*)(ws + WS_GATES), escr};
            pg8::gemm_phase<EpiInProj, pg8::StaticOrder, true, true>(lds, g, S, E);
            SEAM(gb + 0);
        }
        if ((PH_MASK & 4) && IN(gb + 1)) {
            OPAQUE_PTRS();
#ifndef P1MASK
#define P1MASK 7
#endif
            if (P1MASK & 1) { pg8::Gemm g{(const bf16*)(ws + WS_CQ), (const bf16*)(wl + WO_UQ), T, 2048, 512, 0, 0}; pg8::StaticOrder S; S.init(T, 2048, G, bx);
              EpiQUp E{(const float*)(ws + WS_SSQCQ), LIN(IG_MLAQ, l), cosT, sinT, (bf16*)(ws + WS_MQ), escr};
              pg8::gemm_phase<EpiQUp, pg8::StaticOrder, true, true>(lds, g, S, E); }
            if (P1MASK & 2) { pg8::Gemm g{(const bf16*)(ws + WS_CKV), (const bf16*)(wl + WO_UKV), T, 2048, 256, 0, 0}; pg8::StaticOrder S; S.init(T, 2048, G, bx);
              EpiKvUp E{(const float*)(ws + WS_SSQCKV), (const float*)(ws + WS_SSQKR), (const float*)(ws + WS_KR), LIN(IG_MLAK, l), cosT, sinT, (bf16*)(ws + WS_MK), (bf16*)(ws + WS_MV), escr + 2048};
              pg8::gemm_phase<EpiKvUp, pg8::StaticOrder, true, true>(lds, g, S, E); }
            if (P1MASK & 4) cumsum_phase((const float*)(ws + WS_LOGF), (float*)(ws + WS_CUM), lane, wave);
            SEAM(gb + 1);
        }
        if ((PH_MASK & 8) && IN(gb + 2)) {
            OPAQUE_PTRS();
            for (int it = bx; it < 3 * NBATCH * 8 * 32; it += G) {
                const int br = it / (NBATCH * 8 * 32), r = it % (NBATCH * 8 * 32), b = r / (8 * 32), h = (r / 32) % 8, qt = 31 - (r % 32);
                AttnS A;
                if (br == 0) A = AttnS{(const bf16*)(ws + WS_MQ), (const bf16*)(ws + WS_MK), (const bf16*)(ws + WS_MV), (bf16*)(ws + WS_Y), 0, 192, 8, SEQ, 1024, nullptr, nullptr};
                else if (br == 1) A = AttnS{(const bf16*)(ws + WS_FQ), (const bf16*)(ws + WS_FK), (const bf16*)(ws + WS_FV), (bf16*)(ws + WS_Y) + (size_t)T * 1024, 1, 128, 8, SEQ, 1024, (const float*)(ws + WS_CUM), nullptr};
                else A = AttnS{(const bf16*)(ws + WS_CHQ), (const bf16*)(ws + WS_CHK), (const bf16*)(ws + WS_CHV), (bf16*)(ws + WS_Y) + (size_t)2 * T * 1024, 2, 128, 8, SEQ, 1024, nullptr, LIN(IRELB, l)};
                attn_simple_unit(A, b, h, qt, lds, tid);
            }
            __syncthreads();
            SEAM(gb + 2);
        }
        if ((PH_MASK & 16) && IN(gb + 3)) {
            OPAQUE_PTRS();
            pg8::Gemm g{(const bf16*)(ws + WS_Y), (const bf16*)(wl + WO_BR), T, 2048, 1024, (size_t)T * 1024 * 2, (size_t)2048 * 1024 * 2}; pg8::ZOrder<3> S; S.init(T, 2048, G, bx);
            EpiBr E{(const bf16*)(ws + WS_GATES), (bf16*)(ws + WS_MERGED)};
            pg8::gemm_phase<EpiBr, pg8::ZOrder<3>, true, true>(lds, g, S, E);
            SEAM(gb + 3);
        }
        if ((PH_MASK & 32) && IN(gb + 4)) {
            OPAQUE_PTRS();
            pg8::Gemm g{(const bf16*)(ws + WS_MERGED), (const bf16*)(wl + WO_OUT), T, 2048, 2048, 0, 0}; pg8::StaticOrder S; S.init(T, 2048, G, bx);
            EpiResid E{l == 0 ? args.in[IX] : args.out, args.out, xb, ssqx, escr};
            pg8::gemm_phase<EpiResid, pg8::StaticOrder, true, true>(lds, g, S, E);
            SEAM(gb + 4);
        }
        if ((PH_MASK & 64) && IN(gb + 5)) {
            OPAQUE_PTRS();
            { pg8::Gemm g{xb, (const bf16*)(wl + WO_XQ), T, 512, 2048, 0, 0}; pg8::StaticOrder S; S.init(T, 512, G, bx);
              EpiHeadNorm E{ssqx, nullptr, LIN(IG_XQ, l), (bf16*)(ws + WS_XQ), nullptr, 2, SEQ, 11, escr};
              pg8::gemm_phase<EpiHeadNorm, pg8::StaticOrder, true, true>(lds, g, S, E); }
            { pg8::Gemm g{(const bf16*)(ws + WS_MEMB), (const bf16*)(wl + WO_XKV), NBATCH * 256, 1024, 2048, 0, 0}; pg8::StaticOrder S; S.init(NBATCH * 256, 1024, G, (bx + G - 64) % G);
              EpiHeadNorm E{nullptr, (const float*)(ws + WS_RSTDMEM), LIN(IG_XK, l), (bf16*)(ws + WS_XK), (bf16*)(ws + WS_XV), 2, 256, 8, escr + 2048};
              pg8::gemm_phase<EpiHeadNorm, pg8::StaticOrder, true, true>(lds, g, S, E); }
            SEAM(gb + 5);
        }
        if ((PH_MASK & 128) && IN(gb + 6)) {
            OPAQUE_PTRS();
            for (int it = bx; it < NBATCH * 4 * 32; it += G) {
                const int b = it / (4 * 32), h = (it / 32) % 4, qt = it % 32;
                const AttnS A{(const bf16*)(ws + WS_XQ), (const bf16*)(ws + WS_XK), (const bf16*)(ws + WS_XV), (bf16*)(ws + WS_OX), 3, 128, 4, 256, 512, nullptr, nullptr};
                attn_simple_unit(A, b, h, qt, lds, tid);
            }
            __syncthreads();
            SEAM(gb + 6);
        }
        if ((PH_MASK & 256) && IN(gb + 7)) {
            OPAQUE_PTRS();
            pg8::Gemm g{(const bf16*)(ws + WS_OX), (const bf16*)(wl + WO_XO), T, 2048, 512, 0, 0}; pg8::StaticOrder S; S.init(T, 2048, G, bx);
            EpiResid E{args.out, args.out, xb, ssqx, escr};
            pg8::gemm_phase<EpiResid, pg8::StaticOrder, true, true>(lds, g, S, E);
            SEAM(gb + 7);
        }
        if ((PH_MASK & 512) && IN(gb + 8)) {
            OPAQUE_PTRS();
            pg8::Gemm g{xb, (const bf16*)(wl + WO_1), T, FF, 2048, 0, 0}; pg8::StaticOrder S; S.init(T, FF, G, bx);
            EpiMlp1 E{ssqx, (bf16*)(ws + WS_H)};
            pg8::gemm_phase<EpiMlp1, pg8::StaticOrder, true, true>(lds, g, S, E);
            SEAM(gb + 8);
        }
        if ((PH_MASK & 1024) && IN(gb + 9)) {
            OPAQUE_PTRS();
            pg8::Gemm g{(const bf16*)(ws + WS_H), (const bf16*)(wl + WO_2), T, 2048, FF, 0, 0}; pg8::StaticOrder S; S.init(T, 2048, G, bx);
            EpiResid E{args.out, args.out, xb, ssqx, escr};
            pg8::gemm_phase<EpiResid, pg8::StaticOrder, true, true>(lds, g, S, E);
            SEAM(gb + 9);
        }
    }
#undef IN
#undef SEAM
}

extern "C" void kernel_launch(void* const* d_in, const int* in_sizes, int n_in, void* d_out, int out_size, void* d_ws, size_t ws_size, hipStream_t stream) {
    static int grid = 0;
    if (grid == 0) {
        if (n_in != N_IN || in_sizes[0] != T * DM || out_size != T * DM || ws_size < WS_END) { fprintf(stderr, "kernel_launch: unexpected shapes (n_in %d, in0 %d, out %d, ws %zu < %zu)\n", n_in, n_in > 0 ? in_sizes[0] : -1, out_size, ws_size, (size_t)WS_END); grid = -1; return; }
        int dev = 0, cus = 0, per_cu = 0;
        if (hipGetDevice(&dev) != hipSuccess || hipDeviceGetAttribute(&cus, hipDeviceAttributeMultiprocessorCount, dev) != hipSuccess) { grid = -1; return; }
        if (hipFuncSetAttribute((const void*)fwd_kernel, hipFuncAttributeMaxDynamicSharedMemorySize, LDS_BYTES) != hipSuccess) { fprintf(stderr, "kernel_launch: hipFuncSetAttribute failed\n"); grid = -1; return; }
        if (hipOccupancyMaxActiveBlocksPerMultiprocessor(&per_cu, (const void*)fwd_kernel, NWAVES * 64, LDS_BYTES) != hipSuccess || per_cu < 1) fprintf(stderr, "kernel_launch: occupancy query reports %d\n", per_cu);
        (void)hipGetLastError();
        grid = cus;
    }
    if (grid < 0) return;
    if (hipMemsetAsync((char*)d_ws + WS_CTL, 0, CTL_ZERO_BYTES, stream) != hipSuccess) return;
    Args a{};
    for (int i = 0; i < N_IN; ++i) a.in[i] = (const float*)d_in[i];
    a.out = (float*)d_out; a.ws = (unsigned char*)d_ws;
#if MK_PER_PHASE
    for (int g = 0; g < NPHASE; ++g) { a.g_lo = g; a.g_hi = g + 1; hipLaunchKernelGGL(fwd_kernel, dim3(grid), dim3(NWAVES * 64), LDS_BYTES, stream, a); }
#else
    a.g_lo = 0; a.g_hi = NPHASE;
    hipLaunchKernelGGL(fwd_kernel, dim3(grid), dim3(NWAVES * 64), LDS_BYTES, stream, a);
#endif
    const hipError_t le = hipPeekAtLastError();
    if (le != hipSuccess) fprintf(stderr, "kernel_launch: launch failed: %s\n", hipGetErrorName(le));
}
```

```cpp
#include <hip/hip_runtime.h>
#include <cstdio>
#include <cstdint>

#ifndef MK_PER_PHASE
#define MK_PER_PHASE 0
#endif

namespace pg8 {
#define PG8_LAS __attribute__((address_space(3)))
typedef unsigned short bf16_t;
typedef short bf16x8 __attribute__((ext_vector_type(8)));
typedef float f32x4 __attribute__((ext_vector_type(4)));
typedef unsigned u32x4 __attribute__((ext_vector_type(4)));
constexpr int BM = 256, BK = 64, HALF = 128, HTB = HALF * BK * 2  , STAGE_BYTES = 8 * HTB, NXCD = 8, WGM = 8;

__host__ __device__ __forceinline__ int lds_byte(int r, int c) { const int st = (r >> 4) * 2 + (c >> 5), rr = r & 15, cc = c & 31, ob = rr * 64 + cc * 2; return st * 1024 + (ob ^ (((ob >> 9) & 1) << 5)); }
__host__ __device__ __forceinline__ void stage_rc(int b, int& R, int& C) { const int st = b / 1024, sb = b % 1024, swz = sb ^ (((sb >> 9) & 1) << 5); R = (st >> 1) * 16 + swz / 64; C = (st & 1) * 32 + (swz % 64) / 2; }
__host__ __device__ __forceinline__ int perm32(int rho) { const int n = rho >> 4, i = rho & 15; return 8 * (i >> 2) + 4 * n + (i & 3); }

struct Unit { int pm, pn, z; };
struct Gemm { const bf16_t* A; const bf16_t* Bt; int M, N, K; size_t zA, zB; };

struct StaticOrder {
    int nM, nN, nwg, G, c;
    __host__ __device__ void init(int M, int N, int G_, int c_) { nM = M / BM; nN = N / BM; nwg = nM * nN; G = G_; c = c_; }
    __host__ __device__ bool next(int i, Unit& u) const {
        const long L = (long)i * G + c; if (L >= nwg) return false;
        int wgid = (int)L; { const int q = nwg / NXCD, r = nwg % NXCD, xcd = wgid % NXCD, off = wgid / NXCD; wgid = (xcd < r ? xcd * (q + 1) : r * (q + 1) + (xcd - r) * q) + off; }
        const int nig = WGM * nN, gid = wgid / nig, fm = gid * WGM, gsz = (nM - fm) < WGM ? (nM - fm) : WGM;
        u.pm = fm + ((wgid % nig) % gsz); u.pn = (wgid % nig) / gsz; u.z = 0; return true;
    }
    __device__ __forceinline__ void a_ready(const Unit&) const {}
    __device__ __forceinline__ void done(const Unit&) const {}
};

template <int NZ> struct ZOrder {
    StaticOrder so;
    __host__ __device__ void init(int M, int N, int G_, int c_) { so.init(M, N, G_, c_); }
    __host__ __device__ bool next(int i, Unit& u) const { if (!so.next(i / NZ, u)) return false; u.z = i % NZ; return true; }
    __device__ __forceinline__ void a_ready(const Unit&) const {}
    __device__ __forceinline__ void done(const Unit&) const {}
};

__device__ __forceinline__ unsigned cvt_pk_bf16(float lo, float hi) { unsigned r; asm volatile("v_cvt_pk_bf16_f32 %0, %1, %2" : "=v"(r) : "v"(lo), "v"(hi)); return r; }
typedef float f32x2 __attribute__((ext_vector_type(2)));
template <class Epi, class Sched, bool ALIGN_EPI = false, bool SP2 = false>
__device__ __forceinline__ void gemm_phase(PG8_LAS unsigned char* lds, const Gemm g, const Sched& S, const Epi& E) {
    int tid_ = threadIdx.x; asm volatile("" : "+v"(tid_));
    const int tid = tid_, wid = __builtin_amdgcn_readfirstlane(tid >> 6), lane = tid & 63, wr = wid >> 2, wc = wid & 3, fr = lane & 15, fq = lane >> 4;
    const int K = g.K, nt = K / BK;
    unsigned voffA[2], voffB[2];
#pragma unroll
    for (int i = 0; i < 2; ++i) { int R, C; stage_rc(tid * 16 + i * 8192, R, C); const int Rb = Epi::PERM ? ((R & ~31) + perm32(R & 31)) : R;
        voffA[i] = (unsigned)(R * K + C) * 2u; voffB[i] = (unsigned)(Rb * K + C) * 2u; }
    const size_t kstep = (size_t)(BK * 2);
    const size_t hstep = (size_t)HALF * K * 2;
    const size_t tstep = 2 * hstep;
    const unsigned ldsw = (unsigned)wid * 1024u;
    const int aoff = lds_byte(wr * 64 + fr, fq * 8), boff = lds_byte(wc * 32 + fr, fq * 8);
#define PG8_SA(b, h) (((b) * 2 + (h)) * HTB)
#define PG8_SB(b, h) ((4 + (b) * 2 + (h)) * HTB)
#define PG8_STAGE(bufoff, gbase, voff) do { _Pragma("unroll") for (int _i = 0; _i < 2; ++_i) \
        __builtin_amdgcn_global_load_lds((const unsigned*)((const char*)(gbase) + (voff)[_i]), (PG8_LAS unsigned*)(lds + (bufoff) + ldsw + _i * 8192), 16, 0, 0); } while (0)
#define PG8_LDA(dst, b, h) do { _Pragma("unroll") for (int m = 0; m < 4; ++m) _Pragma("unroll") for (int k = 0; k < 2; ++k) dst[m][k] = *(const PG8_LAS bf16x8*)(lds + PG8_SA(b, h) + aoff + m * 2048 + k * 1024); } while (0)
#define PG8_LDB(dst, b, h) do { _Pragma("unroll") for (int n = 0; n < 2; ++n) _Pragma("unroll") for (int k = 0; k < 2; ++k) dst[n][k] = *(const PG8_LAS bf16x8*)(lds + PG8_SB(b, h) + boff + n * 2048 + k * 1024); } while (0)
#define PG8_MMA(ai, bj, At, Bt) do { __builtin_amdgcn_s_setprio(1); _Pragma("unroll") for (int m = 0; m < 4; ++m) _Pragma("unroll") for (int n = 0; n < 2; ++n) _Pragma("unroll") for (int k = 0; k < 2; ++k) \
        acc[ai][bj][m][n] = __builtin_amdgcn_mfma_f32_16x16x32_bf16(Bt[n][k], At[m][k], acc[ai][bj][m][n], 0, 0, 0); __builtin_amdgcn_s_setprio(0); } while (0)
#define PG8_WAIT_V(n) asm volatile("s_waitcnt vmcnt(" #n ")" ::: "memory")
#define PG8_WAIT_L(n) asm volatile("s_waitcnt lgkmcnt(" #n ")" ::: "memory")
#define PG8_BAR __builtin_amdgcn_s_barrier()
#define PG8_SCHED __builtin_amdgcn_sched_barrier(0)
    Unit cur, nxt; int ui = 0;
    if (!S.next(0, cur)) return;
    f32x4 acc[2][2][4][2];
#pragma unroll
    for (int a = 0; a < 2; ++a)
#pragma unroll
        for (int b = 0; b < 2; ++b)
#pragma unroll
            for (int m = 0; m < 4; ++m)
#pragma unroll
                for (int n = 0; n < 2; ++n) acc[a][b][m][n] = (f32x4){0.f, 0.f, 0.f, 0.f};
    bf16x8 At[4][2], B0[2][2], B1[2][2];
    const char* cA = (const char*)g.A + (size_t)cur.pm * tstep + (size_t)cur.z * g.zA; const char* cB = (const char*)g.Bt + (size_t)cur.pn * tstep + (size_t)cur.z * g.zB;
    S.a_ready(cur);
    if constexpr (SP2) {
        PG8_STAGE(PG8_SB(0, 0), cB, voffB); PG8_STAGE(PG8_SB(0, 1), cB + hstep, voffB); PG8_STAGE(PG8_SA(0, 0), cA, voffA); PG8_STAGE(PG8_SA(0, 1), cA + hstep, voffA);
        if (wr == 1) PG8_BAR;
        PG8_WAIT_V(2); PG8_BAR;
        PG8_STAGE(PG8_SB(1, 0), cB + kstep, voffB); PG8_STAGE(PG8_SA(1, 0), cA + kstep, voffA); PG8_STAGE(PG8_SB(1, 1), cB + hstep + kstep, voffB);
        PG8_WAIT_V(6); PG8_BAR;
    } else {
        PG8_STAGE(PG8_SB(0, 0), cB, voffB); PG8_STAGE(PG8_SA(0, 0), cA, voffA); PG8_STAGE(PG8_SB(0, 1), cB + hstep, voffB); PG8_STAGE(PG8_SA(0, 1), cA + hstep, voffA);
        if (wr == 1) PG8_BAR;
        PG8_WAIT_V(4); PG8_BAR;
        PG8_STAGE(PG8_SB(1, 0), cB + kstep, voffB); PG8_STAGE(PG8_SA(1, 0), cA + kstep, voffA); PG8_STAGE(PG8_SB(1, 1), cB + hstep + kstep, voffB);
        PG8_WAIT_V(6); PG8_BAR;
    }
    for (;;) {
        const bool has_next = S.next(ui + 1, nxt);
        const char* nA = has_next ? (const char*)g.A + (size_t)nxt.pm * tstep + (size_t)nxt.z * g.zA : cA; const char* nB = has_next ? (const char*)g.Bt + (size_t)nxt.pn * tstep + (size_t)nxt.z * g.zB : cB;
#pragma unroll 1
        for (int t = 0; t < nt; t += 2) {
            const bool last = (t == nt - 2);
            const char* a1 = cA + (size_t)(t + 1) * kstep;
            const char* a2 = last ? nA : cA + (size_t)(t + 2) * kstep; const char* b2 = last ? nB : cB + (size_t)(t + 2) * kstep;
            const char* a3 = a2 + kstep; const char* b3 = b2 + kstep;
            if (last && has_next) S.a_ready(nxt);
            if constexpr (SP2) {
            PG8_LDB(B0, 0, 0); PG8_LDB(B1, 0, 1); PG8_SCHED; PG8_LDA(At, 0, 0); PG8_STAGE(PG8_SA(1, 1), a1 + hstep, voffA);
            PG8_WAIT_V(8); PG8_WAIT_L(0); PG8_BAR; PG8_MMA(0, 0, At, B0); PG8_MMA(0, 1, At, B1); PG8_BAR; PG8_SCHED;
            PG8_LDA(At, 0, 1); PG8_STAGE(PG8_SB(0, 0), b2, voffB); PG8_STAGE(PG8_SB(0, 1), b2 + hstep, voffB); PG8_STAGE(PG8_SA(0, 0), a2, voffA);
            PG8_WAIT_V(8); PG8_WAIT_L(0); PG8_BAR; PG8_MMA(1, 0, At, B0); PG8_MMA(1, 1, At, B1); PG8_BAR; PG8_SCHED;
            PG8_LDB(B0, 1, 0); PG8_LDB(B1, 1, 1); PG8_SCHED; PG8_LDA(At, 1, 0); PG8_STAGE(PG8_SA(0, 1), a2 + hstep, voffA);
            PG8_WAIT_V(8); PG8_WAIT_L(0); PG8_BAR; PG8_MMA(0, 0, At, B0); PG8_MMA(0, 1, At, B1); PG8_BAR; PG8_SCHED;
            PG8_LDA(At, 1, 1); PG8_STAGE(PG8_SB(1, 0), b3, voffB); PG8_STAGE(PG8_SB(1, 1), b3 + hstep, voffB); PG8_STAGE(PG8_SA(1, 0), a3, voffA);
            PG8_WAIT_V(8); PG8_WAIT_L(0); PG8_BAR; PG8_MMA(1, 0, At, B0); PG8_MMA(1, 1, At, B1); PG8_BAR; PG8_SCHED;
            } else {
            PG8_LDB(B0, 0, 0); PG8_SCHED; PG8_LDA(At, 0, 0); PG8_STAGE(PG8_SA(1, 1), a1 + hstep, voffA);
            PG8_WAIT_L(8); PG8_BAR; PG8_WAIT_L(0); PG8_MMA(0, 0, At, B0); PG8_BAR; PG8_SCHED;
            PG8_LDB(B1, 0, 1); PG8_STAGE(PG8_SB(0, 0), b2, voffB);
            PG8_BAR; PG8_WAIT_L(0); PG8_MMA(0, 1, At, B1); PG8_BAR;
            PG8_LDA(At, 0, 1); PG8_STAGE(PG8_SA(0, 0), a2, voffA);
            PG8_BAR; PG8_WAIT_L(0); PG8_MMA(1, 0, At, B0); PG8_BAR; PG8_SCHED;
            PG8_STAGE(PG8_SB(0, 1), b2 + hstep, voffB);
            PG8_WAIT_V(6); PG8_BAR; PG8_MMA(1, 1, At, B1); PG8_BAR;
            PG8_LDB(B0, 1, 0); PG8_SCHED; PG8_LDA(At, 1, 0); PG8_STAGE(PG8_SA(0, 1), a2 + hstep, voffA);
            PG8_WAIT_L(8); PG8_BAR; PG8_WAIT_L(0); PG8_MMA(0, 0, At, B0); PG8_BAR; PG8_SCHED;
            PG8_LDB(B1, 1, 1); PG8_STAGE(PG8_SB(1, 0), b3, voffB);
            PG8_BAR; PG8_WAIT_L(0); PG8_MMA(0, 1, At, B1); PG8_BAR;
            PG8_LDA(At, 1, 1); PG8_STAGE(PG8_SA(1, 0), a3, voffA);
            PG8_BAR; PG8_WAIT_L(0); PG8_MMA(1, 0, At, B0); PG8_BAR; PG8_SCHED;
            PG8_STAGE(PG8_SB(1, 1), b3 + hstep, voffB);
            PG8_WAIT_V(6); PG8_BAR; PG8_MMA(1, 1, At, B1); PG8_BAR;
            }
        }
        if constexpr (ALIGN_EPI) { if (wr == 0) PG8_BAR; }
        if constexpr (!Epi::AFTER_DRAIN) { E(acc, cur, wr, wc, fr, fq); S.done(cur); }
        if (!has_next) break;
#pragma unroll
        for (int a = 0; a < 2; ++a)
#pragma unroll
            for (int b = 0; b < 2; ++b)
#pragma unroll
                for (int m = 0; m < 4; ++m)
#pragma unroll
                    for (int n = 0; n < 2; ++n) acc[a][b][m][n] = (f32x4){0.f, 0.f, 0.f, 0.f};
        cur = nxt; cA = nA; cB = nB; ++ui;
        if constexpr (ALIGN_EPI) { if (wr == 1) PG8_BAR; }
    }
    PG8_WAIT_V(0);
    if constexpr (!ALIGN_EPI) { if (wr == 0) PG8_BAR; }
    PG8_BAR;
    if constexpr (Epi::AFTER_DRAIN) { E.fused(acc, cur, wr, wc, fr, fq, lds, wid, lane); S.done(cur); }
#undef PG8_SA
#undef PG8_SB
#undef PG8_STAGE
#undef PG8_LDA
#undef PG8_LDB
#undef PG8_MMA
#undef PG8_WAIT_V
#undef PG8_WAIT_L
#undef PG8_BAR
#undef PG8_SCHED
}
}

constexpr int NBATCH = 4, SEQ = 2048, DM = 2048, T = NBATCH * SEQ, NL = 4, FF = 8192;
constexpr int NIN = 13312;
constexpr int DIN_SRC = 13128;
constexpr float EPS = 1e-6f;
enum { IX = 0, IMEM, IG_MIX, IW_IN, IG_CQ, IW_UQ, IG_CKV, IW_UKV, IG_MLAQ, IG_MLAK, IB_F, IG_FOXQ, IG_FOXK, IRELB, IG_CHQ, IG_CHK, IW_BR, IW_OUT,
       IG_CROSS, IG_MEM, IW_XQ, IW_XKV, IG_XQ, IG_XK, IW_XO, IG_MLP, IW_1, IW_2, N_IN };

constexpr size_t MiB = 1u << 20;
constexpr size_t WS_CTL = 0, CTL_ZERO_BYTES = 1 * MiB;
constexpr size_t WS_COS = 1 * MiB, WS_SIN = WS_COS + 256 * 1024, WS_RSTDMEM = WS_SIN + 256 * 1024, WS_GT = WS_RSTDMEM + 4096;
constexpr size_t WS_W = 2 * MiB;
constexpr size_t WO_IN = 0, WO_UQ = WO_IN + (size_t)NIN * 2048 * 2, WO_UKV = WO_UQ + (size_t)2048 * 512 * 2, WO_BR = WO_UKV + (size_t)2048 * 256 * 2,
                 WO_OUT = WO_BR + (size_t)3 * 2048 * 1024 * 2, WO_XQ = WO_OUT + (size_t)2048 * 2048 * 2, WO_XKV = WO_XQ + (size_t)512 * 2048 * 2,
                 WO_XO = WO_XKV + (size_t)1024 * 2048 * 2, WO_1 = WO_XO + (size_t)2048 * 512 * 2, WO_2 = WO_1 + (size_t)8192 * 2048 * 2,
                 W_LAYER = WO_2 + (size_t)2048 * 8192 * 2;
static_assert(W_LAYER == 147 * MiB, "weight map");
constexpr size_t WS_ACT = WS_W + NL * W_LAYER;
constexpr size_t WS_XB = WS_ACT, WS_CQ = WS_XB + 32 * MiB, WS_CKV = WS_CQ + 8 * MiB, WS_KR = WS_CKV + 4 * MiB, WS_SMALL = WS_KR + 2 * MiB;
constexpr size_t WS_SSQX = WS_SMALL, WS_SSQCQ = WS_SSQX + 256 * 1024, WS_SSQCKV = WS_SSQCQ + 64 * 1024, WS_SSQKR = WS_SSQCKV + 32 * 1024,
                 WS_LOGF = WS_SSQKR + 32 * 1024, WS_CUM = WS_LOGF + 256 * 1024;
constexpr size_t WS_FQ = WS_SMALL + 2 * MiB, WS_FK = WS_FQ + 16 * MiB, WS_FV = WS_FK + 16 * MiB, WS_CHQ = WS_FV + 16 * MiB, WS_CHK = WS_CHQ + 16 * MiB, WS_CHV = WS_CHK + 16 * MiB;
constexpr size_t WS_GATES = WS_CHV + 16 * MiB, WS_MQ = WS_GATES + 96 * MiB, WS_MK = WS_MQ + 24 * MiB, WS_MV = WS_MK + 24 * MiB, WS_Y = WS_MV + 16 * MiB;
constexpr size_t WS_MERGED = WS_Y + 48 * MiB, WS_XQ = WS_MERGED + 32 * MiB, WS_MEMB = WS_XQ + 8 * MiB, WS_XK = WS_MEMB + 4 * MiB, WS_XV = WS_XK + 1 * MiB, WS_OX = WS_XV + 1 * MiB;
constexpr size_t WS_H = WS_OX + 8 * MiB, WS_END = WS_H + 128 * MiB;
static_assert(WS_CUM + 256 * 1024 <= WS_FQ, "small map");

constexpr int RING_BYTES = 131072;
constexpr int ESCR_OFF = RING_BYTES, ESCR_BYTES = 16384;
constexpr int MISC_OFF = ESCR_OFF + ESCR_BYTES;
constexpr int LDS_BYTES = MISC_OFF + 1024;

#define GAS __attribute__((address_space(1)))
#define LAS __attribute__((address_space(3)))
typedef unsigned short bf16;
typedef unsigned u32x4 __attribute__((ext_vector_type(4)));
typedef unsigned u32x2 __attribute__((ext_vector_type(2)));
typedef float f32x4 __attribute__((ext_vector_type(4)));
typedef float f32x2 __attribute__((ext_vector_type(2)));
typedef GAS unsigned gu32;
#define RLX_AGENT __ATOMIC_RELAXED, __HIP_MEMORY_SCOPE_AGENT
#define LDS_WAIT() asm volatile("s_waitcnt lgkmcnt(0)" ::: "memory")
#define VM_WAIT() asm volatile("s_waitcnt vmcnt(0)" ::: "memory")
using pg8::cvt_pk_bf16;
__device__ __forceinline__ float bf_lo(unsigned w) { return __uint_as_float(w << 16); }
__device__ __forceinline__ float bf_hi(unsigned w) { return __uint_as_float(w & 0xffff0000u); }
__device__ __forceinline__ float bf2f(bf16 h) { return __uint_as_float((unsigned)h << 16); }
__device__ __forceinline__ u32x4 pack8(f32x4 a, f32x4 b) { u32x4 w; w.x = cvt_pk_bf16(a[0], a[1]); w.y = cvt_pk_bf16(a[2], a[3]); w.z = cvt_pk_bf16(b[0], b[1]); w.w = cvt_pk_bf16(b[2], b[3]); return w; }
__device__ __forceinline__ void unpack8(u32x4 w, f32x4& a, f32x4& b) { a[0] = bf_lo(w.x); a[1] = bf_hi(w.x); a[2] = bf_lo(w.y); a[3] = bf_hi(w.y); b[0] = bf_lo(w.z); b[1] = bf_hi(w.z); b[2] = bf_lo(w.w); b[3] = bf_hi(w.w); }
__device__ __forceinline__ float sumsq4(f32x4 v) { return (v[0] * v[0] + v[1] * v[1]) + (v[2] * v[2] + v[3] * v[3]); }
__device__ __forceinline__ float rsq(float x) { return __builtin_amdgcn_rsqf(x); }
__device__ __forceinline__ float sigmoidf_(float x) { return __builtin_amdgcn_rcpf(1.0f + __expf(-x)); }
__device__ __forceinline__ float log_sigmoidf_(float x) { return fminf(x, 0.f) - log1pf(expf(-fabsf(x))); }

typedef f32x4 Acc[2][2][4][2];
using pg8::Unit;
#define EPI_BAR() do { asm volatile("s_waitcnt lgkmcnt(0)" ::: "memory"); __builtin_amdgcn_s_barrier(); asm volatile("" ::: "memory"); } while (0)
template <int NB> __device__ __forceinline__ void xwave_rowsum(float (&s)[2][4][NB], LAS float* P, int wr, int wc, int fr, int fq) {
    unsigned pw = (unsigned)(uintptr_t)P + (unsigned)(((wr * 64 + fr) * NB * 4 + wc) * 4), pr = (unsigned)(uintptr_t)P + (unsigned)((wr * 64 + fr) * NB * 16);
    asm volatile("" : "+v"(pw), "+v"(pr));
#pragma unroll
    for (int ai = 0; ai < 2; ++ai)
#pragma unroll
        for (int m = 0; m < 4; ++m)
#pragma unroll
            for (int b = 0; b < NB; ++b) { float v = s[ai][m][b]; v += __shfl_xor(v, 16); v += __shfl_xor(v, 32);
                if (fq == 0) *(LAS float*)(pw + (unsigned)(((ai * 128 + m * 16) * NB + b) * 16)) = v; }
    EPI_BAR();
#pragma unroll
    for (int ai = 0; ai < 2; ++ai)
#pragma unroll
        for (int m = 0; m < 4; ++m)
#pragma unroll
            for (int b = 0; b < NB; ++b) { const f32x4 t = *(const LAS f32x4*)(pr + (unsigned)(((ai * 128 + m * 16) * NB + b) * 16)); s[ai][m][b] = (t[0] + t[1]) + (t[2] + t[3]); }
}
__device__ __forceinline__ void fresh_lane(int& fr, int& fq) { int l; asm volatile("v_mbcnt_lo_u32_b32 %0, -1, 0\n\tv_mbcnt_hi_u32_b32 %0, -1, %0" : "=v"(l)); fr = l & 15; fq = l >> 4; }
template <class V> __device__ __forceinline__ V ldg(const void* base, unsigned boff) { return *(const V*)((const char*)base + boff); }
template <class V> __device__ __forceinline__ void stg(void* base, unsigned boff, V v) { *(V*)((char*)base + boff) = v; }
__device__ __forceinline__ float sum8(f32x4 a, f32x4 b) { return ((a[0] + a[1]) + (a[2] + a[3])) + ((b[0] + b[1]) + (b[2] + b[3])); }
__device__ __forceinline__ float rstd8(const float* base, unsigned row) { return rsq(sum8(ldg<f32x4>(base, row * 32u), ldg<f32x4>(base, row * 32u + 16u)) * (1.0f / DM) + EPS); }
#define ROWG(ai, m) ((unsigned)(row0 + (ai) * 128 + (m) * 16))
#define EPI_AM _Pragma("unroll") for (int ai = 0; ai < 2; ++ai) _Pragma("unroll") for (int m = 0; m < 4; ++m) if ((__builtin_amdgcn_sched_barrier(0), true))
#define EPI_BJ _Pragma("unroll") for (int bj = 0; bj < 2; ++bj)

struct EpiInProj {
    static constexpr bool PERM = true, AFTER_DRAIN = false;
    const float* ssqx; bf16* cq; float* ssqcq; bf16* ckv; float* ssqckv; float* kr; float* ssqkr; float* logf; const float* b_f;
    bf16* hm;
    const float* gt;
    bf16* gates; LAS float* scr;
    __device__ __forceinline__ void operator()(Acc& acc, const Unit& u, int wr, int wc, int fr, int fq) const {
        fresh_lane(fr, fq);
        int row0 = u.pm * 256 + wr * 64 + fr, c8 = wc * 32 + fq * 8;
        asm volatile("" : "+v"(row0), "+v"(c8), "+v"(fq));
        const int pn = u.pn;
        EPI_AM { const float rs = rstd8(ssqx, ROWG(ai, m));
            EPI_BJ { acc[ai][bj][m][0] *= rs; acc[ai][bj][m][1] *= rs; } }
        if (pn >= 28) {
            EPI_AM { const unsigned row = ROWG(ai, m);
                EPI_BJ { f32x4 a = acc[ai][bj][m][0], b = acc[ai][bj][m][1];
#pragma unroll
                    for (int e = 0; e < 4; ++e) { a[e] = sigmoidf_(a[e]); b[e] = sigmoidf_(b[e]); }
                    stg<u32x4>(gates, row * 12288u + ((pn - 28) * 256 + bj * 128 + c8) * 2u, pack8(a, b)); } }
            return;
        }
        float s[2][4][2];
        const bool kr_tile = pn == 3;
        EPI_AM { const float s0 = sumsq4(acc[ai][0][m][0]) + sumsq4(acc[ai][0][m][1]), s1 = sumsq4(acc[ai][1][m][0]) + sumsq4(acc[ai][1][m][1]);
            s[ai][m][0] = (kr_tile && wc >= 2) ? 0.f : s0; s[ai][m][1] = kr_tile ? 0.f : s1; }
        xwave_rowsum<2>(s, scr, wr, wc, fr, fq);
        if (pn < 3) {
            EPI_AM { const unsigned row = ROWG(ai, m); const float tot = s[ai][m][0] + s[ai][m][1];
                if (wc == 0 && fq == 0) { if (pn < 2) stg<float>(ssqcq, row * 8u + pn * 4u, tot); else stg<float>(ssqckv, row * 4u, tot); }
                EPI_BJ { const u32x4 w = pack8(acc[ai][bj][m][0], acc[ai][bj][m][1]);
                    if (pn < 2) stg<u32x4>(cq, row * 1024u + (pn * 256 + bj * 128 + c8) * 2u, w); else stg<u32x4>(ckv, row * 512u + (bj * 128 + c8) * 2u, w); } }
        } else if (pn == 3) {
            EPI_AM { const unsigned row = ROWG(ai, m);
                if (wc == 0 && fq == 0) stg<float>(ssqkr, row * 4u, s[ai][m][0]);
                if (wc < 2) { stg<f32x4>(kr, row * 256u + c8 * 4u, acc[ai][0][m][0]); stg<f32x4>(kr, row * 256u + c8 * 4u + 16u, acc[ai][0][m][1]); }
                if (wc == 2 && fq == 0) { f32x4 a = acc[ai][0][m][0], b = acc[ai][0][m][1]; const f32x4 b0 = *(const f32x4*)b_f, b1 = *(const f32x4*)(b_f + 4);
#pragma unroll
                    for (int e = 0; e < 4; ++e) { a[e] = log_sigmoidf_(a[e] + b0[e]); b[e] = log_sigmoidf_(b[e] + b1[e]); }
                    stg<f32x4>(logf, row * 32u, a); stg<f32x4>(logf, row * 32u + 16u, b); } }
        } else {
            const int t = pn - 4, seg = t >> 2, hp = t & 3; const bool isv = seg == 2 || seg == 5;
            const f32x4 g0 = ldg<f32x4>(gt, (seg * 128 + c8) * 4u), g1 = ldg<f32x4>(gt, (seg * 128 + c8) * 4u + 16u);
            bf16* dst = hm + (size_t)seg * (8u << 20);
            EPI_AM { const unsigned row = ROWG(ai, m), b = row >> 11, sp = row & 2047u;
                EPI_BJ { const float rh = isv ? 1.0f : rsq(s[ai][m][bj] * (1.0f / 128.0f) + EPS); const unsigned head = hp * 2 + bj;
                    stg<u32x4>(dst, (((b * 8u + head) * SEQ + sp) * 128u + c8) * 2u, pack8(acc[ai][bj][m][0] * rh * g0, acc[ai][bj][m][1] * rh * g1)); } }
        }
    }
};

struct EpiQUp {
    static constexpr bool PERM = true, AFTER_DRAIN = false;
    const float* ssqcq; const float* gq; const float* cosT; const float* sinT; bf16* mq; LAS float* scr;
    __device__ __forceinline__ void operator()(Acc& acc, const Unit& u, int wr, int wc, int fr, int fq) const {
        fresh_lane(fr, fq);
        int row0 = u.pm * 256 + wr * 64 + fr, c8 = wc * 32 + fq * 8;
        asm volatile("" : "+v"(row0), "+v"(c8), "+v"(fq));
        const unsigned head = u.pn;
        float s[2][4][1];
        EPI_AM { const f32x2 p = ldg<f32x2>(ssqcq, ROWG(ai, m) * 8u); const float rs = rsq((p[0] + p[1]) * (1.0f / 512.0f) + EPS);
            EPI_BJ { acc[ai][bj][m][0] *= rs; acc[ai][bj][m][1] *= rs; }
            s[ai][m][0] = (sumsq4(acc[ai][0][m][0]) + sumsq4(acc[ai][0][m][1])) + (sumsq4(acc[ai][1][m][0]) + sumsq4(acc[ai][1][m][1])); }
        xwave_rowsum<1>(s, scr, wr, wc, fr, fq);
        const f32x4 g0 = ldg<f32x4>(gq, c8 * 4u), g1 = ldg<f32x4>(gq, c8 * 4u + 16u);
        const unsigned gi = 4 * (wc & 1) + fq;
        const f32x4 gr1 = ldg<f32x4>(gq, (128 + 4 * gi) * 4u), gr2 = ldg<f32x4>(gq, (160 + 4 * gi) * 4u);
        EPI_AM { const unsigned row = ROWG(ai, m), b = row >> 11, sp = row & 2047u; const float rq = rsq(s[ai][m][0] * (1.0f / 192.0f) + EPS);
            const unsigned d = ((b * 8u + head) * SEQ + sp) * 384u;
            stg<u32x4>(mq, d + c8 * 2u, pack8(acc[ai][0][m][0] * rq * g0, acc[ai][0][m][1] * rq * g1));
            if (wc < 2) { const f32x4 x1 = acc[ai][1][m][0] * rq * gr1, x2 = acc[ai][1][m][1] * rq * gr2;
                const f32x4 c = ldg<f32x4>(cosT, (sp * 32u + 4 * gi) * 4u), sn = ldg<f32x4>(sinT, (sp * 32u + 4 * gi) * 4u);
                stg<u32x4>(mq, d + (128 + 8 * gi) * 2u, pack8(x1 * c - x2 * sn, x1 * sn + x2 * c)); } }
    }
};

struct EpiKvUp {
    static constexpr bool PERM = true, AFTER_DRAIN = false;
    const float* ssqckv; const float* ssqkr; const float* kr; const float* gk; const float* cosT; const float* sinT; bf16* mk; bf16* mv; LAS float* scr;
    __device__ __forceinline__ void operator()(Acc& acc, const Unit& u, int wr, int wc, int fr, int fq) const {
        fresh_lane(fr, fq);
        int row0 = u.pm * 256 + wr * 64 + fr, c8 = wc * 32 + fq * 8;
        asm volatile("" : "+v"(row0), "+v"(c8), "+v"(fq));
        const unsigned head = u.pn;
        float s[2][4][1];
        EPI_AM { const float rs = rsq(ldg<float>(ssqckv, ROWG(ai, m) * 4u) * (1.0f / 256.0f) + EPS);
            EPI_BJ { acc[ai][bj][m][0] *= rs; acc[ai][bj][m][1] *= rs; }
            s[ai][m][0] = sumsq4(acc[ai][0][m][0]) + sumsq4(acc[ai][0][m][1]); }
        xwave_rowsum<1>(s, scr, wr, wc, fr, fq);
        const f32x4 g0 = ldg<f32x4>(gk, c8 * 4u), g1 = ldg<f32x4>(gk, c8 * 4u + 16u);
        const unsigned qi = 4 * wc + fq, i0 = 2 * qi;
        const f32x2 gr1 = ldg<f32x2>(gk, (128 + i0) * 4u), gr2 = ldg<f32x2>(gk, (160 + i0) * 4u);
        const unsigned slot = 128 + 8 * (qi >> 1) + 2 * (qi & 1);
        EPI_AM { const unsigned row = ROWG(ai, m), b = row >> 11, sp = row & 2047u; const float rk = rsq((s[ai][m][0] + ldg<float>(ssqkr, row * 4u)) * (1.0f / 192.0f) + EPS);
            const unsigned tok = (b * 8u + head) * SEQ + sp, dk = tok * 384u;
            stg<u32x4>(mk, dk + c8 * 2u, pack8(acc[ai][0][m][0] * rk * g0, acc[ai][0][m][1] * rk * g1));
            stg<u32x4>(mv, tok * 256u + c8 * 2u, pack8(acc[ai][1][m][0], acc[ai][1][m][1]));
            const f32x2 x1 = ldg<f32x2>(kr, row * 256u + i0 * 4u) * rk * gr1, x2 = ldg<f32x2>(kr, row * 256u + (32 + i0) * 4u) * rk * gr2;
            const f32x2 c = ldg<f32x2>(cosT, (sp * 32u + i0) * 4u), sn = ldg<f32x2>(sinT, (sp * 32u + i0) * 4u);
            const f32x2 o1 = x1 * c - x2 * sn, o2 = x1 * sn + x2 * c;
            stg<unsigned>(mk, dk + slot * 2u, cvt_pk_bf16(o1[0], o1[1])); stg<unsigned>(mk, dk + (slot + 4) * 2u, cvt_pk_bf16(o2[0], o2[1])); }
    }
};

struct EpiBr {
    static constexpr bool PERM = true, AFTER_DRAIN = false;
    const bf16* gates; bf16* merged;
    __device__ __forceinline__ void operator()(Acc& acc, const Unit& u, int wr, int wc, int fr, int fq) const {
        fresh_lane(fr, fq);
        int row0 = u.pm * 256 + wr * 64 + fr, c8 = wc * 32 + fq * 8;
        asm volatile("" : "+v"(row0), "+v"(c8));
        const unsigned z = u.z;
        EPI_AM { const unsigned row = ROWG(ai, m);
            EPI_BJ { const unsigned col = u.pn * 256 + bj * 128 + c8;
                f32x4 ga, gb; unpack8(ldg<u32x4>(gates, row * 12288u + (z * 2048u + col) * 2u), ga, gb);
                f32x4 a = acc[ai][bj][m][0] * ga, b = acc[ai][bj][m][1] * gb;
                const unsigned d = row * 4096u + col * 2u;
                if (z > 0) { f32x4 pa, pb; unpack8(ldg<u32x4>(merged, d), pa, pb); a += pa; b += pb; }
                stg<u32x4>(merged, d, pack8(a, b)); } }
    }
};

struct EpiResid {
    static constexpr bool PERM = false, AFTER_DRAIN = false;
    const float* xin; float* xout; bf16* xb; float* ssqx; LAS float* scr;
    __device__ __forceinline__ void operator()(Acc& acc, const Unit& u, int wr, int wc, int fr, int fq) const {
        fresh_lane(fr, fq);
        int row0 = u.pm * 256 + wr * 64 + fr, c4 = wc * 32 + fq * 4;
        asm volatile("" : "+v"(row0), "+v"(c4), "+v"(fq));
        float s[2][4][1];
        EPI_AM { const unsigned row = ROWG(ai, m); float q = 0.f;
            EPI_BJ {
#pragma unroll
                for (int n = 0; n < 2; ++n) { const unsigned e = row * 2048u + u.pn * 256 + bj * 128 + n * 16 + c4;
                    const f32x4 v = ldg<f32x4>(xin, e * 4u) + acc[ai][bj][m][n];
                    stg<f32x4>(xout, e * 4u, v); q += sumsq4(v);
                    u32x2 w; w.x = cvt_pk_bf16(v[0], v[1]); w.y = cvt_pk_bf16(v[2], v[3]); stg<u32x2>(xb, e * 2u, w); } }
            s[ai][m][0] = q; }
        xwave_rowsum<1>(s, scr, wr, wc, fr, fq);
        if (wc == 0 && fq == 0) { EPI_AM { stg<float>(ssqx, ROWG(ai, m) * 32u + u.pn * 4u, s[ai][m][0]); } }
    }
};

struct EpiHeadNorm {
    static constexpr bool PERM = true, AFTER_DRAIN = false;
    const float* ssq8;
    const float* rstd1;
    const float* gg; bf16* dk; bf16* dv; int nk_tiles, rows_per_b, lg_rows_per_b; LAS float* scr;
    __device__ __forceinline__ void operator()(Acc& acc, const Unit& u, int wr, int wc, int fr, int fq) const {
        fresh_lane(fr, fq);
        int row0 = u.pm * 256 + wr * 64 + fr, c8 = wc * 32 + fq * 8;
        asm volatile("" : "+v"(row0), "+v"(c8), "+v"(fq));
        const int pn = u.pn;
        EPI_AM { const unsigned row = ROWG(ai, m); const float rs = ssq8 ? rstd8(ssq8, row) : ldg<float>(rstd1, row * 4u);
            EPI_BJ { acc[ai][bj][m][0] *= rs; acc[ai][bj][m][1] *= rs; } }
        const bool isk = pn < nk_tiles;
        if (isk) {
            float s[2][4][2];
            EPI_AM { EPI_BJ { s[ai][m][bj] = sumsq4(acc[ai][bj][m][0]) + sumsq4(acc[ai][bj][m][1]); } }
            xwave_rowsum<2>(s, scr, wr, wc, fr, fq);
            const f32x4 g0 = ldg<f32x4>(gg, c8 * 4u), g1 = ldg<f32x4>(gg, c8 * 4u + 16u);
            EPI_AM { EPI_BJ { const float rh = rsq(s[ai][m][bj] * (1.0f / 128.0f) + EPS); acc[ai][bj][m][0] = acc[ai][bj][m][0] * rh * g0; acc[ai][bj][m][1] = acc[ai][bj][m][1] * rh * g1; } }
        }
        bf16* dst = isk ? dk : dv; const unsigned hp = isk ? pn : pn - nk_tiles;
        EPI_AM { const unsigned row = ROWG(ai, m), b = row >> lg_rows_per_b, sp = row & (unsigned)(rows_per_b - 1);
            EPI_BJ { const unsigned head = hp * 2 + bj; stg<u32x4>(dst, (((b * 4u + head) * rows_per_b + sp) * 128u + c8) * 2u, pack8(acc[ai][bj][m][0], acc[ai][bj][m][1])); } }
    }
};

struct EpiMlp1 {
    static constexpr bool PERM = true, AFTER_DRAIN = false;
    const float* ssqx; bf16* h;
    __device__ __forceinline__ void operator()(Acc& acc, const Unit& u, int wr, int wc, int fr, int fq) const {
        fresh_lane(fr, fq);
        int row0 = u.pm * 256 + wr * 64 + fr, c8 = wc * 32 + fq * 8;
        asm volatile("" : "+v"(row0), "+v"(c8));
        EPI_AM { const unsigned row = ROWG(ai, m); const float rs = rstd8(ssqx, row);
            EPI_BJ { f32x4 a = acc[ai][bj][m][0] * rs, b = acc[ai][bj][m][1] * rs;
#pragma unroll
                for (int e = 0; e < 4; ++e) { a[e] = fmaxf(a[e], 0.f); a[e] *= a[e]; b[e] = fmaxf(b[e], 0.f); b[e] *= b[e]; }
                stg<u32x4>(h, row * 16384u + (u.pn * 256 + bj * 128 + c8) * 2u, pack8(a, b)); } }
    }
};

#define XB_TMO      128
#define XB_XCNT(j)  (256  + 64 * (j))
#define XB_XSUB(j)  (1280 + 64 * (j))
#define XB_XGEN(j)  (2304 + 64 * (j))
#define XB_TOP      3328
#define XB_TOPGEN   3392
#define XCD_BAR_WORDS 3456
#define XB_SPIN_CAP (1u << 18)
__device__ __forceinline__ unsigned xb_ld(unsigned* p)              { return __hip_atomic_load(p, __ATOMIC_RELAXED, __HIP_MEMORY_SCOPE_AGENT); }
__device__ __forceinline__ unsigned xb_add(unsigned* p, unsigned v) { return __hip_atomic_fetch_add(p, v, __ATOMIC_RELAXED, __HIP_MEMORY_SCOPE_AGENT); }
__device__ __forceinline__ unsigned xb_xcc_id() { return (unsigned)__builtin_amdgcn_s_getreg((3 << 11) | 20) & 0xFu; }
#define XB_SPIN(cond, bar) do { unsigned _sp = 0; while (cond) { __builtin_amdgcn_s_sleep(1); \
    if ((++_sp & 255u) == 0u) { if (xb_ld(&(bar)[XB_TMO])) break; if (_sp > XB_SPIN_CAP) { atomicAdd(&(bar)[XB_TMO], 1u); break; } } } } while (0)
struct XcdBarrier { unsigned* bar; unsigned x; volatile LAS unsigned* st; };
__device__ __forceinline__ XcdBarrier xcd_barrier_post(unsigned* bar, volatile LAS unsigned* st) {
    XcdBarrier b; b.bar = bar; b.x = xb_xcc_id(); b.st = st;
    if (threadIdx.x == 0) (void)xb_add(&bar[XB_XCNT(b.x)], 1u);
    return b;
}
__device__ __forceinline__ void xcd_barrier_complete(unsigned* bar, unsigned x, unsigned& nloc, unsigned& nx) {
    const unsigned G = gridDim.x * gridDim.y * gridDim.z;
    unsigned sum, cnt, mine, sp = 0u;
    for (;;) {
        sum = 0u; cnt = 0u; mine = 0u;
#pragma unroll
        for (unsigned j = 0; j < 16; ++j) { const unsigned c = xb_ld(&bar[XB_XCNT(j)]); sum += c; cnt += (c > 0u) ? 1u : 0u; mine = (j == x) ? c : mine; }
        if (sum == G) break;
        __builtin_amdgcn_s_sleep(1);
        if ((++sp & 255u) == 0u) { if (xb_ld(&bar[XB_TMO])) break; if (sp > XB_SPIN_CAP) { atomicAdd(&bar[XB_TMO], 1u); break; } }
    }
    nloc = mine > 0u ? mine : 1u; nx = cnt > 0u ? cnt : 1u;
}
__device__ __forceinline__ void xcd_barrier(const XcdBarrier& b) {
    asm volatile("s_waitcnt vmcnt(0)" ::: "memory");
    __syncthreads();
    if (threadIdx.x == 0) {
        unsigned* bar = b.bar;
        __builtin_amdgcn_s_waitcnt(0);
        unsigned nloc = b.st[0], nx = b.st[1];
        if (nloc == 0u) { xcd_barrier_complete(bar, b.x, nloc, nx); b.st[0] = nloc; b.st[1] = nx; }
        const unsigned old = xb_add(&bar[XB_XSUB(b.x)], 1u);
        const unsigned gen = old / nloc;
        if (old + 1u == (gen + 1u) * nloc) {
            __builtin_amdgcn_fence(__ATOMIC_RELEASE, "agent");
            asm volatile("s_waitcnt vmcnt(0)" ::: "memory");
            const unsigned og = xb_add(&bar[XB_TOP], 1u);
            const unsigned tg = og / nx;
            if (og + 1u == (tg + 1u) * nx) xb_add(&bar[XB_TOPGEN], 1u);
            else XB_SPIN(xb_ld(&bar[XB_TOPGEN]) == tg, bar);
            __builtin_amdgcn_fence(__ATOMIC_ACQUIRE, "agent");
            xb_add(&bar[XB_XGEN(b.x)], 1u);
            asm volatile("s_waitcnt vmcnt(0)" ::: "memory");
        } else {
            XB_SPIN(xb_ld(&bar[XB_XGEN(b.x)]) == gen, bar);
            __builtin_amdgcn_fence(__ATOMIC_ACQUIRE, "agent");
            asm volatile("s_waitcnt vmcnt(0)" ::: "memory");
        }
    }
    __syncthreads();
}

constexpr int NWAVES = 8;
__device__ __forceinline__ float wave_sum(float v) {
#pragma unroll
    for (int o = 1; o < 64; o <<= 1) v += __shfl_xor(v, o);
    return v;
}
__device__ __forceinline__ int colmap_inproj(int n) { if (n < 832) return n; if (n < 840) return 3904 + (n - 832); if (n < 1024) return -1; if (n < 4096) return n - 192; return n - 184; }
__device__ __forceinline__ int colmap_uq(int n) { const int h = n >> 8, j = n & 255; if (j < 128) return h * 192 + j; if (j >= 192) return -1;
    const int p = j - 128, g = p >> 3, w = p & 7; return h * 192 + 128 + (w < 4 ? 4 * g + w : 32 + 4 * g + (w - 4)); }
template <int MAP> __device__ __forceinline__ void transpose_item(const float* W, int K, int Nsrc, const float* gk, bf16* WT, int nblk, LAS float* scr, int item, int lane) {
    const int kb = item / nblk, nb = item % nblk, k0 = 64 * kb, n0 = 32 * nb;
    const int nd = n0 + (lane & 31); const int ns = MAP == 0 ? nd : MAP == 1 ? colmap_inproj(nd) : colmap_uq(nd);
#pragma unroll 8
    for (int i = 0; i < 32; ++i) { const int kk = 2 * i + (lane >> 5); float v = 0.f; if (ns >= 0) { v = W[(size_t)(k0 + kk) * Nsrc + ns]; if (gk) v *= gk[k0 + kk]; } scr[kk * 33 + (lane & 31)] = v; }
    LDS_WAIT(); asm volatile("" ::: "memory");
    const int c = lane & 7;
#pragma unroll
    for (int j = 0; j < 4; ++j) { const int n = (lane >> 3) + 8 * j; const LAS float* s = scr + (8 * c) * 33 + n;
        u32x4 o; o.x = cvt_pk_bf16(s[0 * 33], s[1 * 33]); o.y = cvt_pk_bf16(s[2 * 33], s[3 * 33]); o.z = cvt_pk_bf16(s[4 * 33], s[5 * 33]); o.w = cvt_pk_bf16(s[6 * 33], s[7 * 33]);
        *(u32x4*)(WT + (size_t)(n0 + n) * K + k0 + 8 * c) = o; }
    LDS_WAIT(); asm volatile("" ::: "memory");
}
__device__ __forceinline__ float row_to_bf16(const float* xrow, bf16* orow, int lane) {
    f32x4 v[8]; float s = 0.f;
#pragma unroll
    for (int j = 0; j < 8; ++j) { v[j] = ((const f32x4*)xrow)[lane + 64 * j]; s += sumsq4(v[j]); }
#pragma unroll
    for (int j = 0; j < 8; ++j) { u32x2 w; w.x = cvt_pk_bf16(v[j][0], v[j][1]); w.y = cvt_pk_bf16(v[j][2], v[j][3]); ((u32x2*)orow)[lane + 64 * j] = w; }
    return wave_sum(s);
}

struct Args { const float* in[N_IN]; float* out; unsigned char* ws; int g_lo, g_hi; };
constexpr size_t in_stride(int k) {
    return k == IG_MIX ? 2048 : k == IW_IN ? (size_t)2048 * DIN_SRC : k == IG_CQ ? 512 : k == IW_UQ ? (size_t)512 * 1536 : k == IG_CKV ? 256 : k == IW_UKV ? (size_t)256 * 2048 :
           k == IG_MLAQ ? 192 : k == IG_MLAK ? 192 : k == IB_F ? 8 : k == IG_FOXQ ? 128 : k == IG_FOXK ? 128 : k == IRELB ? 8 * 257 : k == IG_CHQ ? 128 : k == IG_CHK ? 128 :
           k == IW_BR ? (size_t)3 * 1024 * 2048 : k == IW_OUT ? (size_t)2048 * 2048 : k == IG_CROSS ? 2048 : k == IG_MEM ? 2048 : k == IW_XQ ? (size_t)2048 * 512 :
           k == IW_XKV ? (size_t)2048 * 1024 : k == IG_XQ ? 128 : k == IG_XK ? 128 : k == IW_XO ? (size_t)512 * 2048 : k == IG_MLP ? 2048 : k == IW_1 ? (size_t)2048 * 8192 :
           k == IW_2 ? (size_t)8192 * 2048 : 0;
}
#define LIN(k, l) (args.in[k] + (size_t)(l) * in_stride(k))

__device__ __forceinline__ void prologue(const Args& args, LAS unsigned char* lds, int lane, int wave) {
    unsigned char* ws = args.ws;
    LAS float* scr = (LAS float*)(lds + wave * 16384);
    const int gw = blockIdx.x * NWAVES + wave, NGW = gridDim.x * NWAVES;
    constexpr int I_IN = (2048 / 64) * (NIN / 32), I_UQ = (512 / 64) * (2048 / 32), I_UKV = (256 / 64) * (2048 / 32), I_BR1 = (1024 / 64) * (2048 / 32), I_OUT = (2048 / 64) * (2048 / 32),
                  I_XQ = (2048 / 64) * (512 / 32), I_XKV = (2048 / 64) * (1024 / 32), I_XO = (512 / 64) * (2048 / 32), I_1 = (2048 / 64) * (8192 / 32), I_2 = (8192 / 64) * (2048 / 32);
    constexpr int I_LAYER = I_IN + I_UQ + I_UKV + 3 * I_BR1 + I_OUT + I_XQ + I_XKV + I_XO + I_1 + I_2;
    for (int it = gw; it < NL * I_LAYER; it += NGW) {
        const int l = it / I_LAYER; int r = it % I_LAYER;
        unsigned char* wl = ws + WS_W + (size_t)l * W_LAYER;
        if (r < I_IN) { transpose_item<1>(LIN(IW_IN, l), 2048, DIN_SRC, LIN(IG_MIX, l), (bf16*)(wl + WO_IN), NIN / 32, scr, r, lane); continue; } r -= I_IN;
        if (r < I_UQ) { transpose_item<2>(LIN(IW_UQ, l), 512, 1536, LIN(IG_CQ, l), (bf16*)(wl + WO_UQ), 2048 / 32, scr, r, lane); continue; } r -= I_UQ;
        if (r < I_UKV) { transpose_item<0>(LIN(IW_UKV, l), 256, 2048, LIN(IG_CKV, l), (bf16*)(wl + WO_UKV), 2048 / 32, scr, r, lane); continue; } r -= I_UKV;
        if (r < 3 * I_BR1) { const int z = r / I_BR1; transpose_item<0>(LIN(IW_BR, l) + (size_t)z * 1024 * 2048, 1024, 2048, nullptr, (bf16*)(wl + WO_BR) + (size_t)z * 2048 * 1024, 2048 / 32, scr, r % I_BR1, lane); continue; } r -= 3 * I_BR1;
        if (r < I_OUT) { transpose_item<0>(LIN(IW_OUT, l), 2048, 2048, nullptr, (bf16*)(wl + WO_OUT), 2048 / 32, scr, r, lane); continue; } r -= I_OUT;
        if (r < I_XQ) { transpose_item<0>(LIN(IW_XQ, l), 2048, 512, LIN(IG_CROSS, l), (bf16*)(wl + WO_XQ), 512 / 32, scr, r, lane); continue; } r -= I_XQ;
        if (r < I_XKV) { transpose_item<0>(LIN(IW_XKV, l), 2048, 1024, LIN(IG_MEM, l), (bf16*)(wl + WO_XKV), 1024 / 32, scr, r, lane); continue; } r -= I_XKV;
        if (r < I_XO) { transpose_item<0>(LIN(IW_XO, l), 512, 2048, nullptr, (bf16*)(wl + WO_XO), 2048 / 32, scr, r, lane); continue; } r -= I_XO;
        if (r < I_1) { transpose_item<0>(LIN(IW_1, l), 2048, 8192, LIN(IG_MLP, l), (bf16*)(wl + WO_1), 8192 / 32, scr, r, lane); continue; } r -= I_1;
        transpose_item<0>(LIN(IW_2, l), 8192, 2048, nullptr, (bf16*)(wl + WO_2), 2048 / 32, scr, r, lane);
    }
    for (int m = gw; m < T; m += NGW) { const float s = row_to_bf16(args.in[IX] + (size_t)m * DM, (bf16*)(ws + WS_XB) + (size_t)m * DM, lane);
        if (lane < 8) ((float*)(ws + WS_SSQX))[(size_t)m * 8 + lane] = lane == 0 ? s : 0.f; }
    for (int m = gw; m < NBATCH * 256; m += NGW) { const float s = row_to_bf16(args.in[IMEM] + (size_t)m * DM, (bf16*)(ws + WS_MEMB) + (size_t)m * DM, lane);
        if (lane == 0) ((float*)(ws + WS_RSTDMEM))[m] = rsq(s * (1.0f / DM) + EPS); }
    for (int e = gw * 64 + lane; e < NL * 768; e += NGW * 64) { const int l = e / 768, k = (e % 768) >> 7, c = e & 127;
        ((float*)(ws + WS_GT))[e] = k == 0 ? LIN(IG_FOXQ, l)[c] : k == 1 ? LIN(IG_FOXK, l)[c] : k == 3 ? LIN(IG_CHQ, l)[c] : k == 4 ? LIN(IG_CHK, l)[c] : 1.0f; }
    for (int e = gw * 64 + lane; e < SEQ * 32; e += NGW * 64) { const int pos = e >> 5, i = e & 31;
        const float inv = exp2f(-(float)i * (13.287712379549449f / 32.0f)); const float ang = (float)pos * inv;
        ((float*)(ws + WS_COS))[e] = cosf(ang); ((float*)(ws + WS_SIN))[e] = sinf(ang); }
}

__device__ __forceinline__ void cumsum_phase(const float* logf, float* cum, int lane, int wave) {
    const int gw = blockIdx.x * NWAVES + wave;
    if (gw >= NBATCH * 8) return;
    const int b = gw >> 3, h = gw & 7;
    float v[32]; float run = 0.f;
#pragma unroll
    for (int j = 0; j < 32; ++j) { run += logf[((size_t)b * SEQ + lane * 32 + j) * 8 + h]; v[j] = run; }
    float incl = run;
#pragma unroll
    for (int o = 1; o < 64; o <<= 1) { const float t = __shfl_up(incl, o); if (lane >= o) incl += t; }
    const float excl = incl - run;
#pragma unroll
    for (int j = 0; j < 32; ++j) cum[((size_t)b * 8 + h) * SEQ + lane * 32 + j] = v[j] + excl;
}

struct AttnS { const bf16* Q; const bf16* K; const bf16* V; bf16* O; int mode, DK, NH, SK, ldo; const float* cum; const float* relb; };
__device__ __forceinline__ void attn_simple_unit(const AttnS& A, int b, int h, int qt, LAS unsigned char* lds, int tid) {
    const int DK = A.DK, DKP = DK + 1, KP = DK + 2;
    LAS float* qs = (LAS float*)lds;
    LAS bf16* Ks = (LAS bf16*)(lds + 64 * 193 * 4);
    LAS bf16* Vs = (LAS bf16*)(lds + 64 * 193 * 4 + 64 * 194 * 2);
    LAS float* Ps = (LAS float*)(lds + 64 * 193 * 4 + 64 * 194 * 2 + 64 * 130 * 2);
    const int r = tid >> 3, sub = tid & 7;
    const float scale = rsqrtf((float)DK);
    const size_t qbase = ((size_t)(b * A.NH + h) * SEQ + qt * 64) * DK, kvbase = (size_t)(b * A.NH + h) * A.SK;
    __syncthreads();
    for (int e = tid; e < 64 * DK; e += 512) { const int rr = e / DK, d = e % DK; qs[rr * DKP + d] = bf2f(A.Q[qbase + e]) * scale; }
    const int qpos = qt * 64 + r;
    float m_run = -3.0e38f, l_run = 0.f; float o[16];
#pragma unroll
    for (int d = 0; d < 16; ++d) o[d] = 0.f;
    int j_lo = 0, j_hi = qt + 1;
    if (A.mode == 2) j_lo = qt > 8 ? qt - 8 : 0;
    if (A.mode == 3) { j_lo = 0; j_hi = A.SK / 64; }
    const float cq = A.mode == 1 ? A.cum[(size_t)(b * 8 + h) * SEQ + qpos] : 0.f;
    for (int j = j_lo; j < j_hi; ++j) {
        __syncthreads();
        for (int e = tid; e < 64 * DK; e += 512) { const int kk = e / DK, d = e % DK; Ks[kk * KP + d] = A.K[(kvbase + j * 64 + kk) * DK + d]; }
        for (int e = tid; e < 64 * 128; e += 512) { const int kk = e >> 7, d = e & 127; Vs[kk * 130 + d] = A.V[(kvbase + j * 64 + kk) * 128 + d]; }
        __syncthreads();
        float sc[8]; float tmax = -3.0e38f;
#pragma unroll
        for (int kk = 0; kk < 8; ++kk) { const int key = sub + 8 * kk; float s = 0.f;
            for (int d = 0; d < DK; d += 2) { const unsigned w = *(const LAS unsigned*)(Ks + key * KP + d); s += qs[r * DKP + d] * bf_lo(w) + qs[r * DKP + d + 1] * bf_hi(w); }
            const int kpos = j * 64 + key; bool ok = true;
            if (A.mode == 1) { ok = kpos <= qpos; s += cq - A.cum[(size_t)(b * 8 + h) * SEQ + kpos]; }
            if (A.mode == 2) { int rel = qpos - kpos; rel = rel < -128 ? -128 : rel > 128 ? 128 : rel; s += A.relb[h * 257 + rel + 128]; }
            s = ok ? s : -1.0e30f; sc[kk] = s; tmax = fmaxf(tmax, s); }
        tmax = fmaxf(tmax, __shfl_xor(tmax, 1)); tmax = fmaxf(tmax, __shfl_xor(tmax, 2)); tmax = fmaxf(tmax, __shfl_xor(tmax, 4));
        const float m_new = fmaxf(m_run, tmax), alpha = __expf(m_run - m_new); float ps = 0.f;
#pragma unroll
        for (int kk = 0; kk < 8; ++kk) { const float p = __expf(sc[kk] - m_new); ps += p; Ps[r * 65 + sub + 8 * kk] = p; }
        ps += __shfl_xor(ps, 1); ps += __shfl_xor(ps, 2); ps += __shfl_xor(ps, 4);
        l_run = l_run * alpha + ps; m_run = m_new;
        __syncthreads();
#pragma unroll
        for (int d = 0; d < 16; ++d) o[d] *= alpha;
        for (int key = 0; key < 64; ++key) { const float p = Ps[r * 65 + key];
#pragma unroll
            for (int d = 0; d < 16; d += 2) { const unsigned w = *(const LAS unsigned*)(Vs + key * 130 + sub * 16 + d); o[d] += p * bf_lo(w); o[d + 1] += p * bf_hi(w); } }
    }
    const float il = 1.0f / l_run;
    bf16* op = A.O + (size_t)(b * SEQ + qt * 64 + r) * A.ldo + h * 128 + sub * 16;
    u32x4 w0, w1; w0.x = cvt_pk_bf16(o[0] * il, o[1] * il); w0.y = cvt_pk_bf16(o[2] * il, o[3] * il); w0.z = cvt_pk_bf16(o[4] * il, o[5] * il); w0.w = cvt_pk_bf16(o[6] * il, o[7] * il);
    w1.x = cvt_pk_bf16(o[8] * il, o[9] * il); w1.y = cvt_pk_bf16(o[10] * il, o[11] * il); w1.z = cvt_pk_bf16(o[12] * il, o[13] * il); w1.w = cvt_pk_bf16(o[14] * il, o[15] * il);
    *(u32x4*)op = w0; *(u32x4*)(op + 8) = w1;
}

constexpr int NPH = 10;
constexpr int NPHASE = 1 + NL * NPH;
__global__ void __launch_bounds__(NWAVES * 64, 2) fwd_kernel(Args args) {
    extern __shared__ __attribute__((aligned(16))) unsigned char lds_raw[];
    LAS unsigned char* lds = (LAS unsigned char*)lds_raw;
    volatile LAS unsigned* MISC = (volatile LAS unsigned*)(lds + MISC_OFF);
    const int tid0 = threadIdx.x, wave = __builtin_amdgcn_readfirstlane(tid0 >> 6);
    const int G = gridDim.x, bx = blockIdx.x;
    unsigned char* const ws0 = args.ws;
    unsigned* ctl = (unsigned*)(ws0 + WS_CTL);
    for (int u = tid0; u < 256; u += NWAVES * 64) MISC[u] = 0u;
    __syncthreads();
#if MK_PER_PHASE
#define SEAM(g) do { } while (0)
#else
    XcdBarrier bar = xcd_barrier_post(ctl + 4096, MISC + 8);
#define SEAM(g) do { if ((g) + 1 < g_hi) xcd_barrier(bar); } while (0)
#endif
    const int g_lo = args.g_lo, g_hi = args.g_hi;
#ifndef PH_MASK
#define PH_MASK 0x7ff
#endif
#define IN(g) (g_lo <= (g) && (g) < g_hi)
    LAS float* escr = (LAS float*)(lds + ESCR_OFF);

    if ((PH_MASK & 1) && IN(0)) { prologue(args, lds, tid0 & 63, wave); SEAM(0); }

#define OPAQUE_PTRS() unsigned char* ws = ws0; asm volatile("" : "+s"(ws)); int tid = tid0; asm volatile("" : "+v"(tid)); const int lane = tid & 63; (void)lane; unsigned char* wl = ws + WS_W + (size_t)l * W_LAYER; float* ssqx = (float*)(ws + WS_SSQX); bf16* xb = (bf16*)(ws + WS_XB); \
    const float* cosT = (const float*)(ws + WS_COS); const float* sinT = (const float*)(ws + WS_SIN); (void)wl; (void)ssqx; (void)xb; (void)cosT; (void)sinT
    for (int l = 0; l < NL; ++l) {
        const int gb = 1 + l * NPH;
        if ((PH_MASK & 2) && IN(gb + 0)) {
            OPAQUE_PTRS();
            pg8::Gemm g{xb, (const bf16*)(wl + WO_IN), T, NIN, 2048, 0, 0}; pg8::StaticOrder S; S.init(T, NIN, G, bx);
            EpiInProj E{ssqx, (bf16*)(ws + WS_CQ), (float*)(ws + WS_SSQCQ), (bf16*)(ws + WS_CKV), (float*)(ws + WS_SSQCKV), (float*)(ws + WS_KR), (float*)(ws + WS_SSQKR),
                        (float*)(ws + WS_LOGF), LIN(IB_F, l), (bf16*)(ws + WS_FQ), (const float*)(ws + WS_GT) + l * 768, (bf16*)(ws + WS_GATES), escr};
            pg8::gemm_phase<EpiInProj, pg8::StaticOrder, true, true>(lds, g, S, E);
            SEAM(gb + 0);
        }
        if ((PH_MASK & 4) && IN(gb + 1)) {
            OPAQUE_PTRS();
#ifndef P1MASK
#define P1MASK 7
#endif
            if (P1MASK & 1) { pg8::Gemm g{(const bf16*)(ws + WS_CQ), (const bf16*)(wl + WO_UQ), T, 2048, 512, 0, 0}; pg8::StaticOrder S; S.init(T, 2048, G, bx);
              EpiQUp E{(const float*)(ws + WS_SSQCQ), LIN(IG_MLAQ, l), cosT, sinT, (bf16*)(ws + WS_MQ), escr};
              pg8::gemm_phase<EpiQUp, pg8::StaticOrder, true, true>(lds, g, S, E); }
            if (P1MASK & 2) { pg8::Gemm g{(const bf16*)(ws + WS_CKV), (const bf16*)(wl + WO_UKV), T, 2048, 256, 0, 0}; pg8::StaticOrder S; S.init(T, 2048, G, bx);
              EpiKvUp E{(const float*)(ws + WS_SSQCKV), (const float*)(ws + WS_SSQKR), (const float*)(ws + WS_KR), LIN(IG_MLAK, l), cosT, sinT, (bf16*)(ws + WS_MK), (bf16*)(ws + WS_MV), escr + 2048};
              pg8::gemm_phase<EpiKvUp, pg8::StaticOrder, true, true>(lds, g, S, E); }
            if (P1MASK & 4) cumsum_phase((const float*)(ws + WS_LOGF), (float*)(ws + WS_CUM), lane, wave);
            SEAM(gb + 1);
        }
        if ((PH_MASK & 8) && IN(gb + 2)) {
            OPAQUE_PTRS();
            for (int it = bx; it < 3 * NBATCH * 8 * 32; it += G) {
                const int br = it / (NBATCH * 8 * 32), r = it % (NBATCH * 8 * 32), b = r / (8 * 32), h = (r / 32) % 8, qt = 31 - (r % 32);
                AttnS A;
                if (br == 0) A = AttnS{(const bf16*)(ws + WS_MQ), (const bf16*)(ws + WS_MK), (const bf16*)(ws + WS_MV), (bf16*)(ws + WS_Y), 0, 192, 8, SEQ, 1024, nullptr, nullptr};
                else if (br == 1) A = AttnS{(const bf16*)(ws + WS_FQ), (const bf16*)(ws + WS_FK), (const bf16*)(ws + WS_FV), (bf16*)(ws + WS_Y) + (size_t)T * 1024, 1, 128, 8, SEQ, 1024, (const float*)(ws + WS_CUM), nullptr};
                else A = AttnS{(const bf16*)(ws + WS_CHQ), (const bf16*)(ws + WS_CHK), (const bf16*)(ws + WS_CHV), (bf16*)(ws + WS_Y) + (size_t)2 * T * 1024, 2, 128, 8, SEQ, 1024, nullptr, LIN(IRELB, l)};
                attn_simple_unit(A, b, h, qt, lds, tid);
            }
            __syncthreads();
            SEAM(gb + 2);
        }
        if ((PH_MASK & 16) && IN(gb + 3)) {
            OPAQUE_PTRS();
            pg8::Gemm g{(const bf16*)(ws + WS_Y), (const bf16*)(wl + WO_BR), T, 2048, 1024, (size_t)T * 1024 * 2, (size_t)2048 * 1024 * 2}; pg8::ZOrder<3> S; S.init(T, 2048, G, bx);
            EpiBr E{(const bf16*)(ws + WS_GATES), (bf16*)(ws + WS_MERGED)};
            pg8::gemm_phase<EpiBr, pg8::ZOrder<3>, true, true>(lds, g, S, E);
            SEAM(gb + 3);
        }
        if ((PH_MASK & 32) && IN(gb + 4)) {
            OPAQUE_PTRS();
            pg8::Gemm g{(const bf16*)(ws + WS_MERGED), (const bf16*)(wl + WO_OUT), T, 2048, 2048, 0, 0}; pg8::StaticOrder S; S.init(T, 2048, G, bx);
            EpiResid E{l == 0 ? args.in[IX] : args.out, args.out, xb, ssqx, escr};
            pg8::gemm_phase<EpiResid, pg8::StaticOrder, true, true>(lds, g, S, E);
            SEAM(gb + 4);
        }
        if ((PH_MASK & 64) && IN(gb + 5)) {
            OPAQUE_PTRS();
            { pg8::Gemm g{xb, (const bf16*)(wl + WO_XQ), T, 512, 2048, 0, 0}; pg8::StaticOrder S; S.init(T, 512, G, bx);
              EpiHeadNorm E{ssqx, nullptr, LIN(IG_XQ, l), (bf16*)(ws + WS_XQ), nullptr, 2, SEQ, 11, escr};
              pg8::gemm_phase<EpiHeadNorm, pg8::StaticOrder, true, true>(lds, g, S, E); }
            { pg8::Gemm g{(const bf16*)(ws + WS_MEMB), (const bf16*)(wl + WO_XKV), NBATCH * 256, 1024, 2048, 0, 0}; pg8::StaticOrder S; S.init(NBATCH * 256, 1024, G, (bx + G - 64) % G);
              EpiHeadNorm E{nullptr, (const float*)(ws + WS_RSTDMEM), LIN(IG_XK, l), (bf16*)(ws + WS_XK), (bf16*)(ws + WS_XV), 2, 256, 8, escr + 2048};
              pg8::gemm_phase<EpiHeadNorm, pg8::StaticOrder, true, true>(lds, g, S, E); }
            SEAM(gb + 5);
        }
        if ((PH_MASK & 128) && IN(gb + 6)) {
            OPAQUE_PTRS();
            for (int it = bx; it < NBATCH * 4 * 32; it += G) {
                const int b = it / (4 * 32), h = (it / 32) % 4, qt = it % 32;
                const AttnS A{(const bf16*)(ws + WS_XQ), (const bf16*)(ws + WS_XK), (const bf16*)(ws + WS_XV), (bf16*)(ws + WS_OX), 3, 128, 4, 256, 512, nullptr, nullptr};
                attn_simple_unit(A, b, h, qt, lds, tid);
            }
            __syncthreads();
            SEAM(gb + 6);
        }
        if ((PH_MASK & 256) && IN(gb + 7)) {
            OPAQUE_PTRS();
            pg8::Gemm g{(const bf16*)(ws + WS_OX), (const bf16*)(wl + WO_XO), T, 2048, 512, 0, 0}; pg8::StaticOrder S; S.init(T, 2048, G, bx);
            EpiResid E{args.out, args.out, xb, ssqx, escr};
            pg8::gemm_phase<EpiResid, pg8::StaticOrder, true, true>(lds, g, S, E);
            SEAM(gb + 7);
        }
        if ((PH_MASK & 512) && IN(gb + 8)) {
            OPAQUE_PTRS();
            pg8::Gemm g{xb, (const bf16*)(wl + WO_1), T, FF, 2048, 0, 0}; pg8::StaticOrder S; S.init(T, FF, G, bx);
            EpiMlp1 E{ssqx, (bf16*)(ws + WS_H)};
            pg8::gemm_phase<EpiMlp1, pg8::StaticOrder, true, true>(lds, g, S, E);
            SEAM(gb + 8);
        }
        if ((PH_MASK & 1024) && IN(gb + 9)) {
            OPAQUE_PTRS();
            pg8::Gemm g{(const bf16*)(ws + WS_H), (const bf16*)(wl + WO_2), T, 2048, FF, 0, 0}; pg8::StaticOrder S; S.init(T, 2048, G, bx);
            EpiResid E{args.out, args.out, xb, ssqx, escr};
            pg8::gemm_phase<EpiResid, pg8::StaticOrder, true, true>(lds, g, S, E);
            SEAM(gb + 9);
        }
    }
#undef IN
#undef SEAM
}

extern "C" void kernel_launch(void* const* d_in, const int* in_sizes, int n_in, void* d_out, int out_size, void* d_ws, size_t ws_size, hipStream_t stream) {
    static int grid = 0;
    if (grid == 0) {
        if (n_in != N_IN || in_sizes[0] != T * DM || out_size != T * DM || ws_size < WS_END) { fprintf(stderr, "kernel_launch: unexpected shapes (n_in %d, in0 %d, out %d, ws %zu < %zu)\n", n_in, n_in > 0 ? in_sizes[0] : -1, out_size, ws_size, (size_t)WS_END); grid = -1; return; }
        int dev = 0, cus = 0, per_cu = 0;
        if (hipGetDevice(&dev) != hipSuccess || hipDeviceGetAttribute(&cus, hipDeviceAttributeMultiprocessorCount, dev) != hipSuccess) { grid = -1; return; }
        if (hipFuncSetAttribute((const void*)fwd_kernel, hipFuncAttributeMaxDynamicSharedMemorySize, LDS_BYTES) != hipSuccess) { fprintf(stderr, "kernel_launch: hipFuncSetAttribute failed\n"); grid = -1; return; }
        if (hipOccupancyMaxActiveBlocksPerMultiprocessor(&per_cu, (const void*)fwd_kernel, NWAVES * 64, LDS_BYTES) != hipSuccess || per_cu < 1) fprintf(stderr, "kernel_launch: occupancy query reports %d\n", per_cu);
        (void)hipGetLastError();
        grid = cus;
    }
    if (grid < 0) return;
    if (hipMemsetAsync((char*)d_ws + WS_CTL, 0, CTL_ZERO_BYTES, stream) != hipSuccess) return;
    Args a{};
    for (int i = 0; i < N_IN; ++i) a.in[i] = (const float*)d_in[i];
    a.out = (float*)d_out; a.ws = (unsigned char*)d_ws;
#if MK_PER_PHASE
    for (int g = 0; g < NPHASE; ++g) { a.g_lo = g; a.g_hi = g + 1; hipLaunchKernelGGL(fwd_kernel, dim3(grid), dim3(NWAVES * 64), LDS_BYTES, stream, a); }
#else
    a.g_lo = 0; a.g_hi = NPHASE;
    hipLaunchKernelGGL(fwd_kernel, dim3(grid), dim3(NWAVES * 64), LDS_BYTES, stream, a);
#endif
    const hipError_t le = hipPeekAtLastError();
    if (le != hipSuccess) fprintf(stderr, "kernel_launch: launch failed: %s\n", hipGetErrorName(le));
}
```

```cpp
#include <hip/hip_runtime.h>
#include <cstdio>
#include <cstdint>

#ifndef MK_PER_PHASE
#define MK_PER_PHASE 0
#endif

#ifndef ATTN_SIMPLE
#define ATTN_SIMPLE 0
#endif

namespace pg8 {
#define PG8_LAS __attribute__((address_space(3)))
typedef unsigned short bf16_t;
typedef short bf16x8 __attribute__((ext_vector_type(8)));
typedef float f32x4 __attribute__((ext_vector_type(4)));
typedef unsigned u32x4 __attribute__((ext_vector_type(4)));
constexpr int BM = 256, BK = 64, HALF = 128, HTB = HALF * BK * 2  , STAGE_BYTES = 8 * HTB, NXCD = 8, WGM = 8;

__host__ __device__ __forceinline__ int lds_byte(int r, int c) { const int st = (r >> 4) * 2 + (c >> 5), rr = r & 15, cc = c & 31, ob = rr * 64 + cc * 2; return st * 1024 + (ob ^ (((ob >> 9) & 1) << 5)); }
__host__ __device__ __forceinline__ void stage_rc(int b, int& R, int& C) { const int st = b / 1024, sb = b % 1024, swz = sb ^ (((sb >> 9) & 1) << 5); R = (st >> 1) * 16 + swz / 64; C = (st & 1) * 32 + (swz % 64) / 2; }
__host__ __device__ __forceinline__ int perm32(int rho) { const int n = rho >> 4, i = rho & 15; return 8 * (i >> 2) + 4 * n + (i & 3); }

struct Unit { int pm, pn, z; };
struct Gemm { const bf16_t* A; const bf16_t* Bt; int M, N, K; size_t zA, zB; };

struct StaticOrder {
    int nM, nN, nwg, G, c;
    __host__ __device__ void init(int M, int N, int G_, int c_) { nM = M / BM; nN = N / BM; nwg = nM * nN; G = G_; c = c_; }
    __host__ __device__ bool next(int i, Unit& u) const {
        const long L = (long)i * G + c; if (L >= nwg) return false;
        int wgid = (int)L; { const int q = nwg / NXCD, r = nwg % NXCD, xcd = wgid % NXCD, off = wgid / NXCD; wgid = (xcd < r ? xcd * (q + 1) : r * (q + 1) + (xcd - r) * q) + off; }
        const int nig = WGM * nN, gid = wgid / nig, fm = gid * WGM, gsz = (nM - fm) < WGM ? (nM - fm) : WGM;
        u.pm = fm + ((wgid % nig) % gsz); u.pn = (wgid % nig) / gsz; u.z = 0; return true;
    }
    __device__ __forceinline__ void a_ready(const Unit&) const {}
    __device__ __forceinline__ void done(const Unit&) const {}
};

template <int NZ> struct ZOrder {
    StaticOrder so;
    __host__ __device__ void init(int M, int N, int G_, int c_) { so.init(M, N, G_, c_); }
    __host__ __device__ bool next(int i, Unit& u) const { if (!so.next(i / NZ, u)) return false; u.z = i % NZ; return true; }
    __device__ __forceinline__ void a_ready(const Unit&) const {}
    __device__ __forceinline__ void done(const Unit&) const {}
};

__device__ __forceinline__ unsigned cvt_pk_bf16(float lo, float hi) { unsigned r; asm volatile("v_cvt_pk_bf16_f32 %0, %1, %2" : "=v"(r) : "v"(lo), "v"(hi)); return r; }
typedef float f32x2 __attribute__((ext_vector_type(2)));
template <class Epi, class Sched, bool ALIGN_EPI = false, bool SP2 = false>
__device__ __forceinline__ void gemm_phase(PG8_LAS unsigned char* lds, const Gemm g, const Sched& S, const Epi& E) {
    int tid_ = threadIdx.x; asm volatile("" : "+v"(tid_));
    const int tid = tid_, wid = __builtin_amdgcn_readfirstlane(tid >> 6), lane = tid & 63, wr = wid >> 2, wc = wid & 3, fr = lane & 15, fq = lane >> 4;
    const int K = g.K, nt = K / BK;
    unsigned voffA[2], voffB[2];
#pragma unroll
    for (int i = 0; i < 2; ++i) { int R, C; stage_rc(tid * 16 + i * 8192, R, C); const int Rb = Epi::PERM ? ((R & ~31) + perm32(R & 31)) : R;
        voffA[i] = (unsigned)(R * K + C) * 2u; voffB[i] = (unsigned)(Rb * K + C) * 2u; }
    const size_t kstep = (size_t)(BK * 2);
    const size_t hstep = (size_t)HALF * K * 2;
    const size_t tstep = 2 * hstep;
    const unsigned ldsw = (unsigned)wid * 1024u;
    const int aoff = lds_byte(wr * 64 + fr, fq * 8), boff = lds_byte(wc * 32 + fr, fq * 8);
#define PG8_SA(b, h) (((b) * 2 + (h)) * HTB)
#define PG8_SB(b, h) ((4 + (b) * 2 + (h)) * HTB)
#define PG8_STAGE(bufoff, gbase, voff) do { _Pragma("unroll") for (int _i = 0; _i < 2; ++_i) \
        __builtin_amdgcn_global_load_lds((const unsigned*)((const char*)(gbase) + (voff)[_i]), (PG8_LAS unsigned*)(lds + (bufoff) + ldsw + _i * 8192), 16, 0, 0); } while (0)
#define PG8_LDA(dst, b, h) do { _Pragma("unroll") for (int m = 0; m < 4; ++m) _Pragma("unroll") for (int k = 0; k < 2; ++k) dst[m][k] = *(const PG8_LAS bf16x8*)(lds + PG8_SA(b, h) + aoff + m * 2048 + k * 1024); } while (0)
#define PG8_LDB(dst, b, h) do { _Pragma("unroll") for (int n = 0; n < 2; ++n) _Pragma("unroll") for (int k = 0; k < 2; ++k) dst[n][k] = *(const PG8_LAS bf16x8*)(lds + PG8_SB(b, h) + boff + n * 2048 + k * 1024); } while (0)
#define PG8_MMA(ai, bj, At, Bt) do { __builtin_amdgcn_s_setprio(1); _Pragma("unroll") for (int m = 0; m < 4; ++m) _Pragma("unroll") for (int n = 0; n < 2; ++n) _Pragma("unroll") for (int k = 0; k < 2; ++k) \
        acc[ai][bj][m][n] = __builtin_amdgcn_mfma_f32_16x16x32_bf16(Bt[n][k], At[m][k], acc[ai][bj][m][n], 0, 0, 0); __builtin_amdgcn_s_setprio(0); } while (0)
#define PG8_WAIT_V(n) asm volatile("s_waitcnt vmcnt(" #n ")" ::: "memory")
#define PG8_WAIT_L(n) asm volatile("s_waitcnt lgkmcnt(" #n ")" ::: "memory")
#define PG8_BAR __builtin_amdgcn_s_barrier()
#define PG8_SCHED __builtin_amdgcn_sched_barrier(0)
    Unit cur, nxt; int ui = 0;
    if (!S.next(0, cur)) return;
    f32x4 acc[2][2][4][2];
#pragma unroll
    for (int a = 0; a < 2; ++a)
#pragma unroll
        for (int b = 0; b < 2; ++b)
#pragma unroll
            for (int m = 0; m < 4; ++m)
#pragma unroll
                for (int n = 0; n < 2; ++n) acc[a][b][m][n] = (f32x4){0.f, 0.f, 0.f, 0.f};
    bf16x8 At[4][2], B0[2][2], B1[2][2];
    const char* cA = (const char*)g.A + (size_t)cur.pm * tstep + (size_t)cur.z * g.zA; const char* cB = (const char*)g.Bt + (size_t)cur.pn * tstep + (size_t)cur.z * g.zB;
    S.a_ready(cur);
    if constexpr (SP2) {
        PG8_STAGE(PG8_SB(0, 0), cB, voffB); PG8_STAGE(PG8_SB(0, 1), cB + hstep, voffB); PG8_STAGE(PG8_SA(0, 0), cA, voffA); PG8_STAGE(PG8_SA(0, 1), cA + hstep, voffA);
        if (wr == 1) PG8_BAR;
        PG8_WAIT_V(2); PG8_BAR;
        PG8_STAGE(PG8_SB(1, 0), cB + kstep, voffB); PG8_STAGE(PG8_SA(1, 0), cA + kstep, voffA); PG8_STAGE(PG8_SB(1, 1), cB + hstep + kstep, voffB);
        PG8_WAIT_V(6); PG8_BAR;
    } else {
        PG8_STAGE(PG8_SB(0, 0), cB, voffB); PG8_STAGE(PG8_SA(0, 0), cA, voffA); PG8_STAGE(PG8_SB(0, 1), cB + hstep, voffB); PG8_STAGE(PG8_SA(0, 1), cA + hstep, voffA);
        if (wr == 1) PG8_BAR;
        PG8_WAIT_V(4); PG8_BAR;
        PG8_STAGE(PG8_SB(1, 0), cB + kstep, voffB); PG8_STAGE(PG8_SA(1, 0), cA + kstep, voffA); PG8_STAGE(PG8_SB(1, 1), cB + hstep + kstep, voffB);
        PG8_WAIT_V(6); PG8_BAR;
    }
    for (;;) {
        const bool has_next = S.next(ui + 1, nxt);
        const char* nA = has_next ? (const char*)g.A + (size_t)nxt.pm * tstep + (size_t)nxt.z * g.zA : cA; const char* nB = has_next ? (const char*)g.Bt + (size_t)nxt.pn * tstep + (size_t)nxt.z * g.zB : cB;
#pragma unroll 1
        for (int t = 0; t < nt; t += 2) {
            const bool last = (t == nt - 2);
            const char* a1 = cA + (size_t)(t + 1) * kstep;
            const char* a2 = last ? nA : cA + (size_t)(t + 2) * kstep; const char* b2 = last ? nB : cB + (size_t)(t + 2) * kstep;
            const char* a3 = a2 + kstep; const char* b3 = b2 + kstep;
            if (last && has_next) S.a_ready(nxt);
            if constexpr (SP2) {
            PG8_LDB(B0, 0, 0); PG8_LDB(B1, 0, 1); PG8_SCHED; PG8_LDA(At, 0, 0); PG8_STAGE(PG8_SA(1, 1), a1 + hstep, voffA);
            PG8_WAIT_V(8); PG8_WAIT_L(0); PG8_BAR; PG8_MMA(0, 0, At, B0); PG8_MMA(0, 1, At, B1); PG8_BAR; PG8_SCHED;
            PG8_LDA(At, 0, 1); PG8_STAGE(PG8_SB(0, 0), b2, voffB); PG8_STAGE(PG8_SB(0, 1), b2 + hstep, voffB); PG8_STAGE(PG8_SA(0, 0), a2, voffA);
            PG8_WAIT_V(8); PG8_WAIT_L(0); PG8_BAR; PG8_MMA(1, 0, At, B0); PG8_MMA(1, 1, At, B1); PG8_BAR; PG8_SCHED;
            PG8_LDB(B0, 1, 0); PG8_LDB(B1, 1, 1); PG8_SCHED; PG8_LDA(At, 1, 0); PG8_STAGE(PG8_SA(0, 1), a2 + hstep, voffA);
            PG8_WAIT_V(8); PG8_WAIT_L(0); PG8_BAR; PG8_MMA(0, 0, At, B0); PG8_MMA(0, 1, At, B1); PG8_BAR; PG8_SCHED;
            PG8_LDA(At, 1, 1); PG8_STAGE(PG8_SB(1, 0), b3, voffB); PG8_STAGE(PG8_SB(1, 1), b3 + hstep, voffB); PG8_STAGE(PG8_SA(1, 0), a3, voffA);
            PG8_WAIT_V(8); PG8_WAIT_L(0); PG8_BAR; PG8_MMA(1, 0, At, B0); PG8_MMA(1, 1, At, B1); PG8_BAR; PG8_SCHED;
            } else {
            PG8_LDB(B0, 0, 0); PG8_SCHED; PG8_LDA(At, 0, 0); PG8_STAGE(PG8_SA(1, 1), a1 + hstep, voffA);
            PG8_WAIT_L(8); PG8_BAR; PG8_WAIT_L(0); PG8_MMA(0, 0, At, B0); PG8_BAR; PG8_SCHED;
            PG8_LDB(B1, 0, 1); PG8_STAGE(PG8_SB(0, 0), b2, voffB);
            PG8_BAR; PG8_WAIT_L(0); PG8_MMA(0, 1, At, B1); PG8_BAR;
            PG8_LDA(At, 0, 1); PG8_STAGE(PG8_SA(0, 0), a2, voffA);
            PG8_BAR; PG8_WAIT_L(0); PG8_MMA(1, 0, At, B0); PG8_BAR; PG8_SCHED;
            PG8_STAGE(PG8_SB(0, 1), b2 + hstep, voffB);
            PG8_WAIT_V(6); PG8_BAR; PG8_MMA(1, 1, At, B1); PG8_BAR;
            PG8_LDB(B0, 1, 0); PG8_SCHED; PG8_LDA(At, 1, 0); PG8_STAGE(PG8_SA(0, 1), a2 + hstep, voffA);
            PG8_WAIT_L(8); PG8_BAR; PG8_WAIT_L(0); PG8_MMA(0, 0, At, B0); PG8_BAR; PG8_SCHED;
            PG8_LDB(B1, 1, 1); PG8_STAGE(PG8_SB(1, 0), b3, voffB);
            PG8_BAR; PG8_WAIT_L(0); PG8_MMA(0, 1, At, B1); PG8_BAR;
            PG8_LDA(At, 1, 1); PG8_STAGE(PG8_SA(1, 0), a3, voffA);
            PG8_BAR; PG8_WAIT_L(0); PG8_MMA(1, 0, At, B0); PG8_BAR; PG8_SCHED;
            PG8_STAGE(PG8_SB(1, 1), b3 + hstep, voffB);
            PG8_WAIT_V(6); PG8_BAR; PG8_MMA(1, 1, At, B1); PG8_BAR;
            }
        }
        if constexpr (ALIGN_EPI) { if (wr == 0) PG8_BAR; }
        if constexpr (!Epi::AFTER_DRAIN) { E(acc, cur, wr, wc, fr, fq); S.done(cur); }
        if (!has_next) break;
#pragma unroll
        for (int a = 0; a < 2; ++a)
#pragma unroll
            for (int b = 0; b < 2; ++b)
#pragma unroll
                for (int m = 0; m < 4; ++m)
#pragma unroll
                    for (int n = 0; n < 2; ++n) acc[a][b][m][n] = (f32x4){0.f, 0.f, 0.f, 0.f};
        cur = nxt; cA = nA; cB = nB; ++ui;
        if constexpr (ALIGN_EPI) { if (wr == 1) PG8_BAR; }
    }
    PG8_WAIT_V(0);
    if constexpr (!ALIGN_EPI) { if (wr == 0) PG8_BAR; }
    PG8_BAR;
    if constexpr (Epi::AFTER_DRAIN) { E.fused(acc, cur, wr, wc, fr, fq, lds, wid, lane); S.done(cur); }
#undef PG8_SA
#undef PG8_SB
#undef PG8_STAGE
#undef PG8_LDA
#undef PG8_LDB
#undef PG8_MMA
#undef PG8_WAIT_V
#undef PG8_WAIT_L
#undef PG8_BAR
#undef PG8_SCHED
}
}

constexpr int NBATCH = 4, SEQ = 2048, DM = 2048, T = NBATCH * SEQ, NL = 4, FF = 8192;
constexpr int NIN = 13312;
constexpr int DIN_SRC = 13128;
constexpr float EPS = 1e-6f;
enum { IX = 0, IMEM, IG_MIX, IW_IN, IG_CQ, IW_UQ, IG_CKV, IW_UKV, IG_MLAQ, IG_MLAK, IB_F, IG_FOXQ, IG_FOXK, IRELB, IG_CHQ, IG_CHK, IW_BR, IW_OUT,
       IG_CROSS, IG_MEM, IW_XQ, IW_XKV, IG_XQ, IG_XK, IW_XO, IG_MLP, IW_1, IW_2, N_IN };

constexpr size_t MiB = 1u << 20;
constexpr size_t WS_CTL = 0, CTL_ZERO_BYTES = 1 * MiB;
constexpr size_t WS_COS = 1 * MiB, WS_SIN = WS_COS + 256 * 1024, WS_RSTDMEM = WS_SIN + 256 * 1024, WS_GT = WS_RSTDMEM + 4096;
constexpr size_t WS_W = 2 * MiB;
constexpr size_t WO_IN = 0, WO_UQ = WO_IN + (size_t)NIN * 2048 * 2, WO_UKV = WO_UQ + (size_t)2048 * 512 * 2, WO_BR = WO_UKV + (size_t)2048 * 256 * 2,
                 WO_OUT = WO_BR + (size_t)3 * 2048 * 1024 * 2, WO_XQ = WO_OUT + (size_t)2048 * 2048 * 2, WO_XKV = WO_XQ + (size_t)512 * 2048 * 2,
                 WO_XO = WO_XKV + (size_t)1024 * 2048 * 2, WO_1 = WO_XO + (size_t)2048 * 512 * 2, WO_2 = WO_1 + (size_t)8192 * 2048 * 2,
                 W_LAYER = WO_2 + (size_t)2048 * 8192 * 2;
static_assert(W_LAYER == 147 * MiB, "weight map");
constexpr size_t WS_ACT = WS_W + NL * W_LAYER;
constexpr size_t WS_XB = WS_ACT, WS_CQ = WS_XB + 32 * MiB, WS_CKV = WS_CQ + 8 * MiB, WS_KR = WS_CKV + 4 * MiB, WS_SMALL = WS_KR + 2 * MiB;
constexpr size_t WS_SSQX = WS_SMALL, WS_SSQCQ = WS_SSQX + 256 * 1024, WS_SSQCKV = WS_SSQCQ + 64 * 1024, WS_SSQKR = WS_SSQCKV + 32 * 1024,
                 WS_LOGF = WS_SSQKR + 32 * 1024, WS_CUM = WS_LOGF + 256 * 1024;
constexpr size_t WS_FQ = WS_SMALL + 2 * MiB, WS_FK = WS_FQ + 16 * MiB, WS_FV = WS_FK + 16 * MiB, WS_CHQ = WS_FV + 16 * MiB, WS_CHK = WS_CHQ + 16 * MiB, WS_CHV = WS_CHK + 16 * MiB;
constexpr size_t WS_GATES = WS_CHV + 16 * MiB, WS_MQ = WS_GATES + 96 * MiB, WS_MK = WS_MQ + 24 * MiB, WS_MV = WS_MK + 24 * MiB, WS_Y = WS_MV + 16 * MiB;
constexpr size_t WS_MERGED = WS_Y + 48 * MiB, WS_XQ = WS_MERGED + 32 * MiB, WS_MEMB = WS_XQ + 8 * MiB, WS_XK = WS_MEMB + 4 * MiB, WS_XV = WS_XK + 1 * MiB, WS_OX = WS_XV + 1 * MiB;
constexpr size_t WS_H = WS_OX + 8 * MiB, WS_END = WS_H + 128 * MiB;
static_assert(WS_CUM + 256 * 1024 <= WS_FQ, "small map");

constexpr int RING_BYTES = 131072;
constexpr int ESCR_OFF = RING_BYTES, ESCR_BYTES = 16384;
constexpr int MISC_OFF = ESCR_OFF + ESCR_BYTES;
constexpr int LDS_BYTES = MISC_OFF + 1024;

#define GAS __attribute__((address_space(1)))
#define LAS __attribute__((address_space(3)))
typedef unsigned short bf16;
typedef unsigned u32x4 __attribute__((ext_vector_type(4)));
typedef unsigned u32x2 __attribute__((ext_vector_type(2)));
typedef float f32x4 __attribute__((ext_vector_type(4)));
typedef float f32x2 __attribute__((ext_vector_type(2)));
typedef GAS unsigned gu32;
#define RLX_AGENT __ATOMIC_RELAXED, __HIP_MEMORY_SCOPE_AGENT
#define LDS_WAIT() asm volatile("s_waitcnt lgkmcnt(0)" ::: "memory")
#define VM_WAIT() asm volatile("s_waitcnt vmcnt(0)" ::: "memory")
using pg8::cvt_pk_bf16;
__device__ __forceinline__ float bf_lo(unsigned w) { return __uint_as_float(w << 16); }
__device__ __forceinline__ float bf_hi(unsigned w) { return __uint_as_float(w & 0xffff0000u); }
__device__ __forceinline__ float bf2f(bf16 h) { return __uint_as_float((unsigned)h << 16); }
__device__ __forceinline__ u32x4 pack8(f32x4 a, f32x4 b) { u32x4 w; w.x = cvt_pk_bf16(a[0], a[1]); w.y = cvt_pk_bf16(a[2], a[3]); w.z = cvt_pk_bf16(b[0], b[1]); w.w = cvt_pk_bf16(b[2], b[3]); return w; }
__device__ __forceinline__ void unpack8(u32x4 w, f32x4& a, f32x4& b) { a[0] = bf_lo(w.x); a[1] = bf_hi(w.x); a[2] = bf_lo(w.y); a[3] = bf_hi(w.y); b[0] = bf_lo(w.z); b[1] = bf_hi(w.z); b[2] = bf_lo(w.w); b[3] = bf_hi(w.w); }
__device__ __forceinline__ float sumsq4(f32x4 v) { return (v[0] * v[0] + v[1] * v[1]) + (v[2] * v[2] + v[3] * v[3]); }
__device__ __forceinline__ float rsq(float x) { return __builtin_amdgcn_rsqf(x); }
__device__ __forceinline__ float sigmoidf_(float x) { return __builtin_amdgcn_rcpf(1.0f + __expf(-x)); }
__device__ __forceinline__ float log_sigmoidf_(float x) { return fminf(x, 0.f) - log1pf(expf(-fabsf(x))); }

typedef f32x4 Acc[2][2][4][2];
using pg8::Unit;
#define EPI_BAR() do { asm volatile("s_waitcnt lgkmcnt(0)" ::: "memory"); __builtin_amdgcn_s_barrier(); asm volatile("" ::: "memory"); } while (0)
template <int NB> __device__ __forceinline__ void xwave_rowsum(float (&s)[2][4][NB], LAS float* P, int wr, int wc, int fr, int fq) {
    unsigned pw = (unsigned)(uintptr_t)P + (unsigned)(((wr * 64 + fr) * NB * 4 + wc) * 4), pr = (unsigned)(uintptr_t)P + (unsigned)((wr * 64 + fr) * NB * 16);
    asm volatile("" : "+v"(pw), "+v"(pr));
#pragma unroll
    for (int ai = 0; ai < 2; ++ai)
#pragma unroll
        for (int m = 0; m < 4; ++m)
#pragma unroll
            for (int b = 0; b < NB; ++b) { float v = s[ai][m][b]; v += __shfl_xor(v, 16); v += __shfl_xor(v, 32);
                if (fq == 0) *(LAS float*)(pw + (unsigned)(((ai * 128 + m * 16) * NB + b) * 16)) = v; }
    EPI_BAR();
#pragma unroll
    for (int ai = 0; ai < 2; ++ai)
#pragma unroll
        for (int m = 0; m < 4; ++m)
#pragma unroll
            for (int b = 0; b < NB; ++b) { const f32x4 t = *(const LAS f32x4*)(pr + (unsigned)(((ai * 128 + m * 16) * NB + b) * 16)); s[ai][m][b] = (t[0] + t[1]) + (t[2] + t[3]); }
}
__device__ __forceinline__ void fresh_lane(int& fr, int& fq) { int l; asm volatile("v_mbcnt_lo_u32_b32 %0, -1, 0\n\tv_mbcnt_hi_u32_b32 %0, -1, %0" : "=v"(l)); fr = l & 15; fq = l >> 4; }
template <class V> __device__ __forceinline__ V ldg(const void* base, unsigned boff) { return *(const V*)((const char*)base + boff); }
template <class V> __device__ __forceinline__ void stg(void* base, unsigned boff, V v) { *(V*)((char*)base + boff) = v; }
__device__ __forceinline__ float sum8(f32x4 a, f32x4 b) { return ((a[0] + a[1]) + (a[2] + a[3])) + ((b[0] + b[1]) + (b[2] + b[3])); }
__device__ __forceinline__ float rstd8(const float* base, unsigned row) { return rsq(sum8(ldg<f32x4>(base, row * 32u), ldg<f32x4>(base, row * 32u + 16u)) * (1.0f / DM) + EPS); }
#define ROWG(ai, m) ((unsigned)(row0 + (ai) * 128 + (m) * 16))
#define EPI_AM _Pragma("unroll") for (int ai = 0; ai < 2; ++ai) _Pragma("unroll") for (int m = 0; m < 4; ++m) if ((__builtin_amdgcn_sched_barrier(0), true))
#define EPI_BJ _Pragma("unroll") for (int bj = 0; bj < 2; ++bj)

struct EpiInProj {
    static constexpr bool PERM = true, AFTER_DRAIN = false;
    const float* ssqx; bf16* cq; float* ssqcq; bf16* ckv; float* ssqckv; float* kr; float* ssqkr; float* logf; const float* b_f;
    bf16* hm;
    const float* gt;
    bf16* gates; LAS float* scr;
    __device__ __forceinline__ void operator()(Acc& acc, const Unit& u, int wr, int wc, int fr, int fq) const {
        fresh_lane(fr, fq);
        int row0 = u.pm * 256 + wr * 64 + fr, c8 = wc * 32 + fq * 8;
        asm volatile("" : "+v"(row0), "+v"(c8), "+v"(fq));
        const int pn = u.pn;
        EPI_AM { const float rs = rstd8(ssqx, ROWG(ai, m));
            EPI_BJ { acc[ai][bj][m][0] *= rs; acc[ai][bj][m][1] *= rs; } }
        if (pn >= 28) {
            EPI_AM { const unsigned row = ROWG(ai, m);
                EPI_BJ { f32x4 a = acc[ai][bj][m][0], b = acc[ai][bj][m][1];
#pragma unroll
                    for (int e = 0; e < 4; ++e) { a[e] = sigmoidf_(a[e]); b[e] = sigmoidf_(b[e]); }
                    stg<u32x4>(gates, row * 12288u + ((pn - 28) * 256 + bj * 128 + c8) * 2u, pack8(a, b)); } }
            return;
        }
        float s[2][4][2];
        const bool kr_tile = pn == 3;
        EPI_AM { const float s0 = sumsq4(acc[ai][0][m][0]) + sumsq4(acc[ai][0][m][1]), s1 = sumsq4(acc[ai][1][m][0]) + sumsq4(acc[ai][1][m][1]);
            s[ai][m][0] = (kr_tile && wc >= 2) ? 0.f : s0; s[ai][m][1] = kr_tile ? 0.f : s1; }
        xwave_rowsum<2>(s, scr, wr, wc, fr, fq);
        if (pn < 3) {
            EPI_AM { const unsigned row = ROWG(ai, m); const float tot = s[ai][m][0] + s[ai][m][1];
                if (wc == 0 && fq == 0) { if (pn < 2) stg<float>(ssqcq, row * 8u + pn * 4u, tot); else stg<float>(ssqckv, row * 4u, tot); }
                EPI_BJ { const u32x4 w = pack8(acc[ai][bj][m][0], acc[ai][bj][m][1]);
                    if (pn < 2) stg<u32x4>(cq, row * 1024u + (pn * 256 + bj * 128 + c8) * 2u, w); else stg<u32x4>(ckv, row * 512u + (bj * 128 + c8) * 2u, w); } }
        } else if (pn == 3) {
            EPI_AM { const unsigned row = ROWG(ai, m);
                if (wc == 0 && fq == 0) stg<float>(ssqkr, row * 4u, s[ai][m][0]);
                if (wc < 2) { stg<f32x4>(kr, row * 256u + c8 * 4u, acc[ai][0][m][0]); stg<f32x4>(kr, row * 256u + c8 * 4u + 16u, acc[ai][0][m][1]); }
                if (wc == 2 && fq == 0) { f32x4 a = acc[ai][0][m][0], b = acc[ai][0][m][1]; const f32x4 b0 = *(const f32x4*)b_f, b1 = *(const f32x4*)(b_f + 4);
#pragma unroll
                    for (int e = 0; e < 4; ++e) { a[e] = log_sigmoidf_(a[e] + b0[e]); b[e] = log_sigmoidf_(b[e] + b1[e]); }
                    stg<f32x4>(logf, row * 32u, a); stg<f32x4>(logf, row * 32u + 16u, b); } }
        } else {
            const int t = pn - 4, seg = t >> 2, hp = t & 3; const bool isv = seg == 2 || seg == 5;
            const f32x4 g0 = ldg<f32x4>(gt, (seg * 128 + c8) * 4u), g1 = ldg<f32x4>(gt, (seg * 128 + c8) * 4u + 16u);
            bf16* dst = hm + (size_t)seg * (8u << 20);
            EPI_AM { const unsigned row = ROWG(ai, m), b = row >> 11, sp = row & 2047u;
                EPI_BJ { const float rh = isv ? 1.0f : rsq(s[ai][m][bj] * (1.0f / 128.0f) + EPS); const unsigned head = hp * 2 + bj;
                    stg<u32x4>(dst, (((b * 8u + head) * SEQ + sp) * 128u + c8) * 2u, pack8(acc[ai][bj][m][0] * rh * g0, acc[ai][bj][m][1] * rh * g1)); } }
        }
    }
};

struct EpiQUp {
    static constexpr bool PERM = true, AFTER_DRAIN = false;
    const float* ssqcq; const float* gq; const float* cosT; const float* sinT; bf16* mq; LAS float* scr;
    __device__ __forceinline__ void operator()(Acc& acc, const Unit& u, int wr, int wc, int fr, int fq) const {
        fresh_lane(fr, fq);
        int row0 = u.pm * 256 + wr * 64 + fr, c8 = wc * 32 + fq * 8;
        asm volatile("" : "+v"(row0), "+v"(c8), "+v"(fq));
        const unsigned head = u.pn;
        float s[2][4][1];
        EPI_AM { const f32x2 p = ldg<f32x2>(ssqcq, ROWG(ai, m) * 8u); const float rs = rsq((p[0] + p[1]) * (1.0f / 512.0f) + EPS);
            EPI_BJ { acc[ai][bj][m][0] *= rs; acc[ai][bj][m][1] *= rs; }
            s[ai][m][0] = (sumsq4(acc[ai][0][m][0]) + sumsq4(acc[ai][0][m][1])) + (sumsq4(acc[ai][1][m][0]) + sumsq4(acc[ai][1][m][1])); }
        xwave_rowsum<1>(s, scr, wr, wc, fr, fq);
        const f32x4 g0 = ldg<f32x4>(gq, c8 * 4u), g1 = ldg<f32x4>(gq, c8 * 4u + 16u);
        const unsigned gi = 4 * (wc & 1) + fq;
        const f32x4 gr1 = ldg<f32x4>(gq, (128 + 4 * gi) * 4u), gr2 = ldg<f32x4>(gq, (160 + 4 * gi) * 4u);
        EPI_AM { const unsigned row = ROWG(ai, m), b = row >> 11, sp = row & 2047u; const float rq = rsq(s[ai][m][0] * (1.0f / 192.0f) + EPS);
            const unsigned d = ((b * 8u + head) * SEQ + sp) * 384u;
            stg<u32x4>(mq, d + c8 * 2u, pack8(acc[ai][0][m][0] * rq * g0, acc[ai][0][m][1] * rq * g1));
            if (wc < 2) { const f32x4 x1 = acc[ai][1][m][0] * rq * gr1, x2 = acc[ai][1][m][1] * rq * gr2;
                const f32x4 c = ldg<f32x4>(cosT, (sp * 32u + 4 * gi) * 4u), sn = ldg<f32x4>(sinT, (sp * 32u + 4 * gi) * 4u);
                stg<u32x4>(mq, d + (128 + 8 * gi) * 2u, pack8(x1 * c - x2 * sn, x1 * sn + x2 * c)); } }
    }
};

struct EpiKvUp {
    static constexpr bool PERM = true, AFTER_DRAIN = false;
    const float* ssqckv; const float* ssqkr; const float* kr; const float* gk; const float* cosT; const float* sinT; bf16* mk; bf16* mv; LAS float* scr;
    __device__ __forceinline__ void operator()(Acc& acc, const Unit& u, int wr, int wc, int fr, int fq) const {
        fresh_lane(fr, fq);
        int row0 = u.pm * 256 + wr * 64 + fr, c8 = wc * 32 + fq * 8;
        asm volatile("" : "+v"(row0), "+v"(c8), "+v"(fq));
        const unsigned head = u.pn;
        float s[2][4][1];
        EPI_AM { const float rs = rsq(ldg<float>(ssqckv, ROWG(ai, m) * 4u) * (1.0f / 256.0f) + EPS);
            EPI_BJ { acc[ai][bj][m][0] *= rs; acc[ai][bj][m][1] *= rs; }
            s[ai][m][0] = sumsq4(acc[ai][0][m][0]) + sumsq4(acc[ai][0][m][1]); }
        xwave_rowsum<1>(s, scr, wr, wc, fr, fq);
        const f32x4 g0 = ldg<f32x4>(gk, c8 * 4u), g1 = ldg<f32x4>(gk, c8 * 4u + 16u);
        const unsigned qi = 4 * wc + fq, i0 = 2 * qi;
        const f32x2 gr1 = ldg<f32x2>(gk, (128 + i0) * 4u), gr2 = ldg<f32x2>(gk, (160 + i0) * 4u);
        const unsigned slot = 128 + 8 * (qi >> 1) + 2 * (qi & 1);
        EPI_AM { const unsigned row = ROWG(ai, m), b = row >> 11, sp = row & 2047u; const float rk = rsq((s[ai][m][0] + ldg<float>(ssqkr, row * 4u)) * (1.0f / 192.0f) + EPS);
            const unsigned tok = (b * 8u + head) * SEQ + sp, dk = tok * 384u;
            stg<u32x4>(mk, dk + c8 * 2u, pack8(acc[ai][0][m][0] * rk * g0, acc[ai][0][m][1] * rk * g1));
            stg<u32x4>(mv, tok * 256u + c8 * 2u, pack8(acc[ai][1][m][0], acc[ai][1][m][1]));
            const f32x2 x1 = ldg<f32x2>(kr, row * 256u + i0 * 4u) * rk * gr1, x2 = ldg<f32x2>(kr, row * 256u + (32 + i0) * 4u) * rk * gr2;
            const f32x2 c = ldg<f32x2>(cosT, (sp * 32u + i0) * 4u), sn = ldg<f32x2>(sinT, (sp * 32u + i0) * 4u);
            const f32x2 o1 = x1 * c - x2 * sn, o2 = x1 * sn + x2 * c;
            stg<unsigned>(mk, dk + slot * 2u, cvt_pk_bf16(o1[0], o1[1])); stg<unsigned>(mk, dk + (slot + 4) * 2u, cvt_pk_bf16(o2[0], o2[1])); }
    }
};

struct EpiBr {
    static constexpr bool PERM = true, AFTER_DRAIN = false;
    const bf16* gates; bf16* merged;
    __device__ __forceinline__ void operator()(Acc& acc, const Unit& u, int wr, int wc, int fr, int fq) const {
        fresh_lane(fr, fq);
        int row0 = u.pm * 256 + wr * 64 + fr, c8 = wc * 32 + fq * 8;
        asm volatile("" : "+v"(row0), "+v"(c8));
        const unsigned z = u.z;
        EPI_AM { const unsigned row = ROWG(ai, m);
            EPI_BJ { const unsigned col = u.pn * 256 + bj * 128 + c8;
                f32x4 ga, gb; unpack8(ldg<u32x4>(gates, row * 12288u + (z * 2048u + col) * 2u), ga, gb);
                f32x4 a = acc[ai][bj][m][0] * ga, b = acc[ai][bj][m][1] * gb;
                const unsigned d = row * 4096u + col * 2u;
                if (z > 0) { f32x4 pa, pb; unpack8(ldg<u32x4>(merged, d), pa, pb); a += pa; b += pb; }
                stg<u32x4>(merged, d, pack8(a, b)); } }
    }
};

struct EpiResid {
    static constexpr bool PERM = false, AFTER_DRAIN = false;
    const float* xin; float* xout; bf16* xb; float* ssqx; LAS float* scr;
    __device__ __forceinline__ void operator()(Acc& acc, const Unit& u, int wr, int wc, int fr, int fq) const {
        fresh_lane(fr, fq);
        int row0 = u.pm * 256 + wr * 64 + fr, c4 = wc * 32 + fq * 4;
        asm volatile("" : "+v"(row0), "+v"(c4), "+v"(fq));
        float s[2][4][1];
        EPI_AM { const unsigned row = ROWG(ai, m); float q = 0.f;
            EPI_BJ {
#pragma unroll
                for (int n = 0; n < 2; ++n) { const unsigned e = row * 2048u + u.pn * 256 + bj * 128 + n * 16 + c4;
                    const f32x4 v = ldg<f32x4>(xin, e * 4u) + acc[ai][bj][m][n];
                    stg<f32x4>(xout, e * 4u, v); q += sumsq4(v);
                    u32x2 w; w.x = cvt_pk_bf16(v[0], v[1]); w.y = cvt_pk_bf16(v[2], v[3]); stg<u32x2>(xb, e * 2u, w); } }
            s[ai][m][0] = q; }
        xwave_rowsum<1>(s, scr, wr, wc, fr, fq);
        if (wc == 0 && fq == 0) { EPI_AM { stg<float>(ssqx, ROWG(ai, m) * 32u + u.pn * 4u, s[ai][m][0]); } }
    }
};

struct EpiHeadNorm {
    static constexpr bool PERM = true, AFTER_DRAIN = false;
    const float* ssq8;
    const float* rstd1;
    const float* gg; bf16* dk; bf16* dv; int nk_tiles, rows_per_b, lg_rows_per_b; LAS float* scr;
    __device__ __forceinline__ void operator()(Acc& acc, const Unit& u, int wr, int wc, int fr, int fq) const {
        fresh_lane(fr, fq);
        int row0 = u.pm * 256 + wr * 64 + fr, c8 = wc * 32 + fq * 8;
        asm volatile("" : "+v"(row0), "+v"(c8), "+v"(fq));
        const int pn = u.pn;
        EPI_AM { const unsigned row = ROWG(ai, m); const float rs = ssq8 ? rstd8(ssq8, row) : ldg<float>(rstd1, row * 4u);
            EPI_BJ { acc[ai][bj][m][0] *= rs; acc[ai][bj][m][1] *= rs; } }
        const bool isk = pn < nk_tiles;
        if (isk) {
            float s[2][4][2];
            EPI_AM { EPI_BJ { s[ai][m][bj] = sumsq4(acc[ai][bj][m][0]) + sumsq4(acc[ai][bj][m][1]); } }
            xwave_rowsum<2>(s, scr, wr, wc, fr, fq);
            const f32x4 g0 = ldg<f32x4>(gg, c8 * 4u), g1 = ldg<f32x4>(gg, c8 * 4u + 16u);
            EPI_AM { EPI_BJ { const float rh = rsq(s[ai][m][bj] * (1.0f / 128.0f) + EPS); acc[ai][bj][m][0] = acc[ai][bj][m][0] * rh * g0; acc[ai][bj][m][1] = acc[ai][bj][m][1] * rh * g1; } }
        }
        bf16* dst = isk ? dk : dv; const unsigned hp = isk ? pn : pn - nk_tiles;
        EPI_AM { const unsigned row = ROWG(ai, m), b = row >> lg_rows_per_b, sp = row & (unsigned)(rows_per_b - 1);
            EPI_BJ { const unsigned head = hp * 2 + bj; stg<u32x4>(dst, (((b * 4u + head) * rows_per_b + sp) * 128u + c8) * 2u, pack8(acc[ai][bj][m][0], acc[ai][bj][m][1])); } }
    }
};

struct EpiMlp1 {
    static constexpr bool PERM = true, AFTER_DRAIN = false;
    const float* ssqx; bf16* h;
    __device__ __forceinline__ void operator()(Acc& acc, const Unit& u, int wr, int wc, int fr, int fq) const {
        fresh_lane(fr, fq);
        int row0 = u.pm * 256 + wr * 64 + fr, c8 = wc * 32 + fq * 8;
        asm volatile("" : "+v"(row0), "+v"(c8));
        EPI_AM { const unsigned row = ROWG(ai, m); const float rs = rstd8(ssqx, row);
            EPI_BJ { f32x4 a = acc[ai][bj][m][0] * rs, b = acc[ai][bj][m][1] * rs;
#pragma unroll
                for (int e = 0; e < 4; ++e) { a[e] = fmaxf(a[e], 0.f); a[e] *= a[e]; b[e] = fmaxf(b[e], 0.f); b[e] *= b[e]; }
                stg<u32x4>(h, row * 16384u + (u.pn * 256 + bj * 128 + c8) * 2u, pack8(a, b)); } }
    }
};

namespace att {
typedef short bf16x8 __attribute__((ext_vector_type(8)));
typedef short s16x4 __attribute__((ext_vector_type(4)));
typedef float f32x16 __attribute__((ext_vector_type(16)));
constexpr int NW = 8, QBLK = 32, KVBLK = 64, QB = NW * QBLK, DV = 128;
constexpr int SHM_V = KVBLK * DV * 2;
constexpr float SQRT_D = 11.313708498984761f;
template <int MODE> struct Cfg { static constexpr int DK = MODE == 0 ? 192 : 128, SHM_K = KVBLK * DK * 2, NQF = DK / 16;
    static constexpr int OFF_K = 2 * SHM_V, OFF_WS = OFF_K + 2 * SHM_K, OFF_CK = OFF_WS + NW * 64 * 4, OFF_EXT = OFF_CK + 2 * 64 * 4, LDS_BYTES = OFF_EXT + 256 * 4;
    static constexpr bool SK = MODE != 3; };
static_assert(Cfg<0>::LDS_BYTES <= RING_BYTES, "attention LDS");
#define SBAR() __builtin_amdgcn_sched_barrier(0)
template <int DK> __device__ __forceinline__ int kswz(int row, int colB) { return row * (DK * 2) + (colB ^ ((row & 7) << 4)); }
__device__ __forceinline__ int v_st(int k, int c) { const int kk = (k & ~0xC) | ((k & 4) << 1) | ((k & 8) >> 1); return ((kk >> 3) * 4 + (c >> 5)) * 512 + ((kk & 7) * 32 + (c & 31)) * 2; }
__device__ __forceinline__ int v_rd_base(int lane) { return ((lane & 3) << 3) | (((lane >> 2) & 3) << 6) | (((lane >> 4) & 1) << 5) | (((lane >> 5) & 1) << 8); }
constexpr int v_rd_off(int d0, int ks, int half) { return d0 * 512 + ks * 4096 + half * 2048; }
__device__ __forceinline__ int crow(int r, int hi) { return (r & 3) + 8 * (r >> 2) + 4 * hi; }
__device__ __forceinline__ unsigned cvtpk(float lo, float hi) { unsigned r; asm volatile("v_cvt_pk_bf16_f32 %0, %1, %2" : "=v"(r) : "v"(lo), "v"(hi)); return r; }
__device__ __forceinline__ bf16x8 load8(const bf16* p) { return *reinterpret_cast<const bf16x8*>(p); }
__device__ __forceinline__ void mask_tile(f32x16& p0, f32x16& p1, int dq) {
    const float NEG = -__builtin_inff();
#pragma unroll
    for (int r = 0; r < 16; ++r) { const int c = (r & 3) + 8 * (r >> 2); if (dq - c < 0) p0[r] = NEG; if (dq - c - 32 < 0) p1[r] = NEG; }
}
template <int MODE> __device__ __forceinline__ void partialSM(f32x16& p0, f32x16& p1, float& m_reg, float& mn, float& alpha) {
    constexpr float SCALE = MODE == 0 ? 0.07216878364870322f : 0.08838834764831845f, THR = 8.f;
    float pmax = p0[0]; for (int r = 1; r < 16; ++r) pmax = fmaxf(pmax, p0[r]); for (int r = 0; r < 16; ++r) pmax = fmaxf(pmax, p1[r]);
    { auto rr = __builtin_amdgcn_permlane32_swap(__float_as_uint(pmax), __float_as_uint(pmax), false, false);
      pmax = fmaxf(__uint_as_float(rr[0]), __uint_as_float(rr[1])); }
    constexpr float C2 = 1.4426950408889634f * SCALE;
    if (__builtin_expect(__all((pmax - m_reg) * SCALE <= THR), 1)) { mn = m_reg; alpha = 1.f; }
    else { mn = fmaxf(m_reg, pmax); alpha = __builtin_amdgcn_exp2f((m_reg - mn) * C2); m_reg = mn; }
    const float mnL = -mn * C2;
    for (int r = 0; r < 16; ++r) p0[r] = fmaf(p0[r], C2, mnL); for (int r = 0; r < 16; ++r) p1[r] = fmaf(p1[r], C2, mnL);
    for (int r = 0; r < 16; ++r) p0[r] = __builtin_amdgcn_exp2f(p0[r]);
}
__device__ __forceinline__ void finishSM(f32x16& p0, f32x16& p1, float alpha, float& l_reg, bf16x8& pa0, bf16x8& pa1, bf16x8& pa2, bf16x8& pa3) {
    for (int r = 0; r < 16; ++r) p1[r] = __builtin_amdgcn_exp2f(p1[r]);
    float ps = 0; for (int r = 0; r < 16; ++r) ps += p0[r]; for (int r = 0; r < 16; ++r) ps += p1[r];
    { auto rr = __builtin_amdgcn_permlane32_swap(__float_as_uint(ps), __float_as_uint(ps), false, false);
      ps = __uint_as_float(rr[0]) + __uint_as_float(rr[1]); }
    l_reg = l_reg * alpha + ps;
#define PK4(P, B_, OUT) do { unsigned a0 = cvtpk(P[B_+0], P[B_+1]), a1 = cvtpk(P[B_+2], P[B_+3]);                          \
        unsigned b0 = cvtpk(P[B_+4], P[B_+5]), b1 = cvtpk(P[B_+6], P[B_+7]);                                             \
        auto r0 = __builtin_amdgcn_permlane32_swap(a0, b0, false, false); auto r1 = __builtin_amdgcn_permlane32_swap(a1, b1, false, false); \
        u32x4 w = {r0[0], r1[0], r0[1], r1[1]}; OUT = *reinterpret_cast<bf16x8*>(&w); } while (0)
    PK4(p0, 0, pa0); PK4(p0, 8, pa1); PK4(p1, 0, pa2); PK4(p1, 8, pa3);
#undef PK4
}
template <int MODE, int KB>
__device__ __forceinline__ void qkt(f32x16& p0, f32x16& p1, const char* K_lds, int r32, int hi, const bf16x8* qr, bool act) {
    constexpr int DK = Cfg<MODE>::DK, SHM_K = Cfg<MODE>::SHM_K;
    if (Cfg<MODE>::SK && !act) { const float NEG = -__builtin_inff();
#pragma unroll
        for (int r = 0; r < 16; ++r) { p0[r] = NEG; p1[r] = NEG; } return; }
    const char* kb[4];
#pragma unroll
    for (int dd = 0; dd < 4; ++dd) kb[dd] = K_lds + KB * SHM_K + kswz<DK>(r32, (dd * 16 + hi * 8) * 2);
#pragma unroll
    for (int d0 = 0; d0 < DK / 16; ++d0) { const char* a = kb[d0 & 3] + (d0 >> 2) * 128;
        bf16x8 b0 = *reinterpret_cast<const bf16x8*>(a);
        bf16x8 b1 = *reinterpret_cast<const bf16x8*>(a + 32 * DK * 2);
        p0 = __builtin_amdgcn_mfma_f32_32x32x16_bf16(b0, qr[d0], p0, 0, 0, 0);
        p1 = __builtin_amdgcn_mfma_f32_32x32x16_bf16(b1, qr[d0], p1, 0, 0, 0); }
}
template <int VB, bool SK>
__device__ __forceinline__ void pv_tile(f32x16* o, int vb0, bf16x8 pa0, bf16x8 pa1, bf16x8 pa2, bf16x8 pa3, bool act) {
    if (SK && !act) return;
#define TRRD(dst, off) asm volatile("ds_read_b64_tr_b16 %0, %1 offset:%2" : "=&v"(dst) : "v"(vb0), "i"(off) : "memory")
#define PV_D0(d0) do { s16x4 l0, l1, l2, l3, h0, h1, h2, h3; constexpr int b_ = VB * SHM_V + v_rd_off(d0, 0, 0); \
        TRRD(l0, b_); TRRD(h0, b_ + 2048); TRRD(l1, b_ + 4096); TRRD(h1, b_ + 6144); TRRD(l2, b_ + 8192); TRRD(h2, b_ + 10240); TRRD(l3, b_ + 12288); TRRD(h3, b_ + 14336); \
        asm volatile("s_waitcnt lgkmcnt(0)" ::: "memory"); SBAR();   \
        o[d0] = __builtin_amdgcn_mfma_f32_32x32x16_bf16(pa0, (bf16x8){l0[0], l0[1], l0[2], l0[3], h0[0], h0[1], h0[2], h0[3]}, o[d0], 0, 0, 0);   \
        o[d0] = __builtin_amdgcn_mfma_f32_32x32x16_bf16(pa1, (bf16x8){l1[0], l1[1], l1[2], l1[3], h1[0], h1[1], h1[2], h1[3]}, o[d0], 0, 0, 0);   \
        o[d0] = __builtin_amdgcn_mfma_f32_32x32x16_bf16(pa2, (bf16x8){l2[0], l2[1], l2[2], l2[3], h2[0], h2[1], h2[2], h2[3]}, o[d0], 0, 0, 0);   \
        o[d0] = __builtin_amdgcn_mfma_f32_32x32x16_bf16(pa3, (bf16x8){l3[0], l3[1], l3[2], l3[3], h3[0], h3[1], h3[2], h3[3]}, o[d0], 0, 0, 0); } while (0)
    PV_D0(0); PV_D0(1); PV_D0(2); PV_D0(3);
#undef PV_D0
#undef TRRD
}

struct Blk { const bf16* Q; const bf16* K; const bf16* V; bf16* O; int P0, ldo; const float* cum; const float* relb; };
template <int MODE> struct Stage { bf16x8 st_v0, st_v1, st_k0, st_k1, st_k2; float st_c; };
template <int MODE> __device__ __forceinline__ int blk_jlo(int P0) { return MODE == 2 ? (P0 >= 512 ? (P0 - 512) / KVBLK : 0) : 0; }
template <int MODE> __device__ __forceinline__ int blk_jhi(int P0, int skv) { return MODE == 3 ? skv / KVBLK : (P0 + QB - 1) / KVBLK + 1; }
#define VMW() asm volatile("s_waitcnt vmcnt(0)" ::: "memory")
#define KROW(p, k0, rr) ((p) + (size_t)((k0) + (rr)) * DK + sc)
#define VROW(p, k0, rr) ((p) + (size_t)((k0) + (rr)) * DV + sc)
#define SLOAD_H(B_, k0) do { S.st_v0 = load8(VROW((B_).V, k0, sr)); S.st_v1 = load8(VROW((B_).V, k0, 32 + sr));              \
                         S.st_k0 = load8(KROW((B_).K, k0, sr)); S.st_k1 = load8(KROW((B_).K, k0, 32 + sr));              \
                         if constexpr (MODE == 0) S.st_k2 = load8((B_).K + (size_t)((k0) + (tid >> 3)) * DK + 128 + (tid & 7) * 8);   \
                         if constexpr (MODE == 1) { if (tid < 64) S.st_c = (B_).cum[(k0) + tid] * SQRT_D; } } while (0)
#define SWRITE_HK(bf) do { *(bf16x8*)(K_lds + (bf) * SHM_K + kws) = S.st_k0; *(bf16x8*)(K_lds + (bf) * SHM_K + kws + 32 * DK * 2) = S.st_k1; \
                           if constexpr (MODE == 0) *(bf16x8*)(K_lds + (bf) * SHM_K + kws2) = S.st_k2;     \
                           if constexpr (MODE == 1) { if (tid < 64) ck_l[(bf) * 64 + tid] = S.st_c; } } while (0)
#define SWRITE_HV(bf) do { *(bf16x8*)(V_lds + (bf) * SHM_V + vst0) = S.st_v0; *(bf16x8*)(V_lds + (bf) * SHM_V + vst1) = S.st_v1; } while (0)
#define SWRITE_H(bf) do { SWRITE_HV(bf); SWRITE_HK(bf); } while (0)
template <int MODE>
__device__ __forceinline__ void attn_block(const Blk& cur, int skv, char* lds) {
    constexpr int DK = Cfg<MODE>::DK, SHM_K = Cfg<MODE>::SHM_K, NQF = Cfg<MODE>::NQF; constexpr bool SK = Cfg<MODE>::SK;
    int tid_ = threadIdx.x; asm volatile("" : "+v"(tid_));
    const int tid = tid_, wid = __builtin_amdgcn_readfirstlane(tid >> 6), lane = tid & 63, r32 = lane & 31, hi = lane >> 5;
    const int j_lo = blk_jlo<MODE>(cur.P0), j_hi = blk_jhi<MODE>(cur.P0, skv);
    const int NT = j_hi - j_lo;
    const int qlo = cur.P0 + wid * QBLK, qm = qlo + r32 - 4 * hi;
    const int cq = qlo >> 6;
    char* V_lds = lds; char* K_lds = lds + Cfg<MODE>::OFF_K;
    float* ws = (float*)(lds + Cfg<MODE>::OFF_WS) + wid * 64; float* li_l = ws, * al_l = ws + 32;
    float* ck_l = (float*)(lds + Cfg<MODE>::OFF_CK); const float* ext_l = (const float*)(lds + Cfg<MODE>::OFF_EXT); (void)ck_l; (void)ext_l; (void)qm; (void)cq;
    float m_reg = -1e30f, l_reg = 0; f32x16 o[4] = {};
    const int sr = tid >> 4, sc = (tid & 15) * 8, vst0 = v_st(sr, sc), vst1 = v_st(32 + sr, sc), kws = kswz<DK>(sr, sc * 2), kws2 = kswz<DK>(tid >> 3, (128 + (tid & 7) * 8) * 2); (void)kws2;
    const int vb0 = (int)(uintptr_t)V_lds + v_rd_base(lane);
    float cqs = 0.f; if constexpr (MODE == 1) cqs = cur.cum[qlo + r32] * SQRT_D;
    const int extb = (qlo & 63) + r32 - 4 * hi + 4; (void)extb; (void)cqs;
    Stage<MODE> S; bf16x8 qr[NQF];
#define RESC(a) do { if (__any((a) < 1.f)) { if (hi == 0) al_l[r32] = (a); asm volatile("s_waitcnt lgkmcnt(0)" ::: "memory");              \
                     for (int d_ = 0; d_ < 4; ++d_) for (int r = 0; r < 16; ++r) o[d_][r] *= al_l[crow(r, hi)]; } } while (0)
#define KBASE(t) ((j_lo + (t)) * KVBLK)
#define ACT(t) (MODE == 0 ? (j_lo + (t)) <= cq : MODE == 1 ? KBASE(t) <= qlo + QBLK - 1 : MODE == 2 ? ((j_lo + (t)) <= cq && (j_lo + (t)) + 8 >= cq) : true)
#define MASKT(P0_, P1_, t) do { if constexpr (MODE == 1) { const int kb_ = KBASE(t); if (ACT(t) && kb_ + KVBLK - 1 > qlo) mask_tile(P0_, P1_, qm - kb_); } } while (0)
#define INITP(PX0, PX1, t, KB) do { if constexpr (MODE == 0 || MODE == 3) { PX0 = f32x16{}; PX1 = f32x16{}; }                                  \
        else if constexpr (MODE == 1) { _Pragma("unroll") for (int g_ = 0; g_ < 4; ++g_) { const f32x4 c0_ = *(const f32x4*)(ck_l + (KB) * 64 + 8 * g_ + 4 * hi), c1_ = *(const f32x4*)(ck_l + (KB) * 64 + 32 + 8 * g_ + 4 * hi); \
              _Pragma("unroll") for (int e_ = 0; e_ < 4; ++e_) { PX0[4 * g_ + e_] = cqs - c0_[e_]; PX1[4 * g_ + e_] = cqs - c1_[e_]; } } }          \
        else { const int d_ = cq - (j_lo + (t)); if (d_ >= 3 || d_ < 0) { const float cf_ = ext_l[191]; _Pragma("unroll") for (int r = 0; r < 16; ++r) { PX0[r] = cf_; PX1[r] = cf_; } }   \
               else { const float* eb_ = ext_l + 64 * d_ + extb; _Pragma("unroll") for (int r = 0; r < 16; ++r) { PX0[r] = eb_[59 - ((r & 3) + 8 * (r >> 2))]; PX1[r] = eb_[27 - ((r & 3) + 8 * (r >> 2))]; } } } } while (0)
#pragma unroll
    for (int d0 = 0; d0 < NQF; ++d0) qr[d0] = load8(cur.Q + (size_t)(wid * QBLK + r32) * DK + d0 * 16 + hi * 8);
    SLOAD_H(cur, KBASE(0));
    if constexpr (MODE == 2) { if (tid < 256) { int rel = tid - 63; rel = rel > 128 ? 128 : rel; ((float*)(lds + Cfg<MODE>::OFF_EXT))[tid] = cur.relb[rel + 128] * SQRT_D; } }
    VMW(); SWRITE_H(0); SBAR();
    if (NT > 1) SLOAD_H(cur, KBASE(1));
    __syncthreads();
#define STEP(t, B_) do { f32x16 p0, p1; float mn, al; bf16x8 pa0, pa1, pa2, pa3;                                                        \
        INITP(p0, p1, t, B_); qkt<MODE, B_>(p0, p1, K_lds, r32, hi, qr, ACT(t));                                              \
        MASKT(p0, p1, t); partialSM<MODE>(p0, p1, m_reg, mn, al); RESC(al); finishSM(p0, p1, al, l_reg, pa0, pa1, pa2, pa3); SBAR();   \
        if ((t) + 1 < NT) { VMW(); SWRITE_H(1 - (B_)); SBAR(); }                                                              \
        pv_tile<B_, SK>(o, vb0, pa0, pa1, pa2, pa3, ACT(t)); SBAR();                                                          \
        if ((t) + 2 < NT) { SLOAD_H(cur, KBASE((t) + 2)); SBAR(); }                                                           \
        __syncthreads(); } while (0)
    for (int t = 0; t < NT; t += 2) { STEP(t, 0); if (t + 1 < NT) STEP(t + 1, 1); }
    if (hi == 0) li_l[r32] = l_reg; asm volatile("s_waitcnt lgkmcnt(0)" ::: "memory");
    float rli[16];
#pragma unroll
    for (int r = 0; r < 16; ++r) rli[r] = __builtin_amdgcn_rcpf(li_l[crow(r, hi)]);
    bf16* Ow = cur.O + (size_t)(wid * QBLK) * cur.ldo;
#pragma unroll
    for (int r = 0; r < 16; ++r) { const int orow = crow(r, hi);
#pragma unroll
        for (int d0 = 0; d0 < 4; ++d0) { const float v = o[d0][r] * rli[r];
            const float vn = __shfl_xor(v, 1);
            if ((r32 & 1) == 0) *(unsigned*)(Ow + (size_t)orow * cur.ldo + d0 * 32 + r32) = cvtpk(v, vn); } }
    __syncthreads();
#undef RESC
#undef KBASE
#undef ACT
#undef MASKT
#undef INITP
#undef STEP
}
#undef KROW
#undef VROW
#undef VMW
#undef SLOAD_H
#undef SWRITE_HK
#undef SWRITE_HV
#undef SWRITE_H
#undef SBAR
}

#define XB_TMO      128
#define XB_XCNT(j)  (256  + 64 * (j))
#define XB_XSUB(j)  (1280 + 64 * (j))
#define XB_XGEN(j)  (2304 + 64 * (j))
#define XB_TOP      3328
#define XB_TOPGEN   3392
#define XCD_BAR_WORDS 3456
#define XB_SPIN_CAP (1u << 18)
__device__ __forceinline__ unsigned xb_ld(unsigned* p)              { return __hip_atomic_load(p, __ATOMIC_RELAXED, __HIP_MEMORY_SCOPE_AGENT); }
__device__ __forceinline__ unsigned xb_add(unsigned* p, unsigned v) { return __hip_atomic_fetch_add(p, v, __ATOMIC_RELAXED, __HIP_MEMORY_SCOPE_AGENT); }
__device__ __forceinline__ unsigned xb_xcc_id() { return (unsigned)__builtin_amdgcn_s_getreg((3 << 11) | 20) & 0xFu; }
#define XB_SPIN(cond, bar) do { unsigned _sp = 0; while (cond) { __builtin_amdgcn_s_sleep(1); \
    if ((++_sp & 255u) == 0u) { if (xb_ld(&(bar)[XB_TMO])) break; if (_sp > XB_SPIN_CAP) { atomicAdd(&(bar)[XB_TMO], 1u); break; } } } } while (0)
struct XcdBarrier { unsigned* bar; unsigned x; volatile LAS unsigned* st; };
__device__ __forceinline__ XcdBarrier xcd_barrier_post(unsigned* bar, volatile LAS unsigned* st) {
    XcdBarrier b; b.bar = bar; b.x = xb_xcc_id(); b.st = st;
    if (threadIdx.x == 0) (void)xb_add(&bar[XB_XCNT(b.x)], 1u);
    return b;
}
__device__ __forceinline__ void xcd_barrier_complete(unsigned* bar, unsigned x, unsigned& nloc, unsigned& nx) {
    const unsigned G = gridDim.x * gridDim.y * gridDim.z;
    unsigned sum, cnt, mine, sp = 0u;
    for (;;) {
        sum = 0u; cnt = 0u; mine = 0u;
#pragma unroll
        for (unsigned j = 0; j < 16; ++j) { const unsigned c = xb_ld(&bar[XB_XCNT(j)]); sum += c; cnt += (c > 0u) ? 1u : 0u; mine = (j == x) ? c : mine; }
        if (sum == G) break;
        __builtin_amdgcn_s_sleep(1);
        if ((++sp & 255u) == 0u) { if (xb_ld(&bar[XB_TMO])) break; if (sp > XB_SPIN_CAP) { atomicAdd(&bar[XB_TMO], 1u); break; } }
    }
    nloc = mine > 0u ? mine : 1u; nx = cnt > 0u ? cnt : 1u;
}
__device__ __forceinline__ void xcd_barrier(const XcdBarrier& b) {
    asm volatile("s_waitcnt vmcnt(0)" ::: "memory");
    __syncthreads();
    if (threadIdx.x == 0) {
        unsigned* bar = b.bar;
        __builtin_amdgcn_s_waitcnt(0);
        unsigned nloc = b.st[0], nx = b.st[1];
        if (nloc == 0u) { xcd_barrier_complete(bar, b.x, nloc, nx); b.st[0] = nloc; b.st[1] = nx; }
        const unsigned old = xb_add(&bar[XB_XSUB(b.x)], 1u);
        const unsigned gen = old / nloc;
        if (old + 1u == (gen + 1u) * nloc) {
            __builtin_amdgcn_fence(__ATOMIC_RELEASE, "agent");
            asm volatile("s_waitcnt vmcnt(0)" ::: "memory");
            const unsigned og = xb_add(&bar[XB_TOP], 1u);
            const unsigned tg = og / nx;
            if (og + 1u == (tg + 1u) * nx) xb_add(&bar[XB_TOPGEN], 1u);
            else XB_SPIN(xb_ld(&bar[XB_TOPGEN]) == tg, bar);
            __builtin_amdgcn_fence(__ATOMIC_ACQUIRE, "agent");
            xb_add(&bar[XB_XGEN(b.x)], 1u);
            asm volatile("s_waitcnt vmcnt(0)" ::: "memory");
        } else {
            XB_SPIN(xb_ld(&bar[XB_XGEN(b.x)]) == gen, bar);
            __builtin_amdgcn_fence(__ATOMIC_ACQUIRE, "agent");
            asm volatile("s_waitcnt vmcnt(0)" ::: "memory");
        }
    }
    __syncthreads();
}

constexpr int NWAVES = 8;
__device__ __forceinline__ float wave_sum(float v) {
#pragma unroll
    for (int o = 1; o < 64; o <<= 1) v += __shfl_xor(v, o);
    return v;
}
__device__ __forceinline__ int colmap_inproj(int n) { if (n < 832) return n; if (n < 840) return 3904 + (n - 832); if (n < 1024) return -1; if (n < 4096) return n - 192; return n - 184; }
__device__ __forceinline__ int colmap_uq(int n) { const int h = n >> 8, j = n & 255; if (j < 128) return h * 192 + j; if (j >= 192) return -1;
    const int p = j - 128, g = p >> 3, w = p & 7; return h * 192 + 128 + (w < 4 ? 4 * g + w : 32 + 4 * g + (w - 4)); }
template <int MAP> __device__ __forceinline__ void transpose_item(const float* W, int K, int Nsrc, const float* gk, bf16* WT, int nblk, LAS float* scr, int item, int lane) {
    const int kb = item / nblk, nb = item % nblk, k0 = 64 * kb, n0 = 32 * nb;
    const int nd = n0 + (lane & 31); const int ns = MAP == 0 ? nd : MAP == 1 ? colmap_inproj(nd) : colmap_uq(nd);
#pragma unroll 8
    for (int i = 0; i < 32; ++i) { const int kk = 2 * i + (lane >> 5); float v = 0.f; if (ns >= 0) { v = W[(size_t)(k0 + kk) * Nsrc + ns]; if (gk) v *= gk[k0 + kk]; } scr[kk * 33 + (lane & 31)] = v; }
    LDS_WAIT(); asm volatile("" ::: "memory");
    const int c = lane & 7;
#pragma unroll
    for (int j = 0; j < 4; ++j) { const int n = (lane >> 3) + 8 * j; const LAS float* s = scr + (8 * c) * 33 + n;
        u32x4 o; o.x = cvt_pk_bf16(s[0 * 33], s[1 * 33]); o.y = cvt_pk_bf16(s[2 * 33], s[3 * 33]); o.z = cvt_pk_bf16(s[4 * 33], s[5 * 33]); o.w = cvt_pk_bf16(s[6 * 33], s[7 * 33]);
        *(u32x4*)(WT + (size_t)(n0 + n) * K + k0 + 8 * c) = o; }
    LDS_WAIT(); asm volatile("" ::: "memory");
}
__device__ __forceinline__ float row_to_bf16(const float* xrow, bf16* orow, int lane) {
    f32x4 v[8]; float s = 0.f;
#pragma unroll
    for (int j = 0; j < 8; ++j) { v[j] = ((const f32x4*)xrow)[lane + 64 * j]; s += sumsq4(v[j]); }
#pragma unroll
    for (int j = 0; j < 8; ++j) { u32x2 w; w.x = cvt_pk_bf16(v[j][0], v[j][1]); w.y = cvt_pk_bf16(v[j][2], v[j][3]); ((u32x2*)orow)[lane + 64 * j] = w; }
    return wave_sum(s);
}

struct Args { const float* in[N_IN]; float* out; unsigned char* ws; int g_lo, g_hi; };
constexpr size_t in_stride(int k) {
    return k == IG_MIX ? 2048 : k == IW_IN ? (size_t)2048 * DIN_SRC : k == IG_CQ ? 512 : k == IW_UQ ? (size_t)512 * 1536 : k == IG_CKV ? 256 : k == IW_UKV ? (size_t)256 * 2048 :
           k == IG_MLAQ ? 192 : k == IG_MLAK ? 192 : k == IB_F ? 8 : k == IG_FOXQ ? 128 : k == IG_FOXK ? 128 : k == IRELB ? 8 * 257 : k == IG_CHQ ? 128 : k == IG_CHK ? 128 :
           k == IW_BR ? (size_t)3 * 1024 * 2048 : k == IW_OUT ? (size_t)2048 * 2048 : k == IG_CROSS ? 2048 : k == IG_MEM ? 2048 : k == IW_XQ ? (size_t)2048 * 512 :
           k == IW_XKV ? (size_t)2048 * 1024 : k == IG_XQ ? 128 : k == IG_XK ? 128 : k == IW_XO ? (size_t)512 * 2048 : k == IG_MLP ? 2048 : k == IW_1 ? (size_t)2048 * 8192 :
           k == IW_2 ? (size_t)8192 * 2048 : 0;
}
#define LIN(k, l) (args.in[k] + (size_t)(l) * in_stride(k))

__device__ __forceinline__ void prologue(const Args& args, LAS unsigned char* lds, int lane, int wave) {
    unsigned char* ws = args.ws;
    LAS float* scr = (LAS float*)(lds + wave * 16384);
    const int gw = blockIdx.x * NWAVES + wave, NGW = gridDim.x * NWAVES;
    constexpr int I_IN = (2048 / 64) * (NIN / 32), I_UQ = (512 / 64) * (2048 / 32), I_UKV = (256 / 64) * (2048 / 32), I_BR1 = (1024 / 64) * (2048 / 32), I_OUT = (2048 / 64) * (2048 / 32),
                  I_XQ = (2048 / 64) * (512 / 32), I_XKV = (2048 / 64) * (1024 / 32), I_XO = (512 / 64) * (2048 / 32), I_1 = (2048 / 64) * (8192 / 32), I_2 = (8192 / 64) * (2048 / 32);
    constexpr int I_LAYER = I_IN + I_UQ + I_UKV + 3 * I_BR1 + I_OUT + I_XQ + I_XKV + I_XO + I_1 + I_2;
    for (int it = gw; it < NL * I_LAYER; it += NGW) {
        const int l = it / I_LAYER; int r = it % I_LAYER;
        unsigned char* wl = ws + WS_W + (size_t)l * W_LAYER;
        if (r < I_IN) { transpose_item<1>(LIN(IW_IN, l), 2048, DIN_SRC, LIN(IG_MIX, l), (bf16*)(wl + WO_IN), NIN / 32, scr, r, lane); continue; } r -= I_IN;
        if (r < I_UQ) { transpose_item<2>(LIN(IW_UQ, l), 512, 1536, LIN(IG_CQ, l), (bf16*)(wl + WO_UQ), 2048 / 32, scr, r, lane); continue; } r -= I_UQ;
        if (r < I_UKV) { transpose_item<0>(LIN(IW_UKV, l), 256, 2048, LIN(IG_CKV, l), (bf16*)(wl + WO_UKV), 2048 / 32, scr, r, lane); continue; } r -= I_UKV;
        if (r < 3 * I_BR1) { const int z = r / I_BR1; transpose_item<0>(LIN(IW_BR, l) + (size_t)z * 1024 * 2048, 1024, 2048, nullptr, (bf16*)(wl + WO_BR) + (size_t)z * 2048 * 1024, 2048 / 32, scr, r % I_BR1, lane); continue; } r -= 3 * I_BR1;
        if (r < I_OUT) { transpose_item<0>(LIN(IW_OUT, l), 2048, 2048, nullptr, (bf16*)(wl + WO_OUT), 2048 / 32, scr, r, lane); continue; } r -= I_OUT;
        if (r < I_XQ) { transpose_item<0>(LIN(IW_XQ, l), 2048, 512, LIN(IG_CROSS, l), (bf16*)(wl + WO_XQ), 512 / 32, scr, r, lane); continue; } r -= I_XQ;
        if (r < I_XKV) { transpose_item<0>(LIN(IW_XKV, l), 2048, 1024, LIN(IG_MEM, l), (bf16*)(wl + WO_XKV), 1024 / 32, scr, r, lane); continue; } r -= I_XKV;
        if (r < I_XO) { transpose_item<0>(LIN(IW_XO, l), 512, 2048, nullptr, (bf16*)(wl + WO_XO), 2048 / 32, scr, r, lane); continue; } r -= I_XO;
        if (r < I_1) { transpose_item<0>(LIN(IW_1, l), 2048, 8192, LIN(IG_MLP, l), (bf16*)(wl + WO_1), 8192 / 32, scr, r, lane); continue; } r -= I_1;
        transpose_item<0>(LIN(IW_2, l), 8192, 2048, nullptr, (bf16*)(wl + WO_2), 2048 / 32, scr, r, lane);
    }
    for (int m = gw; m < T; m += NGW) { const float s = row_to_bf16(args.in[IX] + (size_t)m * DM, (bf16*)(ws + WS_XB) + (size_t)m * DM, lane);
        if (lane < 8) ((float*)(ws + WS_SSQX))[(size_t)m * 8 + lane] = lane == 0 ? s : 0.f; }
    for (int m = gw; m < NBATCH * 256; m += NGW) { const float s = row_to_bf16(args.in[IMEM] + (size_t)m * DM, (bf16*)(ws + WS_MEMB) + (size_t)m * DM, lane);
        if (lane == 0) ((float*)(ws + WS_RSTDMEM))[m] = rsq(s * (1.0f / DM) + EPS); }
    for (int e = gw * 64 + lane; e < NL * 768; e += NGW * 64) { const int l = e / 768, k = (e % 768) >> 7, c = e & 127;
        ((float*)(ws + WS_GT))[e] = k == 0 ? LIN(IG_FOXQ, l)[c] : k == 1 ? LIN(IG_FOXK, l)[c] : k == 3 ? LIN(IG_CHQ, l)[c] : k == 4 ? LIN(IG_CHK, l)[c] : 1.0f; }
    for (int e = gw * 64 + lane; e < SEQ * 32; e += NGW * 64) { const int pos = e >> 5, i = e & 31;
        const float inv = exp2f(-(float)i * (13.287712379549449f / 32.0f)); const float ang = (float)pos * inv;
        ((float*)(ws + WS_COS))[e] = cosf(ang); ((float*)(ws + WS_SIN))[e] = sinf(ang); }
}

__device__ __forceinline__ void cumsum_phase(const float* logf, float* cum, int lane, int wave) {
    const int gw = blockIdx.x * NWAVES + wave;
    if (gw >= NBATCH * 8) return;
    const int b = gw >> 3, h = gw & 7;
    float v[32]; float run = 0.f;
#pragma unroll
    for (int j = 0; j < 32; ++j) { run += logf[((size_t)b * SEQ + lane * 32 + j) * 8 + h]; v[j] = run; }
    float incl = run;
#pragma unroll
    for (int o = 1; o < 64; o <<= 1) { const float t = __shfl_up(incl, o); if (lane >= o) incl += t; }
    const float excl = incl - run;
#pragma unroll
    for (int j = 0; j < 32; ++j) cum[((size_t)b * 8 + h) * SEQ + lane * 32 + j] = v[j] + excl;
}

struct AttnS { const bf16* Q; const bf16* K; const bf16* V; bf16* O; int mode, DK, NH, SK, ldo; const float* cum; const float* relb; };
__device__ __forceinline__ void attn_simple_unit(const AttnS& A, int b, int h, int qt, LAS unsigned char* lds, int tid) {
    const int DK = A.DK, DKP = DK + 1, KP = DK + 2;
    LAS float* qs = (LAS float*)lds;
    LAS bf16* Ks = (LAS bf16*)(lds + 64 * 193 * 4);
    LAS bf16* Vs = (LAS bf16*)(lds + 64 * 193 * 4 + 64 * 194 * 2);
    LAS float* Ps = (LAS float*)(lds + 64 * 193 * 4 + 64 * 194 * 2 + 64 * 130 * 2);
    const int r = tid >> 3, sub = tid & 7;
    const float scale = rsqrtf((float)DK);
    const size_t qbase = ((size_t)(b * A.NH + h) * SEQ + qt * 64) * DK, kvbase = (size_t)(b * A.NH + h) * A.SK;
    __syncthreads();
    for (int e = tid; e < 64 * DK; e += 512) { const int rr = e / DK, d = e % DK; qs[rr * DKP + d] = bf2f(A.Q[qbase + e]) * scale; }
    const int qpos = qt * 64 + r;
    float m_run = -3.0e38f, l_run = 0.f; float o[16];
#pragma unroll
    for (int d = 0; d < 16; ++d) o[d] = 0.f;
    int j_lo = 0, j_hi = qt + 1;
    if (A.mode == 2) j_lo = qt > 8 ? qt - 8 : 0;
    if (A.mode == 3) { j_lo = 0; j_hi = A.SK / 64; }
    const float cq = A.mode == 1 ? A.cum[(size_t)(b * 8 + h) * SEQ + qpos] : 0.f;
    for (int j = j_lo; j < j_hi; ++j) {
        __syncthreads();
        for (int e = tid; e < 64 * DK; e += 512) { const int kk = e / DK, d = e % DK; Ks[kk * KP + d] = A.K[(kvbase + j * 64 + kk) * DK + d]; }
        for (int e = tid; e < 64 * 128; e += 512) { const int kk = e >> 7, d = e & 127; Vs[kk * 130 + d] = A.V[(kvbase + j * 64 + kk) * 128 + d]; }
        __syncthreads();
        float sc[8]; float tmax = -3.0e38f;
#pragma unroll
        for (int kk = 0; kk < 8; ++kk) { const int key = sub + 8 * kk; float s = 0.f;
            for (int d = 0; d < DK; d += 2) { const unsigned w = *(const LAS unsigned*)(Ks + key * KP + d); s += qs[r * DKP + d] * bf_lo(w) + qs[r * DKP + d + 1] * bf_hi(w); }
            const int kpos = j * 64 + key; bool ok = true;
            if (A.mode == 1) { ok = kpos <= qpos; s += cq - A.cum[(size_t)(b * 8 + h) * SEQ + kpos]; }
            if (A.mode == 2) { int rel = qpos - kpos; rel = rel < -128 ? -128 : rel > 128 ? 128 : rel; s += A.relb[h * 257 + rel + 128]; }
            s = ok ? s : -1.0e30f; sc[kk] = s; tmax = fmaxf(tmax, s); }
        tmax = fmaxf(tmax, __shfl_xor(tmax, 1)); tmax = fmaxf(tmax, __shfl_xor(tmax, 2)); tmax = fmaxf(tmax, __shfl_xor(tmax, 4));
        const float m_new = fmaxf(m_run, tmax), alpha = __expf(m_run - m_new); float ps = 0.f;
#pragma unroll
        for (int kk = 0; kk < 8; ++kk) { const float p = __expf(sc[kk] - m_new); ps += p; Ps[r * 65 + sub + 8 * kk] = p; }
        ps += __shfl_xor(ps, 1); ps += __shfl_xor(ps, 2); ps += __shfl_xor(ps, 4);
        l_run = l_run * alpha + ps; m_run = m_new;
        __syncthreads();
#pragma unroll
        for (int d = 0; d < 16; ++d) o[d] *= alpha;
        for (int key = 0; key < 64; ++key) { const float p = Ps[r * 65 + key];
#pragma unroll
            for (int d = 0; d < 16; d += 2) { const unsigned w = *(const LAS unsigned*)(Vs + key * 130 + sub * 16 + d); o[d] += p * bf_lo(w); o[d + 1] += p * bf_hi(w); } }
    }
    const float il = 1.0f / l_run;
    bf16* op = A.O + (size_t)(b * SEQ + qt * 64 + r) * A.ldo + h * 128 + sub * 16;
    u32x4 w0, w1; w0.x = cvt_pk_bf16(o[0] * il, o[1] * il); w0.y = cvt_pk_bf16(o[2] * il, o[3] * il); w0.z = cvt_pk_bf16(o[4] * il, o[5] * il); w0.w = cvt_pk_bf16(o[6] * il, o[7] * il);
    w1.x = cvt_pk_bf16(o[8] * il, o[9] * il); w1.y = cvt_pk_bf16(o[10] * il, o[11] * il); w1.z = cvt_pk_bf16(o[12] * il, o[13] * il); w1.w = cvt_pk_bf16(o[14] * il, o[15] * il);
    *(u32x4*)op = w0; *(u32x4*)(op + 8) = w1;
}

constexpr int NPH = 10;
constexpr int NPHASE = 1 + NL * NPH;
__global__ void __launch_bounds__(NWAVES * 64, 2) fwd_kernel(Args args) {
    extern __shared__ __attribute__((aligned(16))) unsigned char lds_raw[];
    LAS unsigned char* lds = (LAS unsigned char*)lds_raw;
    volatile LAS unsigned* MISC = (volatile LAS unsigned*)(lds + MISC_OFF);
    const int tid0 = threadIdx.x, wave = __builtin_amdgcn_readfirstlane(tid0 >> 6);
    const int G = gridDim.x, bx = blockIdx.x, vcu = (G % 8 == 0) ? (bx % 8) * (G / 8) + bx / 8 : bx;
    unsigned char* const ws0 = args.ws;
    unsigned* ctl = (unsigned*)(ws0 + WS_CTL);
    for (int u = tid0; u < 256; u += NWAVES * 64) MISC[u] = 0u;
    __syncthreads();
#if MK_PER_PHASE
#define SEAM(g) do { } while (0)
#else
    XcdBarrier bar = xcd_barrier_post(ctl + 4096, MISC + 8);
#define SEAM(g) do { if ((g) + 1 < g_hi) xcd_barrier(bar); } while (0)
#endif
    const int g_lo = args.g_lo, g_hi = args.g_hi;
#ifndef PH_MASK
#define PH_MASK 0x7ff
#endif
#define IN(g) (g_lo <= (g) && (g) < g_hi)
    LAS float* escr = (LAS float*)(lds + ESCR_OFF);

    if ((PH_MASK & 1) && IN(0)) { prologue(args, lds, tid0 & 63, wave); SEAM(0); }

#define OPAQUE_PTRS() size_t zoff_ = 0; asm volatile("" : "+s"(zoff_)); unsigned char* ws = ws0 + zoff_;     \
    int tid = tid0; asm volatile("" : "+v"(tid)); const int lane = tid & 63; (void)lane; unsigned char* wl = ws + WS_W + (size_t)l * W_LAYER; float* ssqx = (float*)(ws + WS_SSQX); bf16* xb = (bf16*)(ws + WS_XB); \
    const float* cosT = (const float*)(ws + WS_COS); const float* sinT = (const float*)(ws + WS_SIN); (void)wl; (void)ssqx; (void)xb; (void)cosT; (void)sinT
    for (int l = 0; l < NL; ++l) {
        const int gb = 1 + l * NPH;
        if ((PH_MASK & 2) && IN(gb + 0)) {
            OPAQUE_PTRS();
            pg8::Gemm g{xb, (const bf16*)(wl + WO_IN), T, NIN, 2048, 0, 0}; pg8::StaticOrder S; S.init(T, NIN, G, bx);
            EpiInProj E{ssqx, (bf16*)(ws + WS_CQ), (float*)(ws + WS_SSQCQ), (bf16*)(ws + WS_CKV), (float*)(ws + WS_SSQCKV), (float*)(ws + WS_KR), (float*)(ws + WS_SSQKR),
                        (float*)(ws + WS_LOGF), LIN(IB_F, l), (bf16*)(ws + WS_FQ), (const float*)(ws + WS_GT) + l * 768, (bf16*)(ws + WS_GATES), escr};
            pg8::gemm_phase<EpiInProj, pg8::StaticOrder, true, true>(lds, g, S, E);
            SEAM(gb + 0);
        }
        if ((PH_MASK & 4) && IN(gb + 1)) {
            OPAQUE_PTRS();
#ifndef P1MASK
#define P1MASK 7
#endif
            if (P1MASK & 1) { pg8::Gemm g{(const bf16*)(ws + WS_CQ), (const bf16*)(wl + WO_UQ), T, 2048, 512, 0, 0}; pg8::StaticOrder S; S.init(T, 2048, G, bx);
              EpiQUp E{(const float*)(ws + WS_SSQCQ), LIN(IG_MLAQ, l), cosT, sinT, (bf16*)(ws + WS_MQ), escr};
              pg8::gemm_phase<EpiQUp, pg8::StaticOrder, true, true>(lds, g, S, E); }
            if (P1MASK & 2) { pg8::Gemm g{(const bf16*)(ws + WS_CKV), (const bf16*)(wl + WO_UKV), T, 2048, 256, 0, 0}; pg8::StaticOrder S; S.init(T, 2048, G, bx);
              EpiKvUp E{(const float*)(ws + WS_SSQCKV), (const float*)(ws + WS_SSQKR), (const float*)(ws + WS_KR), LIN(IG_MLAK, l), cosT, sinT, (bf16*)(ws + WS_MK), (bf16*)(ws + WS_MV), escr + 2048};
              pg8::gemm_phase<EpiKvUp, pg8::StaticOrder, true, true>(lds, g, S, E); }
            if (P1MASK & 4) cumsum_phase((const float*)(ws + WS_LOGF), (float*)(ws + WS_CUM), lane, wave);
            SEAM(gb + 1);
        }
        if ((PH_MASK & 8) && IN(gb + 2)) {
            OPAQUE_PTRS();
#if ATTN_SIMPLE
            for (int it = bx; it < 3 * NBATCH * 8 * 32; it += G) {
                const int br = it / (NBATCH * 8 * 32), r = it % (NBATCH * 8 * 32), b = r / (8 * 32), h = (r / 32) % 8, qt = 31 - (r % 32);
                AttnS A;
                if (br == 0) A = AttnS{(const bf16*)(ws + WS_MQ), (const bf16*)(ws + WS_MK), (const bf16*)(ws + WS_MV), (bf16*)(ws + WS_Y), 0, 192, 8, SEQ, 1024, nullptr, nullptr};
                else if (br == 1) A = AttnS{(const bf16*)(ws + WS_FQ), (const bf16*)(ws + WS_FK), (const bf16*)(ws + WS_FV), (bf16*)(ws + WS_Y) + (size_t)T * 1024, 1, 128, 8, SEQ, 1024, (const float*)(ws + WS_CUM), nullptr};
                else A = AttnS{(const bf16*)(ws + WS_CHQ), (const bf16*)(ws + WS_CHK), (const bf16*)(ws + WS_CHV), (bf16*)(ws + WS_Y) + (size_t)2 * T * 1024, 2, 128, 8, SEQ, 1024, nullptr, LIN(IRELB, l)};
                attn_simple_unit(A, b, h, qt, lds, tid);
            }
#else
            for (int c = vcu; c < 256; c += G) {
                const int bh = c >> 3, q = c & 7, b = bh >> 3, h = bh & 7;
#ifndef A2MASK
#define A2MASK 7
#endif
                if (A2MASK & 1) { const int qb = q; const att::Blk k{(const bf16*)(ws + WS_MQ) + ((size_t)bh * SEQ + qb * 256) * 192, (const bf16*)(ws + WS_MK) + (size_t)bh * SEQ * 192, (const bf16*)(ws + WS_MV) + (size_t)bh * SEQ * 128,
                      (bf16*)(ws + WS_Y) + ((size_t)b * SEQ + qb * 256) * 1024 + h * 128, qb * 256, 1024, nullptr, nullptr};
                  att::attn_block<0>(k, SEQ, (char*)lds_raw); }
                if (A2MASK & 2) { const int qb = 7 - q; const att::Blk k{(const bf16*)(ws + WS_FQ) + ((size_t)bh * SEQ + qb * 256) * 128, (const bf16*)(ws + WS_FK) + (size_t)bh * SEQ * 128, (const bf16*)(ws + WS_FV) + (size_t)bh * SEQ * 128,
                      (bf16*)(ws + WS_Y) + (size_t)T * 1024 + ((size_t)b * SEQ + qb * 256) * 1024 + h * 128, qb * 256, 1024, (const float*)(ws + WS_CUM) + (size_t)bh * SEQ, nullptr};
                  att::attn_block<1>(k, SEQ, (char*)lds_raw); }
                if (A2MASK & 4) { const int qb = q == 7 ? 0 : q == 6 ? 1 : 7 - q; const att::Blk k{(const bf16*)(ws + WS_CHQ) + ((size_t)bh * SEQ + qb * 256) * 128, (const bf16*)(ws + WS_CHK) + (size_t)bh * SEQ * 128, (const bf16*)(ws + WS_CHV) + (size_t)bh * SEQ * 128,
                      (bf16*)(ws + WS_Y) + (size_t)2 * T * 1024 + ((size_t)b * SEQ + qb * 256) * 1024 + h * 128, qb * 256, 1024, nullptr, LIN(IRELB, l) + h * 257};
                  att::attn_block<2>(k, SEQ, (char*)lds_raw); }
            }
#endif
            __syncthreads();
            SEAM(gb + 2);
        }
        if ((PH_MASK & 16) && IN(gb + 3)) {
            OPAQUE_PTRS();
            pg8::Gemm g{(const bf16*)(ws + WS_Y), (const bf16*)(wl + WO_BR), T, 2048, 1024, (size_t)T * 1024 * 2, (size_t)2048 * 1024 * 2}; pg8::ZOrder<3> S; S.init(T, 2048, G, bx);
            EpiBr E{(const bf16*)(ws + WS_GATES), (bf16*)(ws + WS_MERGED)};
            pg8::gemm_phase<EpiBr, pg8::ZOrder<3>, true, true>(lds, g, S, E);
            SEAM(gb + 3);
        }
        if ((PH_MASK & 32) && IN(gb + 4)) {
            OPAQUE_PTRS();
            pg8::Gemm g{(const bf16*)(ws + WS_MERGED), (const bf16*)(wl + WO_OUT), T, 2048, 2048, 0, 0}; pg8::StaticOrder S; S.init(T, 2048, G, bx);
            EpiResid E{l == 0 ? args.in[IX] : args.out, args.out, xb, ssqx, escr};
            pg8::gemm_phase<EpiResid, pg8::StaticOrder, true, true>(lds, g, S, E);
            SEAM(gb + 4);
        }
        if ((PH_MASK & 64) && IN(gb + 5)) {
            OPAQUE_PTRS();
            { pg8::Gemm g{xb, (const bf16*)(wl + WO_XQ), T, 512, 2048, 0, 0}; pg8::StaticOrder S; S.init(T, 512, G, bx);
              EpiHeadNorm E{ssqx, nullptr, LIN(IG_XQ, l), (bf16*)(ws + WS_XQ), nullptr, 2, SEQ, 11, escr};
              pg8::gemm_phase<EpiHeadNorm, pg8::StaticOrder, true, true>(lds, g, S, E); }
            { pg8::Gemm g{(const bf16*)(ws + WS_MEMB), (const bf16*)(wl + WO_XKV), NBATCH * 256, 1024, 2048, 0, 0}; pg8::StaticOrder S; S.init(NBATCH * 256, 1024, G, (bx + G - 64) % G);
              EpiHeadNorm E{nullptr, (const float*)(ws + WS_RSTDMEM), LIN(IG_XK, l), (bf16*)(ws + WS_XK), (bf16*)(ws + WS_XV), 2, 256, 8, escr + 2048};
              pg8::gemm_phase<EpiHeadNorm, pg8::StaticOrder, true, true>(lds, g, S, E); }
            SEAM(gb + 5);
        }
        if ((PH_MASK & 128) && IN(gb + 6)) {
            OPAQUE_PTRS();
#if ATTN_SIMPLE
            for (int it = bx; it < NBATCH * 4 * 32; it += G) {
                const int b = it / (4 * 32), h = (it / 32) % 4, qt = it % 32;
                const AttnS A{(const bf16*)(ws + WS_XQ), (const bf16*)(ws + WS_XK), (const bf16*)(ws + WS_XV), (bf16*)(ws + WS_OX), 3, 128, 4, 256, 512, nullptr, nullptr};
                attn_simple_unit(A, b, h, qt, lds, tid);
            }
#else
            for (int c = vcu; c < 128; c += G) {
                const int bh = c >> 3, qb = c & 7, b = bh >> 2, h = bh & 3;
                const att::Blk k{(const bf16*)(ws + WS_XQ) + ((size_t)bh * SEQ + qb * 256) * 128, (const bf16*)(ws + WS_XK) + (size_t)bh * 256 * 128, (const bf16*)(ws + WS_XV) + (size_t)bh * 256 * 128,
                    (bf16*)(ws + WS_OX) + ((size_t)b * SEQ + qb * 256) * 512 + h * 128, qb * 256, 512, nullptr, nullptr};
                att::attn_block<3>(k, 256, (char*)lds_raw);
            }
#endif
            __syncthreads();
            SEAM(gb + 6);
        }
        if ((PH_MASK & 256) && IN(gb + 7)) {
            OPAQUE_PTRS();
            pg8::Gemm g{(const bf16*)(ws + WS_OX), (const bf16*)(wl + WO_XO), T, 2048, 512, 0, 0}; pg8::StaticOrder S; S.init(T, 2048, G, bx);
            EpiResid E{args.out, args.out, xb, ssqx, escr};
            pg8::gemm_phase<EpiResid, pg8::StaticOrder, true, true>(lds, g, S, E);
            SEAM(gb + 7);
        }
        if ((PH_MASK & 512) && IN(gb + 8)) {
            OPAQUE_PTRS();
            pg8::Gemm g{xb, (const bf16*)(wl + WO_1), T, FF, 2048, 0, 0}; pg8::StaticOrder S; S.init(T, FF, G, bx);
            EpiMlp1 E{ssqx, (bf16*)(ws + WS_H)};
            pg8::gemm_phase<EpiMlp1, pg8::StaticOrder, true, true>(lds, g, S, E);
            SEAM(gb + 8);
        }
        if ((PH_MASK & 1024) && IN(gb + 9)) {
            OPAQUE_PTRS();
            pg8::Gemm g{(const bf16*)(ws + WS_H), (const bf16*)(wl + WO_2), T, 2048, FF, 0, 0}; pg8::StaticOrder S; S.init(T, 2048, G, bx);
            EpiResid E{args.out, args.out, xb, ssqx, escr};
            pg8::gemm_phase<EpiResid, pg8::StaticOrder, true, true>(lds, g, S, E);
            SEAM(gb + 9);
        }
    }
#undef IN
#undef SEAM
}

extern "C" void kernel_launch(void* const* d_in, const int* in_sizes, int n_in, void* d_out, int out_size, void* d_ws, size_t ws_size, hipStream_t stream) {
    static int grid = 0;
    if (grid == 0) {
        if (n_in != N_IN || in_sizes[0] != T * DM || out_size != T * DM || ws_size < WS_END) { fprintf(stderr, "kernel_launch: unexpected shapes (n_in %d, in0 %d, out %d, ws %zu < %zu)\n", n_in, n_in > 0 ? in_sizes[0] : -1, out_size, ws_size, (size_t)WS_END); grid = -1; return; }
        int dev = 0, cus = 0, per_cu = 0;
        if (hipGetDevice(&dev) != hipSuccess || hipDeviceGetAttribute(&cus, hipDeviceAttributeMultiprocessorCount, dev) != hipSuccess) { grid = -1; return; }
        if (hipFuncSetAttribute((const void*)fwd_kernel, hipFuncAttributeMaxDynamicSharedMemorySize, LDS_BYTES) != hipSuccess) { fprintf(stderr, "kernel_launch: hipFuncSetAttribute failed\n"); grid = -1; return; }
        if (hipOccupancyMaxActiveBlocksPerMultiprocessor(&per_cu, (const void*)fwd_kernel, NWAVES * 64, LDS_BYTES) != hipSuccess || per_cu < 1) fprintf(stderr, "kernel_launch: occupancy query reports %d\n", per_cu);
        (void)hipGetLastError();
        grid = cus;
    }
    if (grid < 0) return;
    if (hipMemsetAsync((char*)d_ws + WS_CTL, 0, CTL_ZERO_BYTES, stream) != hipSuccess) return;
    Args a{};
    for (int i = 0; i < N_IN; ++i) a.in[i] = (const float*)d_in[i];
    a.out = (float*)d_out; a.ws = (unsigned char*)d_ws;
#if MK_PER_PHASE
    for (int g = 0; g < NPHASE; ++g) { a.g_lo = g; a.g_hi = g + 1; hipLaunchKernelGGL(fwd_kernel, dim3(grid), dim3(NWAVES * 64), LDS_BYTES, stream, a); }
#else
    a.g_lo = 0; a.g_hi = NPHASE;
    hipLaunchKernelGGL(fwd_kernel, dim3(grid), dim3(NWAVES * 64), LDS_BYTES, stream, a);
#endif
    const hipError_t le = hipPeekAtLastError();
    if (le != hipSuccess) fprintf(stderr, "kernel_launch: launch failed: %s\n", hipGetErrorName(le));
}
```

```cpp
#include <hip/hip_runtime.h>
#include <cstdio>
#include <cstdint>

#ifndef MK_PER_PHASE
#define MK_PER_PHASE 0
#endif

#ifndef ATTN_SIMPLE
#define ATTN_SIMPLE 0
#endif

namespace pg8 {
#define PG8_LAS __attribute__((address_space(3)))
typedef unsigned short bf16_t;
typedef short bf16x8 __attribute__((ext_vector_type(8)));
typedef float f32x4 __attribute__((ext_vector_type(4)));
typedef unsigned u32x4 __attribute__((ext_vector_type(4)));
constexpr int BM = 256, BK = 64, HALF = 128, HTB = HALF * BK * 2  , STAGE_BYTES = 8 * HTB, NXCD = 8, WGM = 8;

__host__ __device__ __forceinline__ int lds_byte(int r, int c) { const int st = (r >> 4) * 2 + (c >> 5), rr = r & 15, cc = c & 31, ob = rr * 64 + cc * 2; return st * 1024 + (ob ^ (((ob >> 9) & 1) << 5)); }
__host__ __device__ __forceinline__ void stage_rc(int b, int& R, int& C) { const int st = b / 1024, sb = b % 1024, swz = sb ^ (((sb >> 9) & 1) << 5); R = (st >> 1) * 16 + swz / 64; C = (st & 1) * 32 + (swz % 64) / 2; }
__host__ __device__ __forceinline__ int perm32(int rho) { const int n = rho >> 4, i = rho & 15; return 8 * (i >> 2) + 4 * n + (i & 3); }

struct Unit { int pm, pn, z; };
struct Gemm { const bf16_t* A; const bf16_t* Bt; int M, N, K; size_t zA, zB; };

struct StaticOrder {
    int nM, nN, nwg, G, c;
    __host__ __device__ void init(int M, int N, int G_, int c_) { nM = M / BM; nN = N / BM; nwg = nM * nN; G = G_; c = c_; }
    __host__ __device__ bool next(int i, Unit& u) const {
        const long L = (long)i * G + c; if (L >= nwg) return false;
        int wgid = (int)L; { const int q = nwg / NXCD, r = nwg % NXCD, xcd = wgid % NXCD, off = wgid / NXCD; wgid = (xcd < r ? xcd * (q + 1) : r * (q + 1) + (xcd - r) * q) + off; }
        const int nig = WGM * nN, gid = wgid / nig, fm = gid * WGM, gsz = (nM - fm) < WGM ? (nM - fm) : WGM;
        u.pm = fm + ((wgid % nig) % gsz); u.pn = (wgid % nig) / gsz; u.z = 0; return true;
    }
    __device__ __forceinline__ void a_ready(const Unit&) const {}
    __device__ __forceinline__ void done(const Unit&) const {}
};

template <int NZ> struct ZOrder {
    StaticOrder so;
    __host__ __device__ void init(int M, int N, int G_, int c_) { so.init(M, N, G_, c_); }
    __host__ __device__ bool next(int i, Unit& u) const { if (!so.next(i / NZ, u)) return false; u.z = i % NZ; return true; }
    __device__ __forceinline__ void a_ready(const Unit&) const {}
    __device__ __forceinline__ void done(const Unit&) const {}
};

__device__ __forceinline__ unsigned cvt_pk_bf16(float lo, float hi) { unsigned r; asm volatile("v_cvt_pk_bf16_f32 %0, %1, %2" : "=v"(r) : "v"(lo), "v"(hi)); return r; }
typedef float f32x2 __attribute__((ext_vector_type(2)));
template <class Epi, class Sched, bool ALIGN_EPI = false, bool SP2 = false>
__device__ __forceinline__ void gemm_phase(PG8_LAS unsigned char* lds, const Gemm g, const Sched& S, const Epi& E) {
    int tid_ = threadIdx.x; asm volatile("" : "+v"(tid_));
    const int tid = tid_, wid = __builtin_amdgcn_readfirstlane(tid >> 6), lane = tid & 63, wr = wid >> 2, wc = wid & 3, fr = lane & 15, fq = lane >> 4;
    const int K = g.K, nt = K / BK;
    unsigned voffA[2], voffB[2];
#pragma unroll
    for (int i = 0; i < 2; ++i) { int R, C; stage_rc(tid * 16 + i * 8192, R, C); const int Rb = Epi::PERM ? ((R & ~31) + perm32(R & 31)) : R;
        voffA[i] = (unsigned)(R * K + C) * 2u; voffB[i] = (unsigned)(Rb * K + C) * 2u; }
    const size_t kstep = (size_t)(BK * 2);
    const size_t hstep = (size_t)HALF * K * 2;
    const size_t tstep = 2 * hstep;
    const unsigned ldsw = (unsigned)wid * 1024u;
    const int aoff = lds_byte(wr * 64 + fr, fq * 8), boff = lds_byte(wc * 32 + fr, fq * 8);
#define PG8_SA(b, h) (((b) * 2 + (h)) * HTB)
#define PG8_SB(b, h) ((4 + (b) * 2 + (h)) * HTB)
#define PG8_STAGE(bufoff, gbase, voff) do { _Pragma("unroll") for (int _i = 0; _i < 2; ++_i) \
        __builtin_amdgcn_global_load_lds((const unsigned*)((const char*)(gbase) + (voff)[_i]), (PG8_LAS unsigned*)(lds + (bufoff) + ldsw + _i * 8192), 16, 0, 0); } while (0)
#define PG8_LDA(dst, b, h) do { _Pragma("unroll") for (int m = 0; m < 4; ++m) _Pragma("unroll") for (int k = 0; k < 2; ++k) dst[m][k] = *(const PG8_LAS bf16x8*)(lds + PG8_SA(b, h) + aoff + m * 2048 + k * 1024); } while (0)
#define PG8_LDB(dst, b, h) do { _Pragma("unroll") for (int n = 0; n < 2; ++n) _Pragma("unroll") for (int k = 0; k < 2; ++k) dst[n][k] = *(const PG8_LAS bf16x8*)(lds + PG8_SB(b, h) + boff + n * 2048 + k * 1024); } while (0)
#define PG8_MMA(ai, bj, At, Bt) do { __builtin_amdgcn_s_setprio(1); _Pragma("unroll") for (int m = 0; m < 4; ++m) _Pragma("unroll") for (int n = 0; n < 2; ++n) _Pragma("unroll") for (int k = 0; k < 2; ++k) \
        acc[ai][bj][m][n] = __builtin_amdgcn_mfma_f32_16x16x32_bf16(Bt[n][k], At[m][k], acc[ai][bj][m][n], 0, 0, 0); __builtin_amdgcn_s_setprio(0); } while (0)
#define PG8_WAIT_V(n) asm volatile("s_waitcnt vmcnt(" #n ")" ::: "memory")
#define PG8_WAIT_L(n) asm volatile("s_waitcnt lgkmcnt(" #n ")" ::: "memory")
#define PG8_BAR __builtin_amdgcn_s_barrier()
#define PG8_SCHED __builtin_amdgcn_sched_barrier(0)
    Unit cur, nxt; int ui = 0;
    if (!S.next(0, cur)) return;
    f32x4 acc[2][2][4][2];
#pragma unroll
    for (int a = 0; a < 2; ++a)
#pragma unroll
        for (int b = 0; b < 2; ++b)
#pragma unroll
            for (int m = 0; m < 4; ++m)
#pragma unroll
                for (int n = 0; n < 2; ++n) acc[a][b][m][n] = (f32x4){0.f, 0.f, 0.f, 0.f};
    bf16x8 At[4][2], B0[2][2], B1[2][2];
    const char* cA = (const char*)g.A + (size_t)cur.pm * tstep + (size_t)cur.z * g.zA; const char* cB = (const char*)g.Bt + (size_t)cur.pn * tstep + (size_t)cur.z * g.zB;
    S.a_ready(cur);
    if constexpr (SP2) {
        PG8_STAGE(PG8_SB(0, 0), cB, voffB); PG8_STAGE(PG8_SB(0, 1), cB + hstep, voffB); PG8_STAGE(PG8_SA(0, 0), cA, voffA); PG8_STAGE(PG8_SA(0, 1), cA + hstep, voffA);
        if (wr == 1) PG8_BAR;
        PG8_WAIT_V(2); PG8_BAR;
        PG8_STAGE(PG8_SB(1, 0), cB + kstep, voffB); PG8_STAGE(PG8_SA(1, 0), cA + kstep, voffA); PG8_STAGE(PG8_SB(1, 1), cB + hstep + kstep, voffB);
        PG8_WAIT_V(6); PG8_BAR;
    } else {
        PG8_STAGE(PG8_SB(0, 0), cB, voffB); PG8_STAGE(PG8_SA(0, 0), cA, voffA); PG8_STAGE(PG8_SB(0, 1), cB + hstep, voffB); PG8_STAGE(PG8_SA(0, 1), cA + hstep, voffA);
        if (wr == 1) PG8_BAR;
        PG8_WAIT_V(4); PG8_BAR;
        PG8_STAGE(PG8_SB(1, 0), cB + kstep, voffB); PG8_STAGE(PG8_SA(1, 0), cA + kstep, voffA); PG8_STAGE(PG8_SB(1, 1), cB + hstep + kstep, voffB);
        PG8_WAIT_V(6); PG8_BAR;
    }
    for (;;) {
        const bool has_next = S.next(ui + 1, nxt);
        const char* nA = has_next ? (const char*)g.A + (size_t)nxt.pm * tstep + (size_t)nxt.z * g.zA : cA; const char* nB = has_next ? (const char*)g.Bt + (size_t)nxt.pn * tstep + (size_t)nxt.z * g.zB : cB;
#pragma unroll 1
        for (int t = 0; t < nt; t += 2) {
            const bool last = (t == nt - 2);
            const char* a1 = cA + (size_t)(t + 1) * kstep;
            const char* a2 = last ? nA : cA + (size_t)(t + 2) * kstep; const char* b2 = last ? nB : cB + (size_t)(t + 2) * kstep;
            const char* a3 = a2 + kstep; const char* b3 = b2 + kstep;
            if (last && has_next) S.a_ready(nxt);
            if constexpr (SP2) {
            PG8_LDB(B0, 0, 0); PG8_LDB(B1, 0, 1); PG8_SCHED; PG8_LDA(At, 0, 0); PG8_STAGE(PG8_SA(1, 1), a1 + hstep, voffA);
            PG8_WAIT_V(8); PG8_WAIT_L(0); PG8_BAR; PG8_MMA(0, 0, At, B0); PG8_MMA(0, 1, At, B1); PG8_BAR; PG8_SCHED;
            PG8_LDA(At, 0, 1); PG8_STAGE(PG8_SB(0, 0), b2, voffB); PG8_STAGE(PG8_SB(0, 1), b2 + hstep, voffB); PG8_STAGE(PG8_SA(0, 0), a2, voffA);
            PG8_WAIT_V(8); PG8_WAIT_L(0); PG8_BAR; PG8_MMA(1, 0, At, B0); PG8_MMA(1, 1, At, B1); PG8_BAR; PG8_SCHED;
            PG8_LDB(B0, 1, 0); PG8_LDB(B1, 1, 1); PG8_SCHED; PG8_LDA(At, 1, 0); PG8_STAGE(PG8_SA(0, 1), a2 + hstep, voffA);
            PG8_WAIT_V(8); PG8_WAIT_L(0); PG8_BAR; PG8_MMA(0, 0, At, B0); PG8_MMA(0, 1, At, B1); PG8_BAR; PG8_SCHED;
            PG8_LDA(At, 1, 1); PG8_STAGE(PG8_SB(1, 0), b3, voffB); PG8_STAGE(PG8_SB(1, 1), b3 + hstep, voffB); PG8_STAGE(PG8_SA(1, 0), a3, voffA);
            PG8_WAIT_V(8); PG8_WAIT_L(0); PG8_BAR; PG8_MMA(1, 0, At, B0); PG8_MMA(1, 1, At, B1); PG8_BAR; PG8_SCHED;
            } else {
            PG8_LDB(B0, 0, 0); PG8_SCHED; PG8_LDA(At, 0, 0); PG8_STAGE(PG8_SA(1, 1), a1 + hstep, voffA);
            PG8_WAIT_L(8); PG8_BAR; PG8_WAIT_L(0); PG8_MMA(0, 0, At, B0); PG8_BAR; PG8_SCHED;
            PG8_LDB(B1, 0, 1); PG8_STAGE(PG8_SB(0, 0), b2, voffB);
            PG8_BAR; PG8_WAIT_L(0); PG8_MMA(0, 1, At, B1); PG8_BAR;
            PG8_LDA(At, 0, 1); PG8_STAGE(PG8_SA(0, 0), a2, voffA);
            PG8_BAR; PG8_WAIT_L(0); PG8_MMA(1, 0, At, B0); PG8_BAR; PG8_SCHED;
            PG8_STAGE(PG8_SB(0, 1), b2 + hstep, voffB);
            PG8_WAIT_V(6); PG8_BAR; PG8_MMA(1, 1, At, B1); PG8_BAR;
            PG8_LDB(B0, 1, 0); PG8_SCHED; PG8_LDA(At, 1, 0); PG8_STAGE(PG8_SA(0, 1), a2 + hstep, voffA);
            PG8_WAIT_L(8); PG8_BAR; PG8_WAIT_L(0); PG8_MMA(0, 0, At, B0); PG8_BAR; PG8_SCHED;
            PG8_LDB(B1, 1, 1); PG8_STAGE(PG8_SB(1, 0), b3, voffB);
            PG8_BAR; PG8_WAIT_L(0); PG8_MMA(0, 1, At, B1); PG8_BAR;
            PG8_LDA(At, 1, 1); PG8_STAGE(PG8_SA(1, 0), a3, voffA);
            PG8_BAR; PG8_WAIT_L(0); PG8_MMA(1, 0, At, B0); PG8_BAR; PG8_SCHED;
            PG8_STAGE(PG8_SB(1, 1), b3 + hstep, voffB);
            PG8_WAIT_V(6); PG8_BAR; PG8_MMA(1, 1, At, B1); PG8_BAR;
            }
        }
        if constexpr (ALIGN_EPI) { if (wr == 0) PG8_BAR; }
        if constexpr (!Epi::AFTER_DRAIN) { E(acc, cur, wr, wc, fr, fq); S.done(cur); }
        if (!has_next) break;
#pragma unroll
        for (int a = 0; a < 2; ++a)
#pragma unroll
            for (int b = 0; b < 2; ++b)
#pragma unroll
                for (int m = 0; m < 4; ++m)
#pragma unroll
                    for (int n = 0; n < 2; ++n) acc[a][b][m][n] = (f32x4){0.f, 0.f, 0.f, 0.f};
        cur = nxt; cA = nA; cB = nB; ++ui;
        if constexpr (ALIGN_EPI) { if (wr == 1) PG8_BAR; }
    }
    PG8_WAIT_V(0);
    if constexpr (!ALIGN_EPI) { if (wr == 0) PG8_BAR; }
    PG8_BAR;
    if constexpr (Epi::AFTER_DRAIN) { E.fused(acc, cur, wr, wc, fr, fq, lds, wid, lane); S.done(cur); }
#undef PG8_SA
#undef PG8_SB
#undef PG8_STAGE
#undef PG8_LDA
#undef PG8_LDB
#undef PG8_MMA
#undef PG8_WAIT_V
#undef PG8_WAIT_L
#undef PG8_BAR
#undef PG8_SCHED
}
}

constexpr int NBATCH = 4, SEQ = 2048, DM = 2048, T = NBATCH * SEQ, NL = 4, FF = 8192;
constexpr int NIN = 13312;
constexpr int DIN_SRC = 13128;
constexpr float EPS = 1e-6f;
enum { IX = 0, IMEM, IG_MIX, IW_IN, IG_CQ, IW_UQ, IG_CKV, IW_UKV, IG_MLAQ, IG_MLAK, IB_F, IG_FOXQ, IG_FOXK, IRELB, IG_CHQ, IG_CHK, IW_BR, IW_OUT,
       IG_CROSS, IG_MEM, IW_XQ, IW_XKV, IG_XQ, IG_XK, IW_XO, IG_MLP, IW_1, IW_2, N_IN };

constexpr size_t MiB = 1u << 20;
constexpr size_t WS_CTL = 0, CTL_ZERO_BYTES = 1 * MiB;
constexpr size_t WS_COS = 1 * MiB, WS_SIN = WS_COS + 256 * 1024, WS_RSTDMEM = WS_SIN + 256 * 1024, WS_GT = WS_RSTDMEM + 4096;
constexpr size_t WS_W = 2 * MiB;
constexpr size_t WO_IN = 0, WO_UQ = WO_IN + (size_t)NIN * 2048 * 2, WO_UKV = WO_UQ + (size_t)2048 * 512 * 2, WO_BR = WO_UKV + (size_t)2048 * 256 * 2,
                 WO_OUT = WO_BR + (size_t)3 * 2048 * 1024 * 2, WO_XQ = WO_OUT + (size_t)2048 * 2048 * 2, WO_XKV = WO_XQ + (size_t)512 * 2048 * 2,
                 WO_XO = WO_XKV + (size_t)1024 * 2048 * 2, WO_1 = WO_XO + (size_t)2048 * 512 * 2, WO_2 = WO_1 + (size_t)8192 * 2048 * 2,
                 W_LAYER = WO_2 + (size_t)2048 * 8192 * 2;
static_assert(W_LAYER == 147 * MiB, "weight map");
constexpr size_t WS_ACT = WS_W + NL * W_LAYER;
constexpr size_t WS_XB = WS_ACT, WS_CQ = WS_XB + 32 * MiB, WS_CKV = WS_CQ + 8 * MiB, WS_KR = WS_CKV + 4 * MiB, WS_SMALL = WS_KR + 2 * MiB;
constexpr size_t WS_SSQX = WS_SMALL, WS_SSQCQ = WS_SSQX + 256 * 1024, WS_SSQCKV = WS_SSQCQ + 64 * 1024, WS_SSQKR = WS_SSQCKV + 32 * 1024,
                 WS_LOGF = WS_SSQKR + 32 * 1024, WS_CUM = WS_LOGF + 256 * 1024;
constexpr size_t WS_FQ = WS_SMALL + 2 * MiB, WS_FK = WS_FQ + 16 * MiB, WS_FV = WS_FK + 16 * MiB, WS_CHQ = WS_FV + 16 * MiB, WS_CHK = WS_CHQ + 16 * MiB, WS_CHV = WS_CHK + 16 * MiB;
constexpr size_t WS_GATES = WS_CHV + 16 * MiB, WS_MQ = WS_GATES + 96 * MiB, WS_MK = WS_MQ + 24 * MiB, WS_MV = WS_MK + 24 * MiB, WS_Y = WS_MV + 16 * MiB;
constexpr size_t WS_MERGED = WS_Y + 48 * MiB, WS_XQ = WS_MERGED + 32 * MiB, WS_MEMB = WS_XQ + 8 * MiB, WS_XK = WS_MEMB + 4 * MiB, WS_XV = WS_XK + 1 * MiB, WS_OX = WS_XV + 1 * MiB;
constexpr size_t WS_H = WS_OX + 8 * MiB, WS_END = WS_H + 128 * MiB;
static_assert(WS_CUM + 256 * 1024 <= WS_FQ, "small map");

constexpr int RING_BYTES = 131072;
constexpr int ESCR_OFF = RING_BYTES, ESCR_BYTES = 16384;
constexpr int MISC_OFF = ESCR_OFF + ESCR_BYTES;
constexpr int LDS_BYTES = MISC_OFF + 1024;

#define GAS __attribute__((address_space(1)))
#define LAS __attribute__((address_space(3)))
typedef unsigned short bf16;
typedef unsigned u32x4 __attribute__((ext_vector_type(4)));
typedef unsigned u32x2 __attribute__((ext_vector_type(2)));
typedef float f32x4 __attribute__((ext_vector_type(4)));
typedef float f32x2 __attribute__((ext_vector_type(2)));
typedef GAS unsigned gu32;
#define RLX_AGENT __ATOMIC_RELAXED, __HIP_MEMORY_SCOPE_AGENT
#define LDS_WAIT() asm volatile("s_waitcnt lgkmcnt(0)" ::: "memory")
#define VM_WAIT() asm volatile("s_waitcnt vmcnt(0)" ::: "memory")
using pg8::cvt_pk_bf16;
__device__ __forceinline__ float bf_lo(unsigned w) { return __uint_as_float(w << 16); }
__device__ __forceinline__ float bf_hi(unsigned w) { return __uint_as_float(w & 0xffff0000u); }
__device__ __forceinline__ float bf2f(bf16 h) { return __uint_as_float((unsigned)h << 16); }
__device__ __forceinline__ u32x4 pack8(f32x4 a, f32x4 b) { u32x4 w; w.x = cvt_pk_bf16(a[0], a[1]); w.y = cvt_pk_bf16(a[2], a[3]); w.z = cvt_pk_bf16(b[0], b[1]); w.w = cvt_pk_bf16(b[2], b[3]); return w; }
__device__ __forceinline__ void unpack8(u32x4 w, f32x4& a, f32x4& b) { a[0] = bf_lo(w.x); a[1] = bf_hi(w.x); a[2] = bf_lo(w.y); a[3] = bf_hi(w.y); b[0] = bf_lo(w.z); b[1] = bf_hi(w.z); b[2] = bf_lo(w.w); b[3] = bf_hi(w.w); }
__device__ __forceinline__ float sumsq4(f32x4 v) { return (v[0] * v[0] + v[1] * v[1]) + (v[2] * v[2] + v[3] * v[3]); }
__device__ __forceinline__ float rsq(float x) { return __builtin_amdgcn_rsqf(x); }
__device__ __forceinline__ float sigmoidf_(float x) { return __builtin_amdgcn_rcpf(1.0f + __expf(-x)); }
__device__ __forceinline__ float log_sigmoidf_(float x) { return fminf(x, 0.f) - log1pf(expf(-fabsf(x))); }

typedef f32x4 Acc[2][2][4][2];
using pg8::Unit;
#define EPI_BAR() do { asm volatile("s_waitcnt lgkmcnt(0)" ::: "memory"); __builtin_amdgcn_s_barrier(); asm volatile("" ::: "memory"); } while (0)
template <int NB> __device__ __forceinline__ void xwave_rowsum(float (&s)[2][4][NB], LAS float* P, int wr, int wc, int fr, int fq) {
    unsigned pw = (unsigned)(uintptr_t)P + (unsigned)(((wr * 64 + fr) * NB * 4 + wc) * 4), pr = (unsigned)(uintptr_t)P + (unsigned)((wr * 64 + fr) * NB * 16);
    asm volatile("" : "+v"(pw), "+v"(pr));
#pragma unroll
    for (int ai = 0; ai < 2; ++ai)
#pragma unroll
        for (int m = 0; m < 4; ++m)
#pragma unroll
            for (int b = 0; b < NB; ++b) { float v = s[ai][m][b]; v += __shfl_xor(v, 16); v += __shfl_xor(v, 32);
                if (fq == 0) *(LAS float*)(pw + (unsigned)(((ai * 128 + m * 16) * NB + b) * 16)) = v; }
    EPI_BAR();
#pragma unroll
    for (int ai = 0; ai < 2; ++ai)
#pragma unroll
        for (int m = 0; m < 4; ++m)
#pragma unroll
            for (int b = 0; b < NB; ++b) { const f32x4 t = *(const LAS f32x4*)(pr + (unsigned)(((ai * 128 + m * 16) * NB + b) * 16)); s[ai][m][b] = (t[0] + t[1]) + (t[2] + t[3]); }
}
__device__ __forceinline__ void fresh_lane(int& fr, int& fq) { int l; asm volatile("v_mbcnt_lo_u32_b32 %0, -1, 0\n\tv_mbcnt_hi_u32_b32 %0, -1, %0" : "=v"(l)); fr = l & 15; fq = l >> 4; }
template <class V> __device__ __forceinline__ V ldg(const void* base, unsigned boff) { return *(const V*)((const char*)base + boff); }
template <class V> __device__ __forceinline__ void stg(void* base, unsigned boff, V v) { *(V*)((char*)base + boff) = v; }
__device__ __forceinline__ float sum8(f32x4 a, f32x4 b) { return ((a[0] + a[1]) + (a[2] + a[3])) + ((b[0] + b[1]) + (b[2] + b[3])); }
__device__ __forceinline__ float rstd8(const float* base, unsigned row) { return rsq(sum8(ldg<f32x4>(base, row * 32u), ldg<f32x4>(base, row * 32u + 16u)) * (1.0f / DM) + EPS); }
#define ROWG(ai, m) ((unsigned)(row0 + (ai) * 128 + (m) * 16))
#define EPI_AM _Pragma("unroll") for (int ai = 0; ai < 2; ++ai) _Pragma("unroll") for (int m = 0; m < 4; ++m) if ((__builtin_amdgcn_sched_barrier(0), true))
#define EPI_BJ _Pragma("unroll") for (int bj = 0; bj < 2; ++bj)

struct EpiInProj {
    static constexpr bool PERM = true, AFTER_DRAIN = false;
    const float* ssqx; bf16* cq; float* ssqcq; bf16* ckv; float* ssqckv; float* kr; float* ssqkr; float* logf; const float* b_f;
    bf16* hm;
    const float* gt;
    bf16* gates; LAS float* scr;
    __device__ __forceinline__ void operator()(Acc& acc, const Unit& u, int wr, int wc, int fr, int fq) const {
        fresh_lane(fr, fq);
        int row0 = u.pm * 256 + wr * 64 + fr, c8 = wc * 32 + fq * 8;
        asm volatile("" : "+v"(row0), "+v"(c8), "+v"(fq));
        const int pn = u.pn;
        EPI_AM { const float rs = rstd8(ssqx, ROWG(ai, m));
            EPI_BJ { acc[ai][bj][m][0] *= rs; acc[ai][bj][m][1] *= rs; } }
        if (pn >= 28) {
            EPI_AM { const unsigned row = ROWG(ai, m);
                EPI_BJ { f32x4 a = acc[ai][bj][m][0], b = acc[ai][bj][m][1];
#pragma unroll
                    for (int e = 0; e < 4; ++e) { a[e] = sigmoidf_(a[e]); b[e] = sigmoidf_(b[e]); }
                    stg<u32x4>(gates, row * 12288u + ((pn - 28) * 256 + bj * 128 + c8) * 2u, pack8(a, b)); } }
            return;
        }
        float s[2][4][2];
        const bool kr_tile = pn == 3;
        EPI_AM { const float s0 = sumsq4(acc[ai][0][m][0]) + sumsq4(acc[ai][0][m][1]), s1 = sumsq4(acc[ai][1][m][0]) + sumsq4(acc[ai][1][m][1]);
            s[ai][m][0] = (kr_tile && wc >= 2) ? 0.f : s0; s[ai][m][1] = kr_tile ? 0.f : s1; }
        xwave_rowsum<2>(s, scr, wr, wc, fr, fq);
        if (pn < 3) {
            EPI_AM { const unsigned row = ROWG(ai, m); const float tot = s[ai][m][0] + s[ai][m][1];
                if (wc == 0 && fq == 0) { if (pn < 2) stg<float>(ssqcq, row * 8u + pn * 4u, tot); else stg<float>(ssqckv, row * 4u, tot); }
                EPI_BJ { const u32x4 w = pack8(acc[ai][bj][m][0], acc[ai][bj][m][1]);
                    if (pn < 2) stg<u32x4>(cq, row * 1024u + (pn * 256 + bj * 128 + c8) * 2u, w); else stg<u32x4>(ckv, row * 512u + (bj * 128 + c8) * 2u, w); } }
        } else if (pn == 3) {
            EPI_AM { const unsigned row = ROWG(ai, m);
                if (wc == 0 && fq == 0) stg<float>(ssqkr, row * 4u, s[ai][m][0]);
                if (wc < 2) { stg<f32x4>(kr, row * 256u + c8 * 4u, acc[ai][0][m][0]); stg<f32x4>(kr, row * 256u + c8 * 4u + 16u, acc[ai][0][m][1]); }
                if (wc == 2 && fq == 0) { f32x4 a = acc[ai][0][m][0], b = acc[ai][0][m][1]; const f32x4 b0 = *(const f32x4*)b_f, b1 = *(const f32x4*)(b_f + 4);
#pragma unroll
                    for (int e = 0; e < 4; ++e) { a[e] = log_sigmoidf_(a[e] + b0[e]); b[e] = log_sigmoidf_(b[e] + b1[e]); }
                    stg<f32x4>(logf, row * 32u, a); stg<f32x4>(logf, row * 32u + 16u, b); } }
        } else {
            const int t = pn - 4, seg = t >> 2, hp = t & 3; const bool isv = seg == 2 || seg == 5;
            const f32x4 g0 = ldg<f32x4>(gt, (seg * 128 + c8) * 4u), g1 = ldg<f32x4>(gt, (seg * 128 + c8) * 4u + 16u);
            bf16* dst = hm + (size_t)seg * (8u << 20);
            EPI_AM { const unsigned row = ROWG(ai, m), b = row >> 11, sp = row & 2047u;
                EPI_BJ { const float rh = isv ? 1.0f : rsq(s[ai][m][bj] * (1.0f / 128.0f) + EPS); const unsigned head = hp * 2 + bj;
                    stg<u32x4>(dst, (((b * 8u + head) * SEQ + sp) * 128u + c8) * 2u, pack8(acc[ai][bj][m][0] * rh * g0, acc[ai][bj][m][1] * rh * g1)); } }
        }
    }
};

struct EpiQUp {
    static constexpr bool PERM = true, AFTER_DRAIN = false;
    const float* ssqcq; const float* gq; const float* cosT; const float* sinT; bf16* mq; LAS float* scr;
    __device__ __forceinline__ void operator()(Acc& acc, const Unit& u, int wr, int wc, int fr, int fq) const {
        fresh_lane(fr, fq);
        int row0 = u.pm * 256 + wr * 64 + fr, c8 = wc * 32 + fq * 8;
        asm volatile("" : "+v"(row0), "+v"(c8), "+v"(fq));
        const unsigned head = u.pn;
        float s[2][4][1];
        EPI_AM { const f32x2 p = ldg<f32x2>(ssqcq, ROWG(ai, m) * 8u); const float rs = rsq((p[0] + p[1]) * (1.0f / 512.0f) + EPS);
            EPI_BJ { acc[ai][bj][m][0] *= rs; acc[ai][bj][m][1] *= rs; }
            s[ai][m][0] = (sumsq4(acc[ai][0][m][0]) + sumsq4(acc[ai][0][m][1])) + (sumsq4(acc[ai][1][m][0]) + sumsq4(acc[ai][1][m][1])); }
        xwave_rowsum<1>(s, scr, wr, wc, fr, fq);
        const f32x4 g0 = ldg<f32x4>(gq, c8 * 4u), g1 = ldg<f32x4>(gq, c8 * 4u + 16u);
        const unsigned gi = 4 * (wc & 1) + fq;
        const f32x4 gr1 = ldg<f32x4>(gq, (128 + 4 * gi) * 4u), gr2 = ldg<f32x4>(gq, (160 + 4 * gi) * 4u);
        EPI_AM { const unsigned row = ROWG(ai, m), b = row >> 11, sp = row & 2047u; const float rq = rsq(s[ai][m][0] * (1.0f / 192.0f) + EPS);
            const unsigned d = ((b * 8u + head) * SEQ + sp) * 384u;
            stg<u32x4>(mq, d + c8 * 2u, pack8(acc[ai][0][m][0] * rq * g0, acc[ai][0][m][1] * rq * g1));
            if (wc < 2) { const f32x4 x1 = acc[ai][1][m][0] * rq * gr1, x2 = acc[ai][1][m][1] * rq * gr2;
                const f32x4 c = ldg<f32x4>(cosT, (sp * 32u + 4 * gi) * 4u), sn = ldg<f32x4>(sinT, (sp * 32u + 4 * gi) * 4u);
                stg<u32x4>(mq, d + (128 + 8 * gi) * 2u, pack8(x1 * c - x2 * sn, x1 * sn + x2 * c)); } }
    }
};

struct EpiKvUp {
    static constexpr bool PERM = true, AFTER_DRAIN = false;
    const float* ssqckv; const float* ssqkr; const float* kr; const float* gk; const float* cosT; const float* sinT; bf16* mk; bf16* mv; LAS float* scr;
    __device__ __forceinline__ void operator()(Acc& acc, const Unit& u, int wr, int wc, int fr, int fq) const {
        fresh_lane(fr, fq);
        int row0 = u.pm * 256 + wr * 64 + fr, c8 = wc * 32 + fq * 8;
        asm volatile("" : "+v"(row0), "+v"(c8), "+v"(fq));
        const unsigned head = u.pn;
        float s[2][4][1];
        EPI_AM { const float rs = rsq(ldg<float>(ssqckv, ROWG(ai, m) * 4u) * (1.0f / 256.0f) + EPS);
            EPI_BJ { acc[ai][bj][m][0] *= rs; acc[ai][bj][m][1] *= rs; }
            s[ai][m][0] = sumsq4(acc[ai][0][m][0]) + sumsq4(acc[ai][0][m][1]); }
        xwave_rowsum<1>(s, scr, wr, wc, fr, fq);
        const f32x4 g0 = ldg<f32x4>(gk, c8 * 4u), g1 = ldg<f32x4>(gk, c8 * 4u + 16u);
        const unsigned qi = 4 * wc + fq, i0 = 2 * qi;
        const f32x2 gr1 = ldg<f32x2>(gk, (128 + i0) * 4u), gr2 = ldg<f32x2>(gk, (160 + i0) * 4u);
        const unsigned slot = 128 + 8 * (qi >> 1) + 2 * (qi & 1);
        EPI_AM { const unsigned row = ROWG(ai, m), b = row >> 11, sp = row & 2047u; const float rk = rsq((s[ai][m][0] + ldg<float>(ssqkr, row * 4u)) * (1.0f / 192.0f) + EPS);
            const unsigned tok = (b * 8u + head) * SEQ + sp, dk = tok * 384u;
            stg<u32x4>(mk, dk + c8 * 2u, pack8(acc[ai][0][m][0] * rk * g0, acc[ai][0][m][1] * rk * g1));
            stg<u32x4>(mv, tok * 256u + c8 * 2u, pack8(acc[ai][1][m][0], acc[ai][1][m][1]));
            const f32x2 x1 = ldg<f32x2>(kr, row * 256u + i0 * 4u) * rk * gr1, x2 = ldg<f32x2>(kr, row * 256u + (32 + i0) * 4u) * rk * gr2;
            const f32x2 c = ldg<f32x2>(cosT, (sp * 32u + i0) * 4u), sn = ldg<f32x2>(sinT, (sp * 32u + i0) * 4u);
            const f32x2 o1 = x1 * c - x2 * sn, o2 = x1 * sn + x2 * c;
            stg<unsigned>(mk, dk + slot * 2u, cvt_pk_bf16(o1[0], o1[1])); stg<unsigned>(mk, dk + (slot + 4) * 2u, cvt_pk_bf16(o2[0], o2[1])); }
    }
};

struct EpiBr {
    static constexpr bool PERM = true, AFTER_DRAIN = false;
    const bf16* gates; bf16* merged;
    __device__ __forceinline__ void operator()(Acc& acc, const Unit& u, int wr, int wc, int fr, int fq) const {
        fresh_lane(fr, fq);
        int row0 = u.pm * 256 + wr * 64 + fr, c8 = wc * 32 + fq * 8;
        asm volatile("" : "+v"(row0), "+v"(c8));
        const unsigned z = u.z;
        EPI_AM { const unsigned row = ROWG(ai, m);
            EPI_BJ { const unsigned col = u.pn * 256 + bj * 128 + c8;
                f32x4 ga, gb; unpack8(ldg<u32x4>(gates, row * 12288u + (z * 2048u + col) * 2u), ga, gb);
                f32x4 a = acc[ai][bj][m][0] * ga, b = acc[ai][bj][m][1] * gb;
                const unsigned d = row * 4096u + col * 2u;
                if (z > 0) { f32x4 pa, pb; unpack8(ldg<u32x4>(merged, d), pa, pb); a += pa; b += pb; }
                stg<u32x4>(merged, d, pack8(a, b)); } }
    }
};

struct EpiResid {
    static constexpr bool PERM = false, AFTER_DRAIN = false;
    const float* xin; float* xout; bf16* xb; float* ssqx; LAS float* scr;
    __device__ __forceinline__ void operator()(Acc& acc, const Unit& u, int wr, int wc, int fr, int fq) const {
        fresh_lane(fr, fq);
        int row0 = u.pm * 256 + wr * 64 + fr, c4 = wc * 32 + fq * 4;
        asm volatile("" : "+v"(row0), "+v"(c4), "+v"(fq));
        float s[2][4][1];
        EPI_AM { const unsigned row = ROWG(ai, m); float q = 0.f;
            EPI_BJ {
#pragma unroll
                for (int n = 0; n < 2; ++n) { const unsigned e = row * 2048u + u.pn * 256 + bj * 128 + n * 16 + c4;
                    const f32x4 v = ldg<f32x4>(xin, e * 4u) + acc[ai][bj][m][n];
                    stg<f32x4>(xout, e * 4u, v); q += sumsq4(v);
                    u32x2 w; w.x = cvt_pk_bf16(v[0], v[1]); w.y = cvt_pk_bf16(v[2], v[3]); stg<u32x2>(xb, e * 2u, w); } }
            s[ai][m][0] = q; }
        xwave_rowsum<1>(s, scr, wr, wc, fr, fq);
        if (wc == 0 && fq == 0) { EPI_AM { stg<float>(ssqx, ROWG(ai, m) * 32u + u.pn * 4u, s[ai][m][0]); } }
    }
};

struct EpiHeadNorm {
    static constexpr bool PERM = true, AFTER_DRAIN = false;
    const float* ssq8;
    const float* rstd1;
    const float* gg; bf16* dk; bf16* dv; int nk_tiles, rows_per_b, lg_rows_per_b; LAS float* scr;
    __device__ __forceinline__ void operator()(Acc& acc, const Unit& u, int wr, int wc, int fr, int fq) const {
        fresh_lane(fr, fq);
        int row0 = u.pm * 256 + wr * 64 + fr, c8 = wc * 32 + fq * 8;
        asm volatile("" : "+v"(row0), "+v"(c8), "+v"(fq));
        const int pn = u.pn;
        EPI_AM { const unsigned row = ROWG(ai, m); const float rs = ssq8 ? rstd8(ssq8, row) : ldg<float>(rstd1, row * 4u);
            EPI_BJ { acc[ai][bj][m][0] *= rs; acc[ai][bj][m][1] *= rs; } }
        const bool isk = pn < nk_tiles;
        if (isk) {
            float s[2][4][2];
            EPI_AM { EPI_BJ { s[ai][m][bj] = sumsq4(acc[ai][bj][m][0]) + sumsq4(acc[ai][bj][m][1]); } }
            xwave_rowsum<2>(s, scr, wr, wc, fr, fq);
            const f32x4 g0 = ldg<f32x4>(gg, c8 * 4u), g1 = ldg<f32x4>(gg, c8 * 4u + 16u);
            EPI_AM { EPI_BJ { const float rh = rsq(s[ai][m][bj] * (1.0f / 128.0f) + EPS); acc[ai][bj][m][0] = acc[ai][bj][m][0] * rh * g0; acc[ai][bj][m][1] = acc[ai][bj][m][1] * rh * g1; } }
        }
        bf16* dst = isk ? dk : dv; const unsigned hp = isk ? pn : pn - nk_tiles;
        EPI_AM { const unsigned row = ROWG(ai, m), b = row >> lg_rows_per_b, sp = row & (unsigned)(rows_per_b - 1);
            EPI_BJ { const unsigned head = hp * 2 + bj; stg<u32x4>(dst, (((b * 4u + head) * rows_per_b + sp) * 128u + c8) * 2u, pack8(acc[ai][bj][m][0], acc[ai][bj][m][1])); } }
    }
};

struct EpiMlp1 {
    static constexpr bool PERM = true, AFTER_DRAIN = false;
    const float* ssqx; bf16* h;
    __device__ __forceinline__ void operator()(Acc& acc, const Unit& u, int wr, int wc, int fr, int fq) const {
        fresh_lane(fr, fq);
        int row0 = u.pm * 256 + wr * 64 + fr, c8 = wc * 32 + fq * 8;
        asm volatile("" : "+v"(row0), "+v"(c8));
        EPI_AM { const unsigned row = ROWG(ai, m); const float rs = rstd8(ssqx, row);
            EPI_BJ { f32x4 a = acc[ai][bj][m][0] * rs, b = acc[ai][bj][m][1] * rs;
#pragma unroll
                for (int e = 0; e < 4; ++e) { a[e] = fmaxf(a[e], 0.f); a[e] *= a[e]; b[e] = fmaxf(b[e], 0.f); b[e] *= b[e]; }
                stg<u32x4>(h, row * 16384u + (u.pn * 256 + bj * 128 + c8) * 2u, pack8(a, b)); } }
    }
};

namespace att {
typedef short bf16x8 __attribute__((ext_vector_type(8)));
typedef short s16x4 __attribute__((ext_vector_type(4)));
typedef float f32x16 __attribute__((ext_vector_type(16)));
constexpr int NW = 8, QBLK = 32, KVBLK = 64, QB = NW * QBLK, DV = 128;
constexpr int SHM_V = KVBLK * DV * 2;
constexpr float SQRT_D = 11.313708498984761f;
template <int MODE> struct Cfg { static constexpr int DK = MODE == 0 ? 192 : 128, SHM_K = KVBLK * DK * 2, NQF = DK / 16;
    static constexpr int OFF_K = 2 * SHM_V, OFF_WS = OFF_K + 2 * SHM_K, OFF_CK = OFF_WS + NW * 64 * 4, OFF_EXT = OFF_CK + 2 * 64 * 4, LDS_BYTES = OFF_EXT + 256 * 4;
    static constexpr bool SK = MODE != 3; };
static_assert(Cfg<0>::LDS_BYTES <= RING_BYTES, "attention LDS");
#define SBAR() __builtin_amdgcn_sched_barrier(0)
template <int DK> __device__ __forceinline__ int kswz(int row, int colB) { return row * (DK * 2) + (colB ^ ((row & 7) << 4)); }
__device__ __forceinline__ int v_st(int k, int c) { const int kk = (k & ~0xC) | ((k & 4) << 1) | ((k & 8) >> 1); return ((kk >> 3) * 4 + (c >> 5)) * 512 + ((kk & 7) * 32 + (c & 31)) * 2; }
__device__ __forceinline__ int v_rd_base(int lane) { return ((lane & 3) << 3) | (((lane >> 2) & 3) << 6) | (((lane >> 4) & 1) << 5) | (((lane >> 5) & 1) << 8); }
constexpr int v_rd_off(int d0, int ks, int half) { return d0 * 512 + ks * 4096 + half * 2048; }
__device__ __forceinline__ int crow(int r, int hi) { return (r & 3) + 8 * (r >> 2) + 4 * hi; }
__device__ __forceinline__ unsigned cvtpk(float lo, float hi) { unsigned r; asm volatile("v_cvt_pk_bf16_f32 %0, %1, %2" : "=v"(r) : "v"(lo), "v"(hi)); return r; }
__device__ __forceinline__ bf16x8 load8(const bf16* p) { return *reinterpret_cast<const bf16x8*>(p); }
__device__ __forceinline__ void mask_tile(f32x16& p0, f32x16& p1, int dq) {
    const float NEG = -__builtin_inff();
#pragma unroll
    for (int r = 0; r < 16; ++r) { const int c = (r & 3) + 8 * (r >> 2); if (dq - c < 0) p0[r] = NEG; if (dq - c - 32 < 0) p1[r] = NEG; }
}
template <int MODE> __device__ __forceinline__ void partialSM(f32x16& p0, f32x16& p1, float& m_reg, float& mn, float& alpha) {
    constexpr float SCALE = MODE == 0 ? 0.07216878364870322f : 0.08838834764831845f, THR = 8.f;
    float pmax = p0[0]; for (int r = 1; r < 16; ++r) pmax = fmaxf(pmax, p0[r]); for (int r = 0; r < 16; ++r) pmax = fmaxf(pmax, p1[r]);
    { auto rr = __builtin_amdgcn_permlane32_swap(__float_as_uint(pmax), __float_as_uint(pmax), false, false);
      pmax = fmaxf(__uint_as_float(rr[0]), __uint_as_float(rr[1])); }
    constexpr float C2 = 1.4426950408889634f * SCALE;
    if (__builtin_expect(__all((pmax - m_reg) * SCALE <= THR), 1)) { mn = m_reg; alpha = 1.f; }
    else { mn = fmaxf(m_reg, pmax); alpha = __builtin_amdgcn_exp2f((m_reg - mn) * C2); m_reg = mn; }
    const float mnL = -mn * C2;
    for (int r = 0; r < 16; ++r) p0[r] = fmaf(p0[r], C2, mnL); for (int r = 0; r < 16; ++r) p1[r] = fmaf(p1[r], C2, mnL);
    for (int r = 0; r < 16; ++r) p0[r] = __builtin_amdgcn_exp2f(p0[r]);
}
__device__ __forceinline__ void finishSM(f32x16& p0, f32x16& p1, float alpha, float& l_reg, bf16x8& pa0, bf16x8& pa1, bf16x8& pa2, bf16x8& pa3) {
    for (int r = 0; r < 16; ++r) p1[r] = __builtin_amdgcn_exp2f(p1[r]);
    float ps = 0; for (int r = 0; r < 16; ++r) ps += p0[r]; for (int r = 0; r < 16; ++r) ps += p1[r];
    { auto rr = __builtin_amdgcn_permlane32_swap(__float_as_uint(ps), __float_as_uint(ps), false, false);
      ps = __uint_as_float(rr[0]) + __uint_as_float(rr[1]); }
    l_reg = l_reg * alpha + ps;
#define PK4(P, B_, OUT) do { unsigned a0 = cvtpk(P[B_+0], P[B_+1]), a1 = cvtpk(P[B_+2], P[B_+3]);                          \
        unsigned b0 = cvtpk(P[B_+4], P[B_+5]), b1 = cvtpk(P[B_+6], P[B_+7]);                                             \
        auto r0 = __builtin_amdgcn_permlane32_swap(a0, b0, false, false); auto r1 = __builtin_amdgcn_permlane32_swap(a1, b1, false, false); \
        u32x4 w = {r0[0], r1[0], r0[1], r1[1]}; OUT = *reinterpret_cast<bf16x8*>(&w); } while (0)
    PK4(p0, 0, pa0); PK4(p0, 8, pa1); PK4(p1, 0, pa2); PK4(p1, 8, pa3);
#undef PK4
}
template <int MODE, int KB>
__device__ __forceinline__ void qkt(f32x16& p0, f32x16& p1, const char* K_lds, int r32, int hi, const bf16x8* qr, bool act) {
    constexpr int DK = Cfg<MODE>::DK, SHM_K = Cfg<MODE>::SHM_K;
    if (Cfg<MODE>::SK && !act) { const float NEG = -__builtin_inff();
#pragma unroll
        for (int r = 0; r < 16; ++r) { p0[r] = NEG; p1[r] = NEG; } return; }
    const char* kb[4];
#pragma unroll
    for (int dd = 0; dd < 4; ++dd) kb[dd] = K_lds + KB * SHM_K + kswz<DK>(r32, (dd * 16 + hi * 8) * 2);
#pragma unroll
    for (int d0 = 0; d0 < DK / 16; ++d0) { const char* a = kb[d0 & 3] + (d0 >> 2) * 128;
        bf16x8 b0 = *reinterpret_cast<const bf16x8*>(a);
        bf16x8 b1 = *reinterpret_cast<const bf16x8*>(a + 32 * DK * 2);
        p0 = __builtin_amdgcn_mfma_f32_32x32x16_bf16(b0, qr[d0], p0, 0, 0, 0);
        p1 = __builtin_amdgcn_mfma_f32_32x32x16_bf16(b1, qr[d0], p1, 0, 0, 0); }
}
template <int VB, bool SK>
__device__ __forceinline__ void pv_tile(f32x16* o, int vb0, bf16x8 pa0, bf16x8 pa1, bf16x8 pa2, bf16x8 pa3, bool act) {
    if (SK && !act) return;
#define TRRD(dst, off) asm volatile("ds_read_b64_tr_b16 %0, %1 offset:%2" : "=&v"(dst) : "v"(vb0), "i"(off) : "memory")
#define PV_D0(d0) do { s16x4 l0, l1, l2, l3, h0, h1, h2, h3; constexpr int b_ = VB * SHM_V + v_rd_off(d0, 0, 0); \
        TRRD(l0, b_); TRRD(h0, b_ + 2048); TRRD(l1, b_ + 4096); TRRD(h1, b_ + 6144); TRRD(l2, b_ + 8192); TRRD(h2, b_ + 10240); TRRD(l3, b_ + 12288); TRRD(h3, b_ + 14336); \
        asm volatile("s_waitcnt lgkmcnt(0)" ::: "memory"); SBAR();   \
        o[d0] = __builtin_amdgcn_mfma_f32_32x32x16_bf16(pa0, (bf16x8){l0[0], l0[1], l0[2], l0[3], h0[0], h0[1], h0[2], h0[3]}, o[d0], 0, 0, 0);   \
        o[d0] = __builtin_amdgcn_mfma_f32_32x32x16_bf16(pa1, (bf16x8){l1[0], l1[1], l1[2], l1[3], h1[0], h1[1], h1[2], h1[3]}, o[d0], 0, 0, 0);   \
        o[d0] = __builtin_amdgcn_mfma_f32_32x32x16_bf16(pa2, (bf16x8){l2[0], l2[1], l2[2], l2[3], h2[0], h2[1], h2[2], h2[3]}, o[d0], 0, 0, 0);   \
        o[d0] = __builtin_amdgcn_mfma_f32_32x32x16_bf16(pa3, (bf16x8){l3[0], l3[1], l3[2], l3[3], h3[0], h3[1], h3[2], h3[3]}, o[d0], 0, 0, 0); } while (0)
    PV_D0(0); PV_D0(1); PV_D0(2); PV_D0(3);
#undef PV_D0
#undef TRRD
}

struct Blk { const bf16* Q; const bf16* K; const bf16* V; bf16* O; int P0, ldo; const float* cum; const float* relb; };
template <int MODE> struct Stage { bf16x8 st_v0, st_v1, st_k0, st_k1, st_k2; float st_c; };
template <int MODE> __device__ __forceinline__ int blk_jlo(int P0) { return MODE == 2 ? (P0 >= 512 ? (P0 - 512) / KVBLK : 0) : 0; }
template <int MODE> __device__ __forceinline__ int blk_jhi(int P0, int skv) { return MODE == 3 ? skv / KVBLK : (P0 + QB - 1) / KVBLK + 1; }
#define VMW() asm volatile("s_waitcnt vmcnt(0)" ::: "memory")
#define KROW(p, k0, rr) ((p) + (size_t)((k0) + (rr)) * DK + sc)
#define VROW(p, k0, rr) ((p) + (size_t)((k0) + (rr)) * DV + sc)
#define SLOAD_H(B_, k0) do { S.st_v0 = load8(VROW((B_).V, k0, sr)); S.st_v1 = load8(VROW((B_).V, k0, 32 + sr));              \
                         S.st_k0 = load8(KROW((B_).K, k0, sr)); S.st_k1 = load8(KROW((B_).K, k0, 32 + sr));              \
                         if constexpr (MODE == 0) S.st_k2 = load8((B_).K + (size_t)((k0) + (tid >> 3)) * DK + 128 + (tid & 7) * 8);   \
                         if constexpr (MODE == 1) { if (tid < 64) S.st_c = (B_).cum[(k0) + tid] * SQRT_D; } } while (0)
#define SWRITE_HK(bf) do { *(bf16x8*)(K_lds + (bf) * SHM_K + kws) = S.st_k0; *(bf16x8*)(K_lds + (bf) * SHM_K + kws + 32 * DK * 2) = S.st_k1; \
                           if constexpr (MODE == 0) *(bf16x8*)(K_lds + (bf) * SHM_K + kws2) = S.st_k2;     \
                           if constexpr (MODE == 1) { if (tid < 64) ck_l[(bf) * 64 + tid] = S.st_c; } } while (0)
#define SWRITE_HV(bf) do { *(bf16x8*)(V_lds + (bf) * SHM_V + vst0) = S.st_v0; *(bf16x8*)(V_lds + (bf) * SHM_V + vst1) = S.st_v1; } while (0)
#define SWRITE_H(bf) do { SWRITE_HV(bf); SWRITE_HK(bf); } while (0)
template <int MODE>
__device__ __forceinline__ void attn_block(const Blk& cur, int skv, char* lds) {
    constexpr int DK = Cfg<MODE>::DK, SHM_K = Cfg<MODE>::SHM_K, NQF = Cfg<MODE>::NQF; constexpr bool SK = Cfg<MODE>::SK;
    int tid_ = threadIdx.x; asm volatile("" : "+v"(tid_));
    const int tid = tid_, wid = __builtin_amdgcn_readfirstlane(tid >> 6), lane = tid & 63, r32 = lane & 31, hi = lane >> 5;
    const int j_lo = blk_jlo<MODE>(cur.P0), j_hi = blk_jhi<MODE>(cur.P0, skv);
    const int NT = j_hi - j_lo;
    const int qlo = cur.P0 + wid * QBLK, qm = qlo + r32 - 4 * hi;
    const int cq = qlo >> 6;
    char* V_lds = lds; char* K_lds = lds + Cfg<MODE>::OFF_K;
    float* ws = (float*)(lds + Cfg<MODE>::OFF_WS) + wid * 64; float* li_l = ws, * al_l = ws + 32;
    float* ck_l = (float*)(lds + Cfg<MODE>::OFF_CK); const float* ext_l = (const float*)(lds + Cfg<MODE>::OFF_EXT); (void)ck_l; (void)ext_l; (void)qm; (void)cq;
    float m_reg = -1e30f, l_reg = 0; f32x16 o[4] = {};
    const int sr = tid >> 4, sc = (tid & 15) * 8, vst0 = v_st(sr, sc), vst1 = v_st(32 + sr, sc), kws = kswz<DK>(sr, sc * 2), kws2 = kswz<DK>(tid >> 3, (128 + (tid & 7) * 8) * 2); (void)kws2;
    const int vb0 = (int)(uintptr_t)V_lds + v_rd_base(lane);
    float cqs = 0.f; if constexpr (MODE == 1) cqs = cur.cum[qlo + r32] * SQRT_D;
    const int extb = (qlo & 63) + r32 - 4 * hi + 4; (void)extb; (void)cqs;
    Stage<MODE> S; bf16x8 qr[NQF];
#define RESC(a) do { if (__any((a) < 1.f)) { if (hi == 0) al_l[r32] = (a); asm volatile("s_waitcnt lgkmcnt(0)" ::: "memory");              \
                     for (int d_ = 0; d_ < 4; ++d_) for (int r = 0; r < 16; ++r) o[d_][r] *= al_l[crow(r, hi)]; } } while (0)
#define KBASE(t) ((j_lo + (t)) * KVBLK)
#define ACT(t) (MODE == 0 ? (j_lo + (t)) <= cq : MODE == 1 ? KBASE(t) <= qlo + QBLK - 1 : MODE == 2 ? ((j_lo + (t)) <= cq && (j_lo + (t)) + 8 >= cq) : true)
#define MASKT(P0_, P1_, t) do { if constexpr (MODE == 1) { const int kb_ = KBASE(t); if (ACT(t) && kb_ + KVBLK - 1 > qlo) mask_tile(P0_, P1_, qm - kb_); } } while (0)
#define INITP(PX0, PX1, t, KB) do { if constexpr (MODE == 0 || MODE == 3) { PX0 = f32x16{}; PX1 = f32x16{}; }                                  \
        else if constexpr (MODE == 1) { _Pragma("unroll") for (int g_ = 0; g_ < 4; ++g_) { const f32x4 c0_ = *(const f32x4*)(ck_l + (KB) * 64 + 8 * g_ + 4 * hi), c1_ = *(const f32x4*)(ck_l + (KB) * 64 + 32 + 8 * g_ + 4 * hi); \
              _Pragma("unroll") for (int e_ = 0; e_ < 4; ++e_) { PX0[4 * g_ + e_] = cqs - c0_[e_]; PX1[4 * g_ + e_] = cqs - c1_[e_]; } } }          \
        else { const int d_ = cq - (j_lo + (t)); if (d_ >= 3 || d_ < 0) { const float cf_ = ext_l[191]; _Pragma("unroll") for (int r = 0; r < 16; ++r) { PX0[r] = cf_; PX1[r] = cf_; } }   \
               else { const float* eb_ = ext_l + 64 * d_ + extb; _Pragma("unroll") for (int r = 0; r < 16; ++r) { PX0[r] = eb_[59 - ((r & 3) + 8 * (r >> 2))]; PX1[r] = eb_[27 - ((r & 3) + 8 * (r >> 2))]; } } } } while (0)
#pragma unroll
    for (int d0 = 0; d0 < NQF; ++d0) qr[d0] = load8(cur.Q + (size_t)(wid * QBLK + r32) * DK + d0 * 16 + hi * 8);
    SLOAD_H(cur, KBASE(0));
    if constexpr (MODE == 2) { if (tid < 256) { int rel = tid - 63; rel = rel > 128 ? 128 : rel; ((float*)(lds + Cfg<MODE>::OFF_EXT))[tid] = cur.relb[rel + 128] * SQRT_D; } }
    VMW(); SWRITE_H(0); SBAR();
    if (NT > 1) SLOAD_H(cur, KBASE(1));
    __syncthreads();
#define STEP(t, B_) do { f32x16 p0, p1; float mn, al; bf16x8 pa0, pa1, pa2, pa3;                                                        \
        INITP(p0, p1, t, B_); qkt<MODE, B_>(p0, p1, K_lds, r32, hi, qr, ACT(t));                                              \
        MASKT(p0, p1, t); partialSM<MODE>(p0, p1, m_reg, mn, al); RESC(al); finishSM(p0, p1, al, l_reg, pa0, pa1, pa2, pa3); SBAR();   \
        if ((t) + 1 < NT) { VMW(); SWRITE_H(1 - (B_)); SBAR(); }                                                              \
        pv_tile<B_, SK>(o, vb0, pa0, pa1, pa2, pa3, ACT(t)); SBAR();                                                          \
        if ((t) + 2 < NT) { SLOAD_H(cur, KBASE((t) + 2)); SBAR(); }                                                           \
        __syncthreads(); } while (0)
    for (int t = 0; t < NT; t += 2) { STEP(t, 0); if (t + 1 < NT) STEP(t + 1, 1); }
    if (hi == 0) li_l[r32] = l_reg; asm volatile("s_waitcnt lgkmcnt(0)" ::: "memory");
    float rli[16];
#pragma unroll
    for (int r = 0; r < 16; ++r) rli[r] = __builtin_amdgcn_rcpf(li_l[crow(r, hi)]);
    bf16* Ow = cur.O + (size_t)(wid * QBLK) * cur.ldo;
#pragma unroll
    for (int r = 0; r < 16; ++r) { const int orow = crow(r, hi);
#pragma unroll
        for (int d0 = 0; d0 < 4; ++d0) { const float v = o[d0][r] * rli[r];
            const float vn = __shfl_xor(v, 1);
            if ((r32 & 1) == 0) *(unsigned*)(Ow + (size_t)orow * cur.ldo + d0 * 32 + r32) = cvtpk(v, vn); } }
    __syncthreads();
#undef RESC
#undef KBASE
#undef ACT
#undef MASKT
#undef INITP
#undef STEP
}
#undef KROW
#undef VROW
#undef VMW
#undef SLOAD_H
#undef SWRITE_HK
#undef SWRITE_HV
#undef SWRITE_H
#undef SBAR
}

#define XB_TMO      128
#define XB_XCNT(j)  (256  + 64 * (j))
#define XB_XSUB(j)  (1280 + 64 * (j))
#define XB_XGEN(j)  (2304 + 64 * (j))
#define XB_TOP      3328
#define XB_TOPGEN   3392
#define XCD_BAR_WORDS 3456
#define XB_SPIN_CAP (1u << 18)
__device__ __forceinline__ unsigned xb_ld(unsigned* p)              { return __hip_atomic_load(p, __ATOMIC_RELAXED, __HIP_MEMORY_SCOPE_AGENT); }
__device__ __forceinline__ unsigned xb_add(unsigned* p, unsigned v) { return __hip_atomic_fetch_add(p, v, __ATOMIC_RELAXED, __HIP_MEMORY_SCOPE_AGENT); }
__device__ __forceinline__ unsigned xb_xcc_id() { return (unsigned)__builtin_amdgcn_s_getreg((3 << 11) | 20) & 0xFu; }
#define XB_SPIN(cond, bar) do { unsigned _sp = 0; while (cond) { __builtin_amdgcn_s_sleep(1); \
    if ((++_sp & 255u) == 0u) { if (xb_ld(&(bar)[XB_TMO])) break; if (_sp > XB_SPIN_CAP) { atomicAdd(&(bar)[XB_TMO], 1u); break; } } } } while (0)
struct XcdBarrier { unsigned* bar; unsigned x; volatile LAS unsigned* st; };
__device__ __forceinline__ XcdBarrier xcd_barrier_post(unsigned* bar, volatile LAS unsigned* st) {
    XcdBarrier b; b.bar = bar; b.x = xb_xcc_id(); b.st = st;
    if (threadIdx.x == 0) (void)xb_add(&bar[XB_XCNT(b.x)], 1u);
    return b;
}
__device__ __forceinline__ void xcd_barrier_complete(unsigned* bar, unsigned x, unsigned& nloc, unsigned& nx) {
    const unsigned G = gridDim.x * gridDim.y * gridDim.z;
    unsigned sum, cnt, mine, sp = 0u;
    for (;;) {
        sum = 0u; cnt = 0u; mine = 0u;
#pragma unroll
        for (unsigned j = 0; j < 16; ++j) { const unsigned c = xb_ld(&bar[XB_XCNT(j)]); sum += c; cnt += (c > 0u) ? 1u : 0u; mine = (j == x) ? c : mine; }
        if (sum == G) break;
        __builtin_amdgcn_s_sleep(1);
        if ((++sp & 255u) == 0u) { if (xb_ld(&bar[XB_TMO])) break; if (sp > XB_SPIN_CAP) { atomicAdd(&bar[XB_TMO], 1u); break; } }
    }
    nloc = mine > 0u ? mine : 1u; nx = cnt > 0u ? cnt : 1u;
}
__device__ __forceinline__ void xcd_barrier(const XcdBarrier& b) {
    asm volatile("s_waitcnt vmcnt(0)" ::: "memory");
    __syncthreads();
    if (threadIdx.x == 0) {
        unsigned* bar = b.bar;
        __builtin_amdgcn_s_waitcnt(0);
        unsigned nloc = b.st[0], nx = b.st[1];
        if (nloc == 0u) { xcd_barrier_complete(bar, b.x, nloc, nx); b.st[0] = nloc; b.st[1] = nx; }
        const unsigned old = xb_add(&bar[XB_XSUB(b.x)], 1u);
        const unsigned gen = old / nloc;
        if (old + 1u == (gen + 1u) * nloc) {
            __builtin_amdgcn_fence(__ATOMIC_RELEASE, "agent");
            asm volatile("s_waitcnt vmcnt(0)" ::: "memory");
            const unsigned og = xb_add(&bar[XB_TOP], 1u);
            const unsigned tg = og / nx;
            if (og + 1u == (tg + 1u) * nx) xb_add(&bar[XB_TOPGEN], 1u);
            else XB_SPIN(xb_ld(&bar[XB_TOPGEN]) == tg, bar);
            __builtin_amdgcn_fence(__ATOMIC_ACQUIRE, "agent");
            xb_add(&bar[XB_XGEN(b.x)], 1u);
            asm volatile("s_waitcnt vmcnt(0)" ::: "memory");
        } else {
            XB_SPIN(xb_ld(&bar[XB_XGEN(b.x)]) == gen, bar);
            __builtin_amdgcn_fence(__ATOMIC_ACQUIRE, "agent");
            asm volatile("s_waitcnt vmcnt(0)" ::: "memory");
        }
    }
    __syncthreads();
}

constexpr int NWAVES = 8;
__device__ __forceinline__ float wave_sum(float v) {
#pragma unroll
    for (int o = 1; o < 64; o <<= 1) v += __shfl_xor(v, o);
    return v;
}
__device__ __forceinline__ int colmap_inproj(int n) { if (n < 832) return n; if (n < 840) return 3904 + (n - 832); if (n < 1024) return -1; if (n < 4096) return n - 192; return n - 184; }
__device__ __forceinline__ int colmap_uq(int n) { const int h = n >> 8, j = n & 255; if (j < 128) return h * 192 + j; if (j >= 192) return -1;
    const int p = j - 128, g = p >> 3, w = p & 7; return h * 192 + 128 + (w < 4 ? 4 * g + w : 32 + 4 * g + (w - 4)); }
template <int MAP> __device__ __forceinline__ void transpose_item(const float* W, int K, int Nsrc, const float* gk, bf16* WT, int nblk, LAS float* scr, int item, int lane) {
    const int kb = item / nblk, nb = item % nblk, k0 = 64 * kb, n0 = 64 * nb;
    const int krow = lane >> 4, nq = lane & 15, nd = n0 + 4 * nq; const int ns = MAP == 0 ? nd : MAP == 1 ? colmap_inproj(nd) : colmap_uq(nd);
    f32x4 v[16];
#pragma unroll
    for (int i = 0; i < 16; ++i) { v[i] = (f32x4){0.f, 0.f, 0.f, 0.f}; if (ns >= 0) v[i] = *(const f32x4*)(W + (size_t)(k0 + 4 * i + krow) * Nsrc + ns); }
#pragma unroll
    for (int i = 0; i < 16; ++i) { const int kk = 4 * i + krow; f32x4 t = v[i]; if (gk) t = t * gk[k0 + kk];
        LAS float* p = scr + kk * 65 + 4 * nq; p[0] = t[0]; p[1] = t[1]; p[2] = t[2]; p[3] = t[3]; }
    LDS_WAIT(); asm volatile("" ::: "memory");
    const int c = lane & 7;
#pragma unroll
    for (int j = 0; j < 8; ++j) { const int n = (lane >> 3) + 8 * j; const LAS float* s = scr + (8 * c) * 65 + n;
        u32x4 o; o.x = cvt_pk_bf16(s[0 * 65], s[1 * 65]); o.y = cvt_pk_bf16(s[2 * 65], s[3 * 65]); o.z = cvt_pk_bf16(s[4 * 65], s[5 * 65]); o.w = cvt_pk_bf16(s[6 * 65], s[7 * 65]);
        *(u32x4*)(WT + (size_t)(n0 + n) * K + k0 + 8 * c) = o; }
    LDS_WAIT(); asm volatile("" ::: "memory");
}
__device__ __forceinline__ float row_to_bf16(const float* xrow, bf16* orow, int lane) {
    f32x4 v[8]; float s = 0.f;
#pragma unroll
    for (int j = 0; j < 8; ++j) { v[j] = ((const f32x4*)xrow)[lane + 64 * j]; s += sumsq4(v[j]); }
#pragma unroll
    for (int j = 0; j < 8; ++j) { u32x2 w; w.x = cvt_pk_bf16(v[j][0], v[j][1]); w.y = cvt_pk_bf16(v[j][2], v[j][3]); ((u32x2*)orow)[lane + 64 * j] = w; }
    return wave_sum(s);
}

struct Args { const float* in[N_IN]; float* out; unsigned char* ws; int g_lo, g_hi; };
constexpr size_t in_stride(int k) {
    return k == IG_MIX ? 2048 : k == IW_IN ? (size_t)2048 * DIN_SRC : k == IG_CQ ? 512 : k == IW_UQ ? (size_t)512 * 1536 : k == IG_CKV ? 256 : k == IW_UKV ? (size_t)256 * 2048 :
           k == IG_MLAQ ? 192 : k == IG_MLAK ? 192 : k == IB_F ? 8 : k == IG_FOXQ ? 128 : k == IG_FOXK ? 128 : k == IRELB ? 8 * 257 : k == IG_CHQ ? 128 : k == IG_CHK ? 128 :
           k == IW_BR ? (size_t)3 * 1024 * 2048 : k == IW_OUT ? (size_t)2048 * 2048 : k == IG_CROSS ? 2048 : k == IG_MEM ? 2048 : k == IW_XQ ? (size_t)2048 * 512 :
           k == IW_XKV ? (size_t)2048 * 1024 : k == IG_XQ ? 128 : k == IG_XK ? 128 : k == IW_XO ? (size_t)512 * 2048 : k == IG_MLP ? 2048 : k == IW_1 ? (size_t)2048 * 8192 :
           k == IW_2 ? (size_t)8192 * 2048 : 0;
}
#define LIN(k, l) (args.in[k] + (size_t)(l) * in_stride(k))

__device__ __forceinline__ void prologue(const Args& args, LAS unsigned char* lds, int lane, int wave) {
    unsigned char* ws = args.ws;
    LAS float* scr = (LAS float*)(lds + wave * 16640);
    const int gw = blockIdx.x * NWAVES + wave, NGW = gridDim.x * NWAVES;
    constexpr int I_IN = (2048 / 64) * (NIN / 64), I_UQ = (512 / 64) * (2048 / 64), I_UKV = (256 / 64) * (2048 / 64), I_BR1 = (1024 / 64) * (2048 / 64), I_OUT = (2048 / 64) * (2048 / 64),
                  I_XQ = (2048 / 64) * (512 / 64), I_XKV = (2048 / 64) * (1024 / 64), I_XO = (512 / 64) * (2048 / 64), I_1 = (2048 / 64) * (8192 / 64), I_2 = (8192 / 64) * (2048 / 64);
    constexpr int I_LAYER = I_IN + I_UQ + I_UKV + 3 * I_BR1 + I_OUT + I_XQ + I_XKV + I_XO + I_1 + I_2;
    for (int it = gw; it < NL * I_LAYER; it += NGW) {
        const int l = it / I_LAYER; int r = it % I_LAYER;
        unsigned char* wl = ws + WS_W + (size_t)l * W_LAYER;
        if (r < I_IN) { transpose_item<1>(LIN(IW_IN, l), 2048, DIN_SRC, LIN(IG_MIX, l), (bf16*)(wl + WO_IN), NIN / 64, scr, r, lane); continue; } r -= I_IN;
        if (r < I_UQ) { transpose_item<2>(LIN(IW_UQ, l), 512, 1536, LIN(IG_CQ, l), (bf16*)(wl + WO_UQ), 2048 / 64, scr, r, lane); continue; } r -= I_UQ;
        if (r < I_UKV) { transpose_item<0>(LIN(IW_UKV, l), 256, 2048, LIN(IG_CKV, l), (bf16*)(wl + WO_UKV), 2048 / 64, scr, r, lane); continue; } r -= I_UKV;
        if (r < 3 * I_BR1) { const int z = r / I_BR1; transpose_item<0>(LIN(IW_BR, l) + (size_t)z * 1024 * 2048, 1024, 2048, nullptr, (bf16*)(wl + WO_BR) + (size_t)z * 2048 * 1024, 2048 / 64, scr, r % I_BR1, lane); continue; } r -= 3 * I_BR1;
        if (r < I_OUT) { transpose_item<0>(LIN(IW_OUT, l), 2048, 2048, nullptr, (bf16*)(wl + WO_OUT), 2048 / 64, scr, r, lane); continue; } r -= I_OUT;
        if (r < I_XQ) { transpose_item<0>(LIN(IW_XQ, l), 2048, 512, LIN(IG_CROSS, l), (bf16*)(wl + WO_XQ), 512 / 64, scr, r, lane); continue; } r -= I_XQ;
        if (r < I_XKV) { transpose_item<0>(LIN(IW_XKV, l), 2048, 1024, LIN(IG_MEM, l), (bf16*)(wl + WO_XKV), 1024 / 64, scr, r, lane); continue; } r -= I_XKV;
        if (r < I_XO) { transpose_item<0>(LIN(IW_XO, l), 512, 2048, nullptr, (bf16*)(wl + WO_XO), 2048 / 64, scr, r, lane); continue; } r -= I_XO;
        if (r < I_1) { transpose_item<0>(LIN(IW_1, l), 2048, 8192, LIN(IG_MLP, l), (bf16*)(wl + WO_1), 8192 / 64, scr, r, lane); continue; } r -= I_1;
        transpose_item<0>(LIN(IW_2, l), 8192, 2048, nullptr, (bf16*)(wl + WO_2), 2048 / 64, scr, r, lane);
    }
    for (int m = gw; m < T; m += NGW) { const float s = row_to_bf16(args.in[IX] + (size_t)m * DM, (bf16*)(ws + WS_XB) + (size_t)m * DM, lane);
        if (lane < 8) ((float*)(ws + WS_SSQX))[(size_t)m * 8 + lane] = lane == 0 ? s : 0.f; }
    for (int m = gw; m < NBATCH * 256; m += NGW) { const float s = row_to_bf16(args.in[IMEM] + (size_t)m * DM, (bf16*)(ws + WS_MEMB) + (size_t)m * DM, lane);
        if (lane == 0) ((float*)(ws + WS_RSTDMEM))[m] = rsq(s * (1.0f / DM) + EPS); }
    for (int e = gw * 64 + lane; e < NL * 768; e += NGW * 64) { const int l = e / 768, k = (e % 768) >> 7, c = e & 127;
        ((float*)(ws + WS_GT))[e] = k == 0 ? LIN(IG_FOXQ, l)[c] : k == 1 ? LIN(IG_FOXK, l)[c] : k == 3 ? LIN(IG_CHQ, l)[c] : k == 4 ? LIN(IG_CHK, l)[c] : 1.0f; }
    for (int e = gw * 64 + lane; e < SEQ * 32; e += NGW * 64) { const int pos = e >> 5, i = e & 31;
        const float inv = exp2f(-(float)i * (13.287712379549449f / 32.0f)); const float ang = (float)pos * inv;
        ((float*)(ws + WS_COS))[e] = cosf(ang); ((float*)(ws + WS_SIN))[e] = sinf(ang); }
}

__device__ __forceinline__ void cumsum_phase(const float* logf, float* cum, int lane, int wave) {
    const int gw = blockIdx.x * NWAVES + wave;
    if (gw >= NBATCH * 8) return;
    const int b = gw >> 3, h = gw & 7;
    float v[32]; float run = 0.f;
#pragma unroll
    for (int j = 0; j < 32; ++j) { run += logf[((size_t)b * SEQ + lane * 32 + j) * 8 + h]; v[j] = run; }
    float incl = run;
#pragma unroll
    for (int o = 1; o < 64; o <<= 1) { const float t = __shfl_up(incl, o); if (lane >= o) incl += t; }
    const float excl = incl - run;
#pragma unroll
    for (int j = 0; j < 32; ++j) cum[((size_t)b * 8 + h) * SEQ + lane * 32 + j] = v[j] + excl;
}

struct AttnS { const bf16* Q; const bf16* K; const bf16* V; bf16* O; int mode, DK, NH, SK, ldo; const float* cum; const float* relb; };
__device__ __forceinline__ void attn_simple_unit(const AttnS& A, int b, int h, int qt, LAS unsigned char* lds, int tid) {
    const int DK = A.DK, DKP = DK + 1, KP = DK + 2;
    LAS float* qs = (LAS float*)lds;
    LAS bf16* Ks = (LAS bf16*)(lds + 64 * 193 * 4);
    LAS bf16* Vs = (LAS bf16*)(lds + 64 * 193 * 4 + 64 * 194 * 2);
    LAS float* Ps = (LAS float*)(lds + 64 * 193 * 4 + 64 * 194 * 2 + 64 * 130 * 2);
    const int r = tid >> 3, sub = tid & 7;
    const float scale = rsqrtf((float)DK);
    const size_t qbase = ((size_t)(b * A.NH + h) * SEQ + qt * 64) * DK, kvbase = (size_t)(b * A.NH + h) * A.SK;
    __syncthreads();
    for (int e = tid; e < 64 * DK; e += 512) { const int rr = e / DK, d = e % DK; qs[rr * DKP + d] = bf2f(A.Q[qbase + e]) * scale; }
    const int qpos = qt * 64 + r;
    float m_run = -3.0e38f, l_run = 0.f; float o[16];
#pragma unroll
    for (int d = 0; d < 16; ++d) o[d] = 0.f;
    int j_lo = 0, j_hi = qt + 1;
    if (A.mode == 2) j_lo = qt > 8 ? qt - 8 : 0;
    if (A.mode == 3) { j_lo = 0; j_hi = A.SK / 64; }
    const float cq = A.mode == 1 ? A.cum[(size_t)(b * 8 + h) * SEQ + qpos] : 0.f;
    for (int j = j_lo; j < j_hi; ++j) {
        __syncthreads();
        for (int e = tid; e < 64 * DK; e += 512) { const int kk = e / DK, d = e % DK; Ks[kk * KP + d] = A.K[(kvbase + j * 64 + kk) * DK + d]; }
        for (int e = tid; e < 64 * 128; e += 512) { const int kk = e >> 7, d = e & 127; Vs[kk * 130 + d] = A.V[(kvbase + j * 64 + kk) * 128 + d]; }
        __syncthreads();
        float sc[8]; float tmax = -3.0e38f;
#pragma unroll
        for (int kk = 0; kk < 8; ++kk) { const int key = sub + 8 * kk; float s = 0.f;
            for (int d = 0; d < DK; d += 2) { const unsigned w = *(const LAS unsigned*)(Ks + key * KP + d); s += qs[r * DKP + d] * bf_lo(w) + qs[r * DKP + d + 1] * bf_hi(w); }
            const int kpos = j * 64 + key; bool ok = true;
            if (A.mode == 1) { ok = kpos <= qpos; s += cq - A.cum[(size_t)(b * 8 + h) * SEQ + kpos]; }
            if (A.mode == 2) { int rel = qpos - kpos; rel = rel < -128 ? -128 : rel > 128 ? 128 : rel; s += A.relb[h * 257 + rel + 128]; }
            s = ok ? s : -1.0e30f; sc[kk] = s; tmax = fmaxf(tmax, s); }
        tmax = fmaxf(tmax, __shfl_xor(tmax, 1)); tmax = fmaxf(tmax, __shfl_xor(tmax, 2)); tmax = fmaxf(tmax, __shfl_xor(tmax, 4));
        const float m_new = fmaxf(m_run, tmax), alpha = __expf(m_run - m_new); float ps = 0.f;
#pragma unroll
        for (int kk = 0; kk < 8; ++kk) { const float p = __expf(sc[kk] - m_new); ps += p; Ps[r * 65 + sub + 8 * kk] = p; }
        ps += __shfl_xor(ps, 1); ps += __shfl_xor(ps, 2); ps += __shfl_xor(ps, 4);
        l_run = l_run * alpha + ps; m_run = m_new;
        __syncthreads();
#pragma unroll
        for (int d = 0; d < 16; ++d) o[d] *= alpha;
        for (int key = 0; key < 64; ++key) { const float p = Ps[r * 65 + key];
#pragma unroll
            for (int d = 0; d < 16; d += 2) { const unsigned w = *(const LAS unsigned*)(Vs + key * 130 + sub * 16 + d); o[d] += p * bf_lo(w); o[d + 1] += p * bf_hi(w); } }
    }
    const float il = 1.0f / l_run;
    bf16* op = A.O + (size_t)(b * SEQ + qt * 64 + r) * A.ldo + h * 128 + sub * 16;
    u32x4 w0, w1; w0.x = cvt_pk_bf16(o[0] * il, o[1] * il); w0.y = cvt_pk_bf16(o[2] * il, o[3] * il); w0.z = cvt_pk_bf16(o[4] * il, o[5] * il); w0.w = cvt_pk_bf16(o[6] * il, o[7] * il);
    w1.x = cvt_pk_bf16(o[8] * il, o[9] * il); w1.y = cvt_pk_bf16(o[10] * il, o[11] * il); w1.z = cvt_pk_bf16(o[12] * il, o[13] * il); w1.w = cvt_pk_bf16(o[14] * il, o[15] * il);
    *(u32x4*)op = w0; *(u32x4*)(op + 8) = w1;
}

constexpr int NPH = 10;
constexpr int NPHASE = 1 + NL * NPH;
__global__ void __launch_bounds__(NWAVES * 64, 2) fwd_kernel(Args args) {
    extern __shared__ __attribute__((aligned(16))) unsigned char lds_raw[];
    LAS unsigned char* lds = (LAS unsigned char*)lds_raw;
    volatile LAS unsigned* MISC = (volatile LAS unsigned*)(lds + MISC_OFF);
    const int tid0 = threadIdx.x, wave = __builtin_amdgcn_readfirstlane(tid0 >> 6);
    const int G = gridDim.x, bx = blockIdx.x, vcu = (G % 8 == 0) ? (bx % 8) * (G / 8) + bx / 8 : bx;
    unsigned char* const ws0 = args.ws;
    unsigned* ctl = (unsigned*)(ws0 + WS_CTL);
    for (int u = tid0; u < 256; u += NWAVES * 64) MISC[u] = 0u;
    __syncthreads();
#if MK_PER_PHASE
#define SEAM(g) do { } while (0)
#else
    XcdBarrier bar = xcd_barrier_post(ctl + 4096, MISC + 8);
#define SEAM(g) do { if ((g) + 1 < g_hi) xcd_barrier(bar); } while (0)
#endif
    const int g_lo = args.g_lo, g_hi = args.g_hi;
#ifndef PH_MASK
#define PH_MASK 0x7ff
#endif
#define IN(g) (g_lo <= (g) && (g) < g_hi)
#ifndef REP_PH
#define REP_PH -1
#endif
#ifndef REP_N
#define REP_N 1
#endif
#define REPS(p) for (int rep_ = 0; rep_ < ((p) == REP_PH ? REP_N : 1); ++rep_)
    LAS float* escr = (LAS float*)(lds + ESCR_OFF);

    if ((PH_MASK & 1) && IN(0)) { REPS(0) { prologue(args, lds, tid0 & 63, wave); if (REP_PH == 0) __syncthreads(); } SEAM(0); }

#define OPAQUE_PTRS() size_t zoff_ = 0; asm volatile("" : "+s"(zoff_)); unsigned char* ws = ws0 + zoff_;     \
    int tid = tid0; asm volatile("" : "+v"(tid)); const int lane = tid & 63; (void)lane; unsigned char* wl = ws + WS_W + (size_t)l * W_LAYER; float* ssqx = (float*)(ws + WS_SSQX); bf16* xb = (bf16*)(ws + WS_XB); \
    const float* cosT = (const float*)(ws + WS_COS); const float* sinT = (const float*)(ws + WS_SIN); (void)wl; (void)ssqx; (void)xb; (void)cosT; (void)sinT
    for (int l = 0; l < NL; ++l) {
        const int gb = 1 + l * NPH;
        if ((PH_MASK & 2) && IN(gb + 0)) REPS(1) {
            OPAQUE_PTRS();
            pg8::Gemm g{xb, (const bf16*)(wl + WO_IN), T, NIN, 2048, 0, 0}; pg8::StaticOrder S; S.init(T, NIN, G, bx);
            EpiInProj E{ssqx, (bf16*)(ws + WS_CQ), (float*)(ws + WS_SSQCQ), (bf16*)(ws + WS_CKV), (float*)(ws + WS_SSQCKV), (float*)(ws + WS_KR), (float*)(ws + WS_SSQKR),
                        (float*)(ws + WS_LOGF), LIN(IB_F, l), (bf16*)(ws + WS_FQ), (const float*)(ws + WS_GT) + l * 768, (bf16*)(ws + WS_GATES), escr};
            pg8::gemm_phase<EpiInProj, pg8::StaticOrder, true, true>(lds, g, S, E);
            SEAM(gb + 0);
        }
        if ((PH_MASK & 4) && IN(gb + 1)) REPS(2) {
            OPAQUE_PTRS();
#ifndef P1MASK
#define P1MASK 7
#endif
            if (P1MASK & 1) { pg8::Gemm g{(const bf16*)(ws + WS_CQ), (const bf16*)(wl + WO_UQ), T, 2048, 512, 0, 0}; pg8::StaticOrder S; S.init(T, 2048, G, bx);
              EpiQUp E{(const float*)(ws + WS_SSQCQ), LIN(IG_MLAQ, l), cosT, sinT, (bf16*)(ws + WS_MQ), escr};
              pg8::gemm_phase<EpiQUp, pg8::StaticOrder, true, true>(lds, g, S, E); }
            if (P1MASK & 2) { pg8::Gemm g{(const bf16*)(ws + WS_CKV), (const bf16*)(wl + WO_UKV), T, 2048, 256, 0, 0}; pg8::StaticOrder S; S.init(T, 2048, G, bx);
              EpiKvUp E{(const float*)(ws + WS_SSQCKV), (const float*)(ws + WS_SSQKR), (const float*)(ws + WS_KR), LIN(IG_MLAK, l), cosT, sinT, (bf16*)(ws + WS_MK), (bf16*)(ws + WS_MV), escr + 2048};
              pg8::gemm_phase<EpiKvUp, pg8::StaticOrder, true, true>(lds, g, S, E); }
            if (P1MASK & 4) cumsum_phase((const float*)(ws + WS_LOGF), (float*)(ws + WS_CUM), lane, wave);
            SEAM(gb + 1);
        }
        if ((PH_MASK & 8) && IN(gb + 2)) REPS(3) {
            OPAQUE_PTRS();
#if ATTN_SIMPLE
            for (int it = bx; it < 3 * NBATCH * 8 * 32; it += G) {
                const int br = it / (NBATCH * 8 * 32), r = it % (NBATCH * 8 * 32), b = r / (8 * 32), h = (r / 32) % 8, qt = 31 - (r % 32);
                AttnS A;
                if (br == 0) A = AttnS{(const bf16*)(ws + WS_MQ), (const bf16*)(ws + WS_MK), (const bf16*)(ws + WS_MV), (bf16*)(ws + WS_Y), 0, 192, 8, SEQ, 1024, nullptr, nullptr};
                else if (br == 1) A = AttnS{(const bf16*)(ws + WS_FQ), (const bf16*)(ws + WS_FK), (const bf16*)(ws + WS_FV), (bf16*)(ws + WS_Y) + (size_t)T * 1024, 1, 128, 8, SEQ, 1024, (const float*)(ws + WS_CUM), nullptr};
                else A = AttnS{(const bf16*)(ws + WS_CHQ), (const bf16*)(ws + WS_CHK), (const bf16*)(ws + WS_CHV), (bf16*)(ws + WS_Y) + (size_t)2 * T * 1024, 2, 128, 8, SEQ, 1024, nullptr, LIN(IRELB, l)};
                attn_simple_unit(A, b, h, qt, lds, tid);
            }
#else
            for (int c = vcu; c < 256; c += G) {
                const int bh = c >> 3, q = c & 7, b = bh >> 3, h = bh & 7;
#ifndef A2MASK
#define A2MASK 7
#endif
                if (A2MASK & 1) { const int qb = q; const att::Blk k{(const bf16*)(ws + WS_MQ) + ((size_t)bh * SEQ + qb * 256) * 192, (const bf16*)(ws + WS_MK) + (size_t)bh * SEQ * 192, (const bf16*)(ws + WS_MV) + (size_t)bh * SEQ * 128,
                      (bf16*)(ws + WS_Y) + ((size_t)b * SEQ + qb * 256) * 1024 + h * 128, qb * 256, 1024, nullptr, nullptr};
                  att::attn_block<0>(k, SEQ, (char*)lds_raw); }
                if (A2MASK & 2) { const int qb = 7 - q; const att::Blk k{(const bf16*)(ws + WS_FQ) + ((size_t)bh * SEQ + qb * 256) * 128, (const bf16*)(ws + WS_FK) + (size_t)bh * SEQ * 128, (const bf16*)(ws + WS_FV) + (size_t)bh * SEQ * 128,
                      (bf16*)(ws + WS_Y) + (size_t)T * 1024 + ((size_t)b * SEQ + qb * 256) * 1024 + h * 128, qb * 256, 1024, (const float*)(ws + WS_CUM) + (size_t)bh * SEQ, nullptr};
                  att::attn_block<1>(k, SEQ, (char*)lds_raw); }
                if (A2MASK & 4) { const int qb = q == 7 ? 0 : q == 6 ? 1 : 7 - q; const att::Blk k{(const bf16*)(ws + WS_CHQ) + ((size_t)bh * SEQ + qb * 256) * 128, (const bf16*)(ws + WS_CHK) + (size_t)bh * SEQ * 128, (const bf16*)(ws + WS_CHV) + (size_t)bh * SEQ * 128,
                      (bf16*)(ws + WS_Y) + (size_t)2 * T * 1024 + ((size_t)b * SEQ + qb * 256) * 1024 + h * 128, qb * 256, 1024, nullptr, LIN(IRELB, l) + h * 257};
                  att::attn_block<2>(k, SEQ, (char*)lds_raw); }
            }
#endif
            __syncthreads();
            SEAM(gb + 2);
        }
        if ((PH_MASK & 16) && IN(gb + 3)) REPS(4) {
            OPAQUE_PTRS();
            pg8::Gemm g{(const bf16*)(ws + WS_Y), (const bf16*)(wl + WO_BR), T, 2048, 1024, (size_t)T * 1024 * 2, (size_t)2048 * 1024 * 2}; pg8::ZOrder<3> S; S.init(T, 2048, G, bx);
            EpiBr E{(const bf16*)(ws + WS_GATES), (bf16*)(ws + WS_MERGED)};
            pg8::gemm_phase<EpiBr, pg8::ZOrder<3>, true, true>(lds, g, S, E);
            SEAM(gb + 3);
        }
        if ((PH_MASK & 32) && IN(gb + 4)) REPS(5) {
            OPAQUE_PTRS();
            pg8::Gemm g{(const bf16*)(ws + WS_MERGED), (const bf16*)(wl + WO_OUT), T, 2048, 2048, 0, 0}; pg8::StaticOrder S; S.init(T, 2048, G, bx);
            EpiResid E{l == 0 ? args.in[IX] : args.out, args.out, xb, ssqx, escr};
            pg8::gemm_phase<EpiResid, pg8::StaticOrder, true, true>(lds, g, S, E);
            SEAM(gb + 4);
        }
        if ((PH_MASK & 64) && IN(gb + 5)) REPS(6) {
            OPAQUE_PTRS();
            { pg8::Gemm g{xb, (const bf16*)(wl + WO_XQ), T, 512, 2048, 0, 0}; pg8::StaticOrder S; S.init(T, 512, G, bx);
              EpiHeadNorm E{ssqx, nullptr, LIN(IG_XQ, l), (bf16*)(ws + WS_XQ), nullptr, 2, SEQ, 11, escr};
              pg8::gemm_phase<EpiHeadNorm, pg8::StaticOrder, true, true>(lds, g, S, E); }
            { pg8::Gemm g{(const bf16*)(ws + WS_MEMB), (const bf16*)(wl + WO_XKV), NBATCH * 256, 1024, 2048, 0, 0}; pg8::StaticOrder S; S.init(NBATCH * 256, 1024, G, (bx + G - 64) % G);
              EpiHeadNorm E{nullptr, (const float*)(ws + WS_RSTDMEM), LIN(IG_XK, l), (bf16*)(ws + WS_XK), (bf16*)(ws + WS_XV), 2, 256, 8, escr + 2048};
              pg8::gemm_phase<EpiHeadNorm, pg8::StaticOrder, true, true>(lds, g, S, E); }
            SEAM(gb + 5);
        }
        if ((PH_MASK & 128) && IN(gb + 6)) REPS(7) {
            OPAQUE_PTRS();
#if ATTN_SIMPLE
            for (int it = bx; it < NBATCH * 4 * 32; it += G) {
                const int b = it / (4 * 32), h = (it / 32) % 4, qt = it % 32;
                const AttnS A{(const bf16*)(ws + WS_XQ), (const bf16*)(ws + WS_XK), (const bf16*)(ws + WS_XV), (bf16*)(ws + WS_OX), 3, 128, 4, 256, 512, nullptr, nullptr};
                attn_simple_unit(A, b, h, qt, lds, tid);
            }
#else
            for (int c = vcu; c < 128; c += G) {
                const int bh = c >> 3, qb = c & 7, b = bh >> 2, h = bh & 3;
                const att::Blk k{(const bf16*)(ws + WS_XQ) + ((size_t)bh * SEQ + qb * 256) * 128, (const bf16*)(ws + WS_XK) + (size_t)bh * 256 * 128, (const bf16*)(ws + WS_XV) + (size_t)bh * 256 * 128,
                    (bf16*)(ws + WS_OX) + ((size_t)b * SEQ + qb * 256) * 512 + h * 128, qb * 256, 512, nullptr, nullptr};
                att::attn_block<3>(k, 256, (char*)lds_raw);
            }
#endif
            __syncthreads();
            SEAM(gb + 6);
        }
        if ((PH_MASK & 256) && IN(gb + 7)) REPS(8) {
            OPAQUE_PTRS();
            pg8::Gemm g{(const bf16*)(ws + WS_OX), (const bf16*)(wl + WO_XO), T, 2048, 512, 0, 0}; pg8::StaticOrder S; S.init(T, 2048, G, bx);
            EpiResid E{args.out, args.out, xb, ssqx, escr};
            pg8::gemm_phase<EpiResid, pg8::StaticOrder, true, true>(lds, g, S, E);
            SEAM(gb + 7);
        }
        if ((PH_MASK & 512) && IN(gb + 8)) REPS(9) {
            OPAQUE_PTRS();
            pg8::Gemm g{xb, (const bf16*)(wl + WO_1), T, FF, 2048, 0, 0}; pg8::StaticOrder S; S.init(T, FF, G, bx);
            EpiMlp1 E{ssqx, (bf16*)(ws + WS_H)};
            pg8::gemm_phase<EpiMlp1, pg8::StaticOrder, true, true>(lds, g, S, E);
            SEAM(gb + 8);
        }
        if ((PH_MASK & 1024) && IN(gb + 9)) REPS(10) {
            OPAQUE_PTRS();
            pg8::Gemm g{(const bf16*)(ws + WS_H), (const bf16*)(wl + WO_2), T, 2048, FF, 0, 0}; pg8::StaticOrder S; S.init(T, 2048, G, bx);
            EpiResid E{args.out, args.out, xb, ssqx, escr};
            pg8::gemm_phase<EpiResid, pg8::StaticOrder, true, true>(lds, g, S, E);
            SEAM(gb + 9);
        }
    }
#undef IN
#undef SEAM
}

extern "C" void kernel_launch(void* const* d_in, const int* in_sizes, int n_in, void* d_out, int out_size, void* d_ws, size_t ws_size, hipStream_t stream) {
    static int grid = 0;
    if (grid == 0) {
        if (n_in != N_IN || in_sizes[0] != T * DM || out_size != T * DM || ws_size < WS_END) { fprintf(stderr, "kernel_launch: unexpected shapes (n_in %d, in0 %d, out %d, ws %zu < %zu)\n", n_in, n_in > 0 ? in_sizes[0] : -1, out_size, ws_size, (size_t)WS_END); grid = -1; return; }
        int dev = 0, cus = 0, per_cu = 0;
        if (hipGetDevice(&dev) != hipSuccess || hipDeviceGetAttribute(&cus, hipDeviceAttributeMultiprocessorCount, dev) != hipSuccess) { grid = -1; return; }
        if (hipFuncSetAttribute((const void*)fwd_kernel, hipFuncAttributeMaxDynamicSharedMemorySize, LDS_BYTES) != hipSuccess) { fprintf(stderr, "kernel_launch: hipFuncSetAttribute failed\n"); grid = -1; return; }
        if (hipOccupancyMaxActiveBlocksPerMultiprocessor(&per_cu, (const void*)fwd_kernel, NWAVES * 64, LDS_BYTES) != hipSuccess || per_cu < 1) fprintf(stderr, "kernel_launch: occupancy query reports %d\n", per_cu);
        (void)hipGetLastError();
        grid = cus;
    }
    if (grid < 0) return;
    if (hipMemsetAsync((char*)d_ws + WS_CTL, 0, CTL_ZERO_BYTES, stream) != hipSuccess) return;
    Args a{};
    for (int i = 0; i < N_IN; ++i) a.in[i] = (const float*)d_in[i];
    a.out = (float*)d_out; a.ws = (unsigned char*)d_ws;
#if MK_PER_PHASE
    for (int g = 0; g < NPHASE; ++g) { a.g_lo = g; a.g_hi = g + 1; hipLaunchKernelGGL(fwd_kernel, dim3(grid), dim3(NWAVES * 64), LDS_BYTES, stream, a); }
#else
    a.g_lo = 0; a.g_hi = NPHASE;
    hipLaunchKernelGGL(fwd_kernel, dim3(grid), dim3(NWAVES * 64), LDS_BYTES, stream, a);
#endif
    const hipError_t le = hipPeekAtLastError();
    if (le != hipSuccess) fprintf(stderr, "kernel_launch: launch failed: %s\n", hipGetErrorName(le));
}
```

```cpp
#include <hip/hip_runtime.h>
#include <cstdio>
#include <cstdint>

#ifndef MK_PER_PHASE
#define MK_PER_PHASE 0
#endif

#ifndef ATTN_SIMPLE
#define ATTN_SIMPLE 0
#endif

namespace pg8 {
#define PG8_LAS __attribute__((address_space(3)))
typedef unsigned short bf16_t;
typedef short bf16x8 __attribute__((ext_vector_type(8)));
typedef float f32x4 __attribute__((ext_vector_type(4)));
typedef unsigned u32x4 __attribute__((ext_vector_type(4)));
constexpr int BM = 256, BK = 64, HALF = 128, HTB = HALF * BK * 2  , STAGE_BYTES = 8 * HTB, NXCD = 8, WGM = 8;

__host__ __device__ __forceinline__ int lds_byte(int r, int c) { const int st = (r >> 4) * 2 + (c >> 5), rr = r & 15, cc = c & 31, ob = rr * 64 + cc * 2; return st * 1024 + (ob ^ (((ob >> 9) & 1) << 5)); }
__host__ __device__ __forceinline__ void stage_rc(int b, int& R, int& C) { const int st = b / 1024, sb = b % 1024, swz = sb ^ (((sb >> 9) & 1) << 5); R = (st >> 1) * 16 + swz / 64; C = (st & 1) * 32 + (swz % 64) / 2; }
__host__ __device__ __forceinline__ int perm32(int rho) { const int n = rho >> 4, i = rho & 15; return 8 * (i >> 2) + 4 * n + (i & 3); }

struct Unit { int pm, pn, z; };
struct Gemm { const bf16_t* A; const bf16_t* Bt; int M, N, K; size_t zA, zB; };

struct StaticOrder {
    int nM, nN, nwg, G, c;
    __host__ __device__ void init(int M, int N, int G_, int c_) { nM = M / BM; nN = N / BM; nwg = nM * nN; G = G_; c = c_; }
    __host__ __device__ bool next(int i, Unit& u) const {
        const long L = (long)i * G + c; if (L >= nwg) return false;
        int wgid = (int)L; { const int q = nwg / NXCD, r = nwg % NXCD, xcd = wgid % NXCD, off = wgid / NXCD; wgid = (xcd < r ? xcd * (q + 1) : r * (q + 1) + (xcd - r) * q) + off; }
        const int nig = WGM * nN, gid = wgid / nig, fm = gid * WGM, gsz = (nM - fm) < WGM ? (nM - fm) : WGM;
        u.pm = fm + ((wgid % nig) % gsz); u.pn = (wgid % nig) / gsz; u.z = 0; return true;
    }
    __device__ __forceinline__ void a_ready(const Unit&) const {}
    __device__ __forceinline__ void done(const Unit&) const {}
};

template <int NZ> struct ZOrder {
    StaticOrder so;
    __host__ __device__ void init(int M, int N, int G_, int c_) { so.init(M, N, G_, c_); }
    __host__ __device__ bool next(int i, Unit& u) const { if (!so.next(i / NZ, u)) return false; u.z = i % NZ; return true; }
    __device__ __forceinline__ void a_ready(const Unit&) const {}
    __device__ __forceinline__ void done(const Unit&) const {}
};

__device__ __forceinline__ unsigned cvt_pk_bf16(float lo, float hi) { unsigned r; asm volatile("v_cvt_pk_bf16_f32 %0, %1, %2" : "=v"(r) : "v"(lo), "v"(hi)); return r; }
typedef float f32x2 __attribute__((ext_vector_type(2)));
template <class Epi, class Sched, bool ALIGN_EPI = false, bool SP2 = false>
__device__ __forceinline__ void gemm_phase(PG8_LAS unsigned char* lds, const Gemm g, const Sched& S, const Epi& E, const int wave_id  ) {
    int l_; asm volatile("v_mbcnt_lo_u32_b32 %0, -1, 0\n\tv_mbcnt_hi_u32_b32 %0, -1, %0" : "=v"(l_));
    const int wid = wave_id, tid = wid * 64 + l_, lane = l_, wr = wid >> 2, wc = wid & 3, fr = lane & 15, fq = lane >> 4;
    const int K = g.K, nt = K / BK;
    unsigned voffA[2], voffB[2];
#pragma unroll
    for (int i = 0; i < 2; ++i) { int R, C; stage_rc(tid * 16 + i * 8192, R, C); const int Rb = Epi::PERM ? ((R & ~31) + perm32(R & 31)) : R;
        voffA[i] = (unsigned)(R * K + C) * 2u; voffB[i] = (unsigned)(Rb * K + C) * 2u; }
    const size_t kstep = (size_t)(BK * 2);
    const size_t hstep = (size_t)HALF * K * 2;
    const size_t tstep = 2 * hstep;
    const unsigned ldsw = (unsigned)wid * 1024u;
    const int aoff = lds_byte(wr * 64 + fr, fq * 8), boff = lds_byte(wc * 32 + fr, fq * 8);
#define PG8_SA(b, h) (((b) * 2 + (h)) * HTB)
#define PG8_SB(b, h) ((4 + (b) * 2 + (h)) * HTB)
#define PG8_STAGE(bufoff, gbase, voff) do { _Pragma("unroll") for (int _i = 0; _i < 2; ++_i) \
        __builtin_amdgcn_global_load_lds((const unsigned*)((const char*)(gbase) + (voff)[_i]), (PG8_LAS unsigned*)(lds + (bufoff) + ldsw + _i * 8192), 16, 0, 0); } while (0)
#define PG8_LDA(dst, b, h) do { _Pragma("unroll") for (int m = 0; m < 4; ++m) _Pragma("unroll") for (int k = 0; k < 2; ++k) dst[m][k] = *(const PG8_LAS bf16x8*)(lds + PG8_SA(b, h) + aoff + m * 2048 + k * 1024); } while (0)
#define PG8_LDB(dst, b, h) do { _Pragma("unroll") for (int n = 0; n < 2; ++n) _Pragma("unroll") for (int k = 0; k < 2; ++k) dst[n][k] = *(const PG8_LAS bf16x8*)(lds + PG8_SB(b, h) + boff + n * 2048 + k * 1024); } while (0)
#define PG8_MMA(ai, bj, At, Bt) do { __builtin_amdgcn_s_setprio(1); _Pragma("unroll") for (int m = 0; m < 4; ++m) _Pragma("unroll") for (int n = 0; n < 2; ++n) _Pragma("unroll") for (int k = 0; k < 2; ++k) \
        acc[ai][bj][m][n] = __builtin_amdgcn_mfma_f32_16x16x32_bf16(Bt[n][k], At[m][k], acc[ai][bj][m][n], 0, 0, 0); __builtin_amdgcn_s_setprio(0); } while (0)
#define PG8_WAIT_V(n) asm volatile("s_waitcnt vmcnt(" #n ")" ::: "memory")
#define PG8_WAIT_L(n) asm volatile("s_waitcnt lgkmcnt(" #n ")" ::: "memory")
#define PG8_BAR __builtin_amdgcn_s_barrier()
#define PG8_SCHED __builtin_amdgcn_sched_barrier(0)
    Unit cur, nxt; int ui = 0;
    if (!S.next(0, cur)) return;
    f32x4 acc[2][2][4][2];
    E.init(acc, cur, wr, wc, fr, fq);
    bf16x8 At[4][2], B0[2][2], B1[2][2];
    const char* cA = (const char*)g.A + (size_t)cur.pm * tstep + (size_t)cur.z * g.zA; const char* cB = (const char*)g.Bt + (size_t)cur.pn * tstep + (size_t)cur.z * g.zB;
    S.a_ready(cur);
    if constexpr (SP2) {
        PG8_STAGE(PG8_SB(0, 0), cB, voffB); PG8_STAGE(PG8_SB(0, 1), cB + hstep, voffB); PG8_STAGE(PG8_SA(0, 0), cA, voffA); PG8_STAGE(PG8_SA(0, 1), cA + hstep, voffA);
        if (wr == 1) PG8_BAR;
        PG8_WAIT_V(2); PG8_BAR;
        PG8_STAGE(PG8_SB(1, 0), cB + kstep, voffB); PG8_STAGE(PG8_SA(1, 0), cA + kstep, voffA); PG8_STAGE(PG8_SB(1, 1), cB + hstep + kstep, voffB);
        PG8_WAIT_V(6); PG8_BAR;
    } else {
        PG8_STAGE(PG8_SB(0, 0), cB, voffB); PG8_STAGE(PG8_SA(0, 0), cA, voffA); PG8_STAGE(PG8_SB(0, 1), cB + hstep, voffB); PG8_STAGE(PG8_SA(0, 1), cA + hstep, voffA);
        if (wr == 1) PG8_BAR;
        PG8_WAIT_V(4); PG8_BAR;
        PG8_STAGE(PG8_SB(1, 0), cB + kstep, voffB); PG8_STAGE(PG8_SA(1, 0), cA + kstep, voffA); PG8_STAGE(PG8_SB(1, 1), cB + hstep + kstep, voffB);
        PG8_WAIT_V(6); PG8_BAR;
    }
    for (;;) {
        const bool has_next = S.next(ui + 1, nxt);
        const char* nA = has_next ? (const char*)g.A + (size_t)nxt.pm * tstep + (size_t)nxt.z * g.zA : cA; const char* nB = has_next ? (const char*)g.Bt + (size_t)nxt.pn * tstep + (size_t)nxt.z * g.zB : cB;
#pragma unroll 1
        for (int t = 0; t < nt; t += 2) {
            const bool last = (t == nt - 2);
            const char* a1 = cA + (size_t)(t + 1) * kstep;
            const char* a2 = last ? nA : cA + (size_t)(t + 2) * kstep; const char* b2 = last ? nB : cB + (size_t)(t + 2) * kstep;
            const char* a3 = a2 + kstep; const char* b3 = b2 + kstep;
            if (last && has_next) S.a_ready(nxt);
            if constexpr (SP2) {
            PG8_LDB(B0, 0, 0); PG8_LDB(B1, 0, 1); PG8_SCHED; PG8_LDA(At, 0, 0); PG8_STAGE(PG8_SA(1, 1), a1 + hstep, voffA);
            PG8_WAIT_V(8); PG8_WAIT_L(0); PG8_BAR; PG8_MMA(0, 0, At, B0); PG8_MMA(0, 1, At, B1); PG8_BAR; PG8_SCHED;
            PG8_LDA(At, 0, 1); PG8_STAGE(PG8_SB(0, 0), b2, voffB); PG8_STAGE(PG8_SB(0, 1), b2 + hstep, voffB); PG8_STAGE(PG8_SA(0, 0), a2, voffA);
            PG8_WAIT_V(8); PG8_WAIT_L(0); PG8_BAR; PG8_MMA(1, 0, At, B0); PG8_MMA(1, 1, At, B1); PG8_BAR; PG8_SCHED;
            PG8_LDB(B0, 1, 0); PG8_LDB(B1, 1, 1); PG8_SCHED; PG8_LDA(At, 1, 0); PG8_STAGE(PG8_SA(0, 1), a2 + hstep, voffA);
            PG8_WAIT_V(8); PG8_WAIT_L(0); PG8_BAR; PG8_MMA(0, 0, At, B0); PG8_MMA(0, 1, At, B1); PG8_BAR; PG8_SCHED;
            PG8_LDA(At, 1, 1); PG8_STAGE(PG8_SB(1, 0), b3, voffB); PG8_STAGE(PG8_SB(1, 1), b3 + hstep, voffB); PG8_STAGE(PG8_SA(1, 0), a3, voffA);
            PG8_WAIT_V(8); PG8_WAIT_L(0); PG8_BAR; PG8_MMA(1, 0, At, B0); PG8_MMA(1, 1, At, B1); PG8_BAR; PG8_SCHED;
            } else {
            PG8_LDB(B0, 0, 0); PG8_SCHED; PG8_LDA(At, 0, 0); PG8_STAGE(PG8_SA(1, 1), a1 + hstep, voffA);
            PG8_WAIT_L(8); PG8_BAR; PG8_WAIT_L(0); PG8_MMA(0, 0, At, B0); PG8_BAR; PG8_SCHED;
            PG8_LDB(B1, 0, 1); PG8_STAGE(PG8_SB(0, 0), b2, voffB);
            PG8_BAR; PG8_WAIT_L(0); PG8_MMA(0, 1, At, B1); PG8_BAR;
            PG8_LDA(At, 0, 1); PG8_STAGE(PG8_SA(0, 0), a2, voffA);
            PG8_BAR; PG8_WAIT_L(0); PG8_MMA(1, 0, At, B0); PG8_BAR; PG8_SCHED;
            PG8_STAGE(PG8_SB(0, 1), b2 + hstep, voffB);
            PG8_WAIT_V(6); PG8_BAR; PG8_MMA(1, 1, At, B1); PG8_BAR;
            PG8_LDB(B0, 1, 0); PG8_SCHED; PG8_LDA(At, 1, 0); PG8_STAGE(PG8_SA(0, 1), a2 + hstep, voffA);
            PG8_WAIT_L(8); PG8_BAR; PG8_WAIT_L(0); PG8_MMA(0, 0, At, B0); PG8_BAR; PG8_SCHED;
            PG8_LDB(B1, 1, 1); PG8_STAGE(PG8_SB(1, 0), b3, voffB);
            PG8_BAR; PG8_WAIT_L(0); PG8_MMA(0, 1, At, B1); PG8_BAR;
            PG8_LDA(At, 1, 1); PG8_STAGE(PG8_SA(1, 0), a3, voffA);
            PG8_BAR; PG8_WAIT_L(0); PG8_MMA(1, 0, At, B0); PG8_BAR; PG8_SCHED;
            PG8_STAGE(PG8_SB(1, 1), b3 + hstep, voffB);
            PG8_WAIT_V(6); PG8_BAR; PG8_MMA(1, 1, At, B1); PG8_BAR;
            }
        }
        if constexpr (ALIGN_EPI) { if (wr == 0) PG8_BAR; }
        if constexpr (!Epi::AFTER_DRAIN) { E(acc, cur, wr, wc, fr, fq); S.done(cur); }
        if (!has_next) break;
        E.init(acc, nxt, wr, wc, fr, fq);
        cur = nxt; cA = nA; cB = nB; ++ui;
        if constexpr (ALIGN_EPI) { if (wr == 1) PG8_BAR; }
    }
    PG8_WAIT_V(0);
    if constexpr (!ALIGN_EPI) { if (wr == 0) PG8_BAR; }
    PG8_BAR;
    if constexpr (Epi::AFTER_DRAIN) { E.fused(acc, cur, wr, wc, fr, fq, lds, wid, lane); S.done(cur); }
#undef PG8_SA
#undef PG8_SB
#undef PG8_STAGE
#undef PG8_LDA
#undef PG8_LDB
#undef PG8_MMA
#undef PG8_WAIT_V
#undef PG8_WAIT_L
#undef PG8_BAR
#undef PG8_SCHED
}
}

constexpr int NBATCH = 4, SEQ = 2048, DM = 2048, T = NBATCH * SEQ, NL = 4, FF = 8192;
constexpr int NIN = 13312;
constexpr int DIN_SRC = 13128;
constexpr float EPS = 1e-6f;
enum { IX = 0, IMEM, IG_MIX, IW_IN, IG_CQ, IW_UQ, IG_CKV, IW_UKV, IG_MLAQ, IG_MLAK, IB_F, IG_FOXQ, IG_FOXK, IRELB, IG_CHQ, IG_CHK, IW_BR, IW_OUT,
       IG_CROSS, IG_MEM, IW_XQ, IW_XKV, IG_XQ, IG_XK, IW_XO, IG_MLP, IW_1, IW_2, N_IN };

constexpr size_t MiB = 1u << 20;
constexpr size_t WS_CTL = 0, CTL_ZERO_BYTES = 1 * MiB;
constexpr size_t WS_COS = 1 * MiB, WS_SIN = WS_COS + 256 * 1024, WS_RSTDMEM = WS_SIN + 256 * 1024, WS_GT = WS_RSTDMEM + 4096;
constexpr size_t WS_W = 2 * MiB;
constexpr size_t WO_IN = 0, WO_UQ = WO_IN + (size_t)NIN * 2048 * 2, WO_UKV = WO_UQ + (size_t)2048 * 512 * 2, WO_BR = WO_UKV + (size_t)2048 * 256 * 2,
                 WO_OUT = WO_BR + (size_t)3 * 2048 * 1024 * 2, WO_XQ = WO_OUT + (size_t)2048 * 2048 * 2, WO_XKV = WO_XQ + (size_t)512 * 2048 * 2,
                 WO_XO = WO_XKV + (size_t)1024 * 2048 * 2, WO_1 = WO_XO + (size_t)2048 * 512 * 2, WO_2 = WO_1 + (size_t)8192 * 2048 * 2,
                 W_LAYER = WO_2 + (size_t)2048 * 8192 * 2;
static_assert(W_LAYER == 147 * MiB, "weight map");
constexpr size_t WS_ACT = WS_W + NL * W_LAYER;
constexpr size_t WS_XB = WS_ACT, WS_CQ = WS_XB + 32 * MiB, WS_CKV = WS_CQ + 8 * MiB, WS_KR = WS_CKV + 4 * MiB, WS_SMALL = WS_KR + 2 * MiB;
constexpr size_t WS_SSQX = WS_SMALL, WS_SSQCQ = WS_SSQX + 256 * 1024, WS_SSQCKV = WS_SSQCQ + 64 * 1024, WS_SSQKR = WS_SSQCKV + 32 * 1024,
                 WS_LOGF = WS_SSQKR + 32 * 1024, WS_CUM = WS_LOGF + 256 * 1024;
constexpr size_t WS_FQ = WS_SMALL + 2 * MiB, WS_FK = WS_FQ + 16 * MiB, WS_FV = WS_FK + 16 * MiB, WS_CHQ = WS_FV + 16 * MiB, WS_CHK = WS_CHQ + 16 * MiB, WS_CHV = WS_CHK + 16 * MiB;
constexpr size_t WS_GATES = WS_CHV + 16 * MiB, WS_MQ = WS_GATES + 96 * MiB, WS_MK = WS_MQ + 24 * MiB, WS_MV = WS_MK + 24 * MiB, WS_Y = WS_MV + 16 * MiB;
constexpr size_t WS_MERGED = WS_Y + 48 * MiB, WS_XQ = WS_MERGED + 32 * MiB, WS_MEMB = WS_XQ + 8 * MiB, WS_XK = WS_MEMB + 4 * MiB, WS_XV = WS_XK + 1 * MiB, WS_OX = WS_XV + 1 * MiB;
constexpr size_t WS_H = WS_OX + 8 * MiB, WS_END = WS_H + 128 * MiB;
static_assert(WS_CUM + 256 * 1024 <= WS_FQ, "small map");

constexpr int RING_BYTES = 131072;
constexpr int ESCR_OFF = RING_BYTES, ESCR_BYTES = 16384;
constexpr int MISC_OFF = ESCR_OFF + ESCR_BYTES;
constexpr int LDS_BYTES = MISC_OFF + 1024;

#define GAS __attribute__((address_space(1)))
#define LAS __attribute__((address_space(3)))
typedef unsigned short bf16;
typedef unsigned u32x4 __attribute__((ext_vector_type(4)));
typedef unsigned u32x2 __attribute__((ext_vector_type(2)));
typedef float f32x4 __attribute__((ext_vector_type(4)));
typedef float f32x2 __attribute__((ext_vector_type(2)));
typedef GAS unsigned gu32;
#define RLX_AGENT __ATOMIC_RELAXED, __HIP_MEMORY_SCOPE_AGENT
#define LDS_WAIT() asm volatile("s_waitcnt lgkmcnt(0)" ::: "memory")
#define VM_WAIT() asm volatile("s_waitcnt vmcnt(0)" ::: "memory")
using pg8::cvt_pk_bf16;
__device__ __forceinline__ float bf_lo(unsigned w) { return __uint_as_float(w << 16); }
__device__ __forceinline__ float bf_hi(unsigned w) { return __uint_as_float(w & 0xffff0000u); }
__device__ __forceinline__ float bf2f(bf16 h) { return __uint_as_float((unsigned)h << 16); }
__device__ __forceinline__ u32x4 pack8(f32x4 a, f32x4 b) { u32x4 w; w.x = cvt_pk_bf16(a[0], a[1]); w.y = cvt_pk_bf16(a[2], a[3]); w.z = cvt_pk_bf16(b[0], b[1]); w.w = cvt_pk_bf16(b[2], b[3]); return w; }
__device__ __forceinline__ void unpack8(u32x4 w, f32x4& a, f32x4& b) { a[0] = bf_lo(w.x); a[1] = bf_hi(w.x); a[2] = bf_lo(w.y); a[3] = bf_hi(w.y); b[0] = bf_lo(w.z); b[1] = bf_hi(w.z); b[2] = bf_lo(w.w); b[3] = bf_hi(w.w); }
__device__ __forceinline__ float sumsq4(f32x4 v) { return (v[0] * v[0] + v[1] * v[1]) + (v[2] * v[2] + v[3] * v[3]); }
__device__ __forceinline__ float rsq(float x) { return __builtin_amdgcn_rsqf(x); }
__device__ __forceinline__ float sigmoidf_(float x) { return __builtin_amdgcn_rcpf(1.0f + __expf(-x)); }
__device__ __forceinline__ float log_sigmoidf_(float x) { return fminf(x, 0.f) - log1pf(expf(-fabsf(x))); }

typedef f32x4 Acc[2][2][4][2];
using pg8::Unit;
#define EPI_BAR() do { asm volatile("s_waitcnt lgkmcnt(0)" ::: "memory"); __builtin_amdgcn_s_barrier(); asm volatile("" ::: "memory"); } while (0)
#define EPI_SB() __builtin_amdgcn_sched_barrier(0)
__device__ __forceinline__ void fresh_lane(int& fr, int& fq) { int l; asm volatile("v_mbcnt_lo_u32_b32 %0, -1, 0\n\tv_mbcnt_hi_u32_b32 %0, -1, %0" : "=v"(l)); fr = l & 15; fq = l >> 4; }
template <class V> __device__ __forceinline__ V ldg(const void* base, unsigned boff) { return *(const V*)((const char*)base + boff); }
template <class V> __device__ __forceinline__ void stg(void* base, unsigned boff, V v) { *(V*)((char*)base + boff) = v; }
template <int N> __device__ __forceinline__ void fq_sum(float (&v)[N]) {
    float t[N];
#pragma unroll
    for (int i = 0; i < N; ++i) t[i] = __shfl_xor(v[i], 16);
#pragma unroll
    for (int i = 0; i < N; ++i) v[i] += t[i];
#pragma unroll
    for (int i = 0; i < N; ++i) t[i] = __shfl_xor(v[i], 32);
#pragma unroll
    for (int i = 0; i < N; ++i) v[i] += t[i];
}
template <int NB> __device__ __forceinline__ void xwave_rowsum(float (&s)[8 * NB], LAS float* P, int wr, int wc, int fr) {
    unsigned pw = (unsigned)(uintptr_t)P + (unsigned)(((wr * 64 + fr) * NB * 4 + wc) * 4), pr = (unsigned)(uintptr_t)P + (unsigned)((wr * 64 + fr) * NB * 16);
    asm volatile("" : "+v"(pw), "+v"(pr));
    fq_sum<8 * NB>(s);
#pragma unroll
    for (int am = 0; am < 8; ++am)
#pragma unroll
        for (int b = 0; b < NB; ++b) *(LAS float*)(pw + (unsigned)((((am >> 2) * 128 + (am & 3) * 16) * NB + b) * 16)) = s[am * NB + b];
    EPI_BAR();
#pragma unroll
    for (int am = 0; am < 8; ++am)
#pragma unroll
        for (int b = 0; b < NB; ++b) { const f32x4 t = *(const LAS f32x4*)(pr + (unsigned)((((am >> 2) * 128 + (am & 3) * 16) * NB + b) * 16)); s[am * NB + b] = (t[0] + t[1]) + (t[2] + t[3]); }
}
#define ROWG(am) ((unsigned)(row0 + ((am) >> 2) * 128 + ((am) & 3) * 16))
#define EPI_AM _Pragma("unroll") for (int am = 0; am < 8; ++am)
#define EPI_BJ _Pragma("unroll") for (int bj = 0; bj < 2; ++bj)
#define ACC(bj, n) acc[am >> 2][bj][am & 3][n]
__device__ __forceinline__ void rstd_rows8(const float* ssq8, int row0, int fq, float (&rs)[8]) {
    f32x2 p[8];
    EPI_AM p[am] = ldg<f32x2>(ssq8, ROWG(am) * 32u + fq * 8u);
    EPI_SB();
    EPI_AM rs[am] = p[am][0] + p[am][1];
    fq_sum<8>(rs);
    EPI_AM rs[am] = rsq(rs[am] * (1.0f / DM) + EPS);
}
#define EPI_HEAD(CV) fresh_lane(fr, fq); int row0 = u.pm * 256 + wr * 64 + fr, CV = wc * 32 + fq * (PERM ? 8 : 4); asm volatile("" : "+v"(row0), "+v"(CV), "+v"(fq))
__device__ __forceinline__ void acc_zero(Acc& acc) {
#pragma unroll
    for (int a = 0; a < 2; ++a)
#pragma unroll
        for (int b = 0; b < 2; ++b)
#pragma unroll
            for (int m = 0; m < 4; ++m)
#pragma unroll
                for (int n = 0; n < 2; ++n) acc[a][b][m][n] = (f32x4){0.f, 0.f, 0.f, 0.f};
}

struct EpiInProj {
    static constexpr bool PERM = true, AFTER_DRAIN = false;
    const float* ssqx; bf16* cq; float* ssqcq; bf16* ckv; float* ssqckv; float* kr; float* ssqkr; float* logf; const float* b_f;
    bf16* hm;
    const float* gt;
    bf16* gates; LAS float* scr;
    __device__ __forceinline__ void init(Acc& acc, const Unit&, int, int, int, int) const { acc_zero(acc); }
    __device__ __forceinline__ void operator()(Acc& acc, const Unit& u, int wr, int wc, int fr, int fq) const {
        EPI_HEAD(c8);
        const int pn = u.pn;
        float rs[8]; rstd_rows8(ssqx, row0, fq, rs);
        EPI_AM { EPI_BJ { ACC(bj, 0) *= rs[am]; ACC(bj, 1) *= rs[am]; } }
        if (pn >= 28) {
            EPI_AM { const unsigned row = ROWG(am);
                EPI_BJ { f32x4 a = ACC(bj, 0), b = ACC(bj, 1);
#pragma unroll
                    for (int e = 0; e < 4; ++e) { a[e] = sigmoidf_(a[e]); b[e] = sigmoidf_(b[e]); }
                    stg<u32x4>(gates, row * 12288u + ((pn - 28) * 256 + bj * 128 + c8) * 2u, pack8(a, b)); } }
            return;
        }
        float s[16];
        const bool kr_tile = pn == 3;
        EPI_AM { const float s0 = sumsq4(ACC(0, 0)) + sumsq4(ACC(0, 1)), s1 = sumsq4(ACC(1, 0)) + sumsq4(ACC(1, 1));
            s[am * 2] = (kr_tile && wc >= 2) ? 0.f : s0; s[am * 2 + 1] = kr_tile ? 0.f : s1; }
        xwave_rowsum<2>(s, scr, wr, wc, fr);
        if (pn < 3) {
            EPI_AM { const unsigned row = ROWG(am);
                EPI_BJ { const u32x4 w = pack8(ACC(bj, 0), ACC(bj, 1));
                    if (pn < 2) stg<u32x4>(cq, row * 1024u + (pn * 256 + bj * 128 + c8) * 2u, w); else stg<u32x4>(ckv, row * 512u + (bj * 128 + c8) * 2u, w); } }
            if (wc == 0) { EPI_AM { const unsigned row = ROWG(am); const float tot = s[am * 2] + s[am * 2 + 1];
                if (pn < 2) stg<float>(ssqcq, row * 8u + pn * 4u, tot); else stg<float>(ssqckv, row * 4u, tot); } }
        } else if (pn == 3) {
            if (wc < 2) { EPI_AM { const unsigned row = ROWG(am); stg<f32x4>(kr, row * 256u + c8 * 4u, ACC(0, 0)); stg<f32x4>(kr, row * 256u + c8 * 4u + 16u, ACC(0, 1));
                    if (wc == 0) stg<float>(ssqkr, row * 4u, s[am * 2]); } }
            else if (wc == 2) { const f32x4 b0 = *(const f32x4*)b_f, b1 = *(const f32x4*)(b_f + 4);
                EPI_AM { const unsigned row = ROWG(am); f32x4 a = ACC(0, 0), b = ACC(0, 1);
#pragma unroll
                    for (int e = 0; e < 4; ++e) { a[e] = log_sigmoidf_(a[e] + b0[e]); b[e] = log_sigmoidf_(b[e] + b1[e]); }
                    if (fq == 0) { stg<f32x4>(logf, row * 32u, a); stg<f32x4>(logf, row * 32u + 16u, b); } } }
        } else {
            const int t = pn - 4, seg = t >> 2, hp = t & 3; const bool isv = seg == 2 || seg == 5;
            const f32x4 g0 = ldg<f32x4>(gt, (seg * 128 + c8) * 4u), g1 = ldg<f32x4>(gt, (seg * 128 + c8) * 4u + 16u);
            bf16* dst = hm + (size_t)seg * (8u << 20);
            EPI_AM { const unsigned row = ROWG(am), b = row >> 11, sp = row & 2047u;
                EPI_BJ { const float rh = isv ? 1.0f : rsq(s[am * 2 + bj] * (1.0f / 128.0f) + EPS); const unsigned head = hp * 2 + bj;
                    stg<u32x4>(dst, (((b * 8u + head) * SEQ + sp) * 128u + c8) * 2u, pack8(ACC(bj, 0) * rh * g0, ACC(bj, 1) * rh * g1)); } }
        }
    }
};

struct EpiQUp {
    static constexpr bool PERM = true, AFTER_DRAIN = false;
    const float* ssqcq; const float* gq; const float* cosT; const float* sinT; bf16* mq; LAS float* scr;
    __device__ __forceinline__ void init(Acc& acc, const Unit&, int, int, int, int) const { acc_zero(acc); }
    __device__ __forceinline__ void operator()(Acc& acc, const Unit& u, int wr, int wc, int fr, int fq) const {
        EPI_HEAD(c8);
        const unsigned head = u.pn;
        float s[8]; f32x2 p[8];
        EPI_AM p[am] = ldg<f32x2>(ssqcq, ROWG(am) * 8u);
        EPI_SB();
        EPI_AM { const float rs = rsq((p[am][0] + p[am][1]) * (1.0f / 512.0f) + EPS);
            EPI_BJ { ACC(bj, 0) *= rs; ACC(bj, 1) *= rs; }
            s[am] = (sumsq4(ACC(0, 0)) + sumsq4(ACC(0, 1))) + (sumsq4(ACC(1, 0)) + sumsq4(ACC(1, 1))); }
        xwave_rowsum<1>(s, scr, wr, wc, fr);
        const unsigned gi = 4 * (wc & 1) + fq;
        float rq[8];
        EPI_AM rq[am] = rsq(s[am] * (1.0f / 192.0f) + EPS);
        {
            const f32x4 g0 = ldg<f32x4>(gq, c8 * 4u), g1 = ldg<f32x4>(gq, c8 * 4u + 16u);
            EPI_AM { const unsigned row = ROWG(am), b = row >> 11, sp = row & 2047u;
                stg<u32x4>(mq, ((b * 8u + head) * SEQ + sp) * 384u + c8 * 2u, pack8(ACC(0, 0) * rq[am] * g0, ACC(0, 1) * rq[am] * g1)); }
        }
        EPI_SB();
        if (wc < 2) {
            const f32x4 gr1 = ldg<f32x4>(gq, (128 + 4 * gi) * 4u), gr2 = ldg<f32x4>(gq, (160 + 4 * gi) * 4u);
#pragma unroll
            for (int hm2 = 0; hm2 < 4; ++hm2) {
                f32x4 cs[2], sn[2];
#pragma unroll
                for (int m = 0; m < 2; ++m) { const int am = hm2 * 2 + m; const unsigned sp = ROWG(am) & 2047u; cs[m] = ldg<f32x4>(cosT, (sp * 32u + 4 * gi) * 4u); sn[m] = ldg<f32x4>(sinT, (sp * 32u + 4 * gi) * 4u); }
                EPI_SB();
#pragma unroll
                for (int m = 0; m < 2; ++m) { const int am = hm2 * 2 + m; const unsigned row = ROWG(am), b = row >> 11, sp = row & 2047u;
                    const f32x4 x1 = ACC(1, 0) * rq[am] * gr1, x2 = ACC(1, 1) * rq[am] * gr2;
                    stg<u32x4>(mq, ((b * 8u + head) * SEQ + sp) * 384u + (128 + 8 * gi) * 2u, pack8(x1 * cs[m] - x2 * sn[m], x1 * sn[m] + x2 * cs[m])); }
            }
        }
    }
};

struct EpiKvUp {
    static constexpr bool PERM = true, AFTER_DRAIN = false;
    const float* ssqckv; const float* ssqkr; const float* kr; const float* gk; const float* cosT; const float* sinT; bf16* mk; bf16* mv; LAS float* scr;
    __device__ __forceinline__ void init(Acc& acc, const Unit&, int, int, int, int) const { acc_zero(acc); }
    __device__ __forceinline__ void operator()(Acc& acc, const Unit& u, int wr, int wc, int fr, int fq) const {
        EPI_HEAD(c8);
        const unsigned head = u.pn;
        float s[8], p[8], pk[8];
        EPI_AM { p[am] = ldg<float>(ssqckv, ROWG(am) * 4u); pk[am] = ldg<float>(ssqkr, ROWG(am) * 4u); }
        EPI_SB();
        EPI_AM { const float rs = rsq(p[am] * (1.0f / 256.0f) + EPS);
            EPI_BJ { ACC(bj, 0) *= rs; ACC(bj, 1) *= rs; }
            s[am] = sumsq4(ACC(0, 0)) + sumsq4(ACC(0, 1)); }
        xwave_rowsum<1>(s, scr, wr, wc, fr);
        const f32x4 g0 = ldg<f32x4>(gk, c8 * 4u), g1 = ldg<f32x4>(gk, c8 * 4u + 16u);
        const unsigned qi = 4 * wc + fq, i0 = 2 * qi;
        const f32x2 gr1 = ldg<f32x2>(gk, (128 + i0) * 4u), gr2 = ldg<f32x2>(gk, (160 + i0) * 4u);
        const unsigned slot = 128 + 8 * (qi >> 1) + 2 * (qi & 1);
#pragma unroll
        for (int ai = 0; ai < 2; ++ai) {
            f32x2 xa[4], xb_[4], cs[4], sn[4];
#pragma unroll
            for (int m = 0; m < 4; ++m) { const unsigned row = (unsigned)(row0 + ai * 128 + m * 16), sp = row & 2047u;
                xa[m] = ldg<f32x2>(kr, row * 256u + i0 * 4u); xb_[m] = ldg<f32x2>(kr, row * 256u + (32 + i0) * 4u);
                cs[m] = ldg<f32x2>(cosT, (sp * 32u + i0) * 4u); sn[m] = ldg<f32x2>(sinT, (sp * 32u + i0) * 4u); }
            EPI_SB();
#pragma unroll
            for (int m = 0; m < 4; ++m) { const int am = ai * 4 + m; const unsigned row = ROWG(am), b = row >> 11, sp = row & 2047u; const float rk = rsq((s[am] + pk[am]) * (1.0f / 192.0f) + EPS);
                const unsigned tok = (b * 8u + head) * SEQ + sp, dk = tok * 384u;
                stg<u32x4>(mk, dk + c8 * 2u, pack8(ACC(0, 0) * rk * g0, ACC(0, 1) * rk * g1));
                stg<u32x4>(mv, tok * 256u + c8 * 2u, pack8(ACC(1, 0), ACC(1, 1)));
                const f32x2 x1 = xa[m] * rk * gr1, x2 = xb_[m] * rk * gr2;
                const f32x2 o1 = x1 * cs[m] - x2 * sn[m], o2 = x1 * sn[m] + x2 * cs[m];
                stg<unsigned>(mk, dk + slot * 2u, cvt_pk_bf16(o1[0], o1[1])); stg<unsigned>(mk, dk + (slot + 4) * 2u, cvt_pk_bf16(o2[0], o2[1])); }
        }
    }
};

struct EpiBr {
    static constexpr bool PERM = true, AFTER_DRAIN = false;
    const bf16* gates; bf16* merged;
    __device__ __forceinline__ void init(Acc& acc, const Unit&, int, int, int, int) const { acc_zero(acc); }
    __device__ __forceinline__ void operator()(Acc& acc, const Unit& u, int wr, int wc, int fr, int fq) const {
        EPI_HEAD(c8);
        const unsigned z = u.z;
#pragma unroll
        for (int ai = 0; ai < 2; ++ai) {
            u32x4 gv[4][2], mv_[4][2];
#pragma unroll
            for (int m = 0; m < 4; ++m) { const unsigned row = (unsigned)(row0 + ai * 128 + m * 16);
                EPI_BJ { const unsigned col = u.pn * 256 + bj * 128 + c8; gv[m][bj] = ldg<u32x4>(gates, row * 12288u + (z * 2048u + col) * 2u);
                    mv_[m][bj] = (u32x4){0u, 0u, 0u, 0u}; if (z > 0) mv_[m][bj] = ldg<u32x4>(merged, row * 4096u + col * 2u); } }
            EPI_SB();
#pragma unroll
            for (int m = 0; m < 4; ++m) { const int am = ai * 4 + m; const unsigned row = ROWG(am);
                EPI_BJ { const unsigned col = u.pn * 256 + bj * 128 + c8;
                    f32x4 ga, gb, pa, pb; unpack8(gv[m][bj], ga, gb); unpack8(mv_[m][bj], pa, pb);
                    stg<u32x4>(merged, row * 4096u + col * 2u, pack8(ACC(bj, 0) * ga + pa, ACC(bj, 1) * gb + pb)); } }
        }
    }
};

template <bool FINAL> struct EpiResid {
    static constexpr bool PERM = true, AFTER_DRAIN = false;
    bf16* xb; float* ssqx; float* out; LAS float* scr;
    __device__ __forceinline__ void init(Acc& acc, const Unit& u, int wr, int wc, int fr, int fq) const {
        EPI_HEAD(c8);
        EPI_AM { const unsigned row = ROWG(am);
            EPI_BJ { unpack8(ldg<u32x4>(xb, (row * 2048u + u.pn * 256 + bj * 128 + c8) * 2u), ACC(bj, 0), ACC(bj, 1)); } }
    }
    __device__ __forceinline__ void operator()(Acc& acc, const Unit& u, int wr, int wc, int fr, int fq) const {
        EPI_HEAD(c8);
        float s[8];
        EPI_AM { const unsigned row = ROWG(am); float q = 0.f;
            EPI_BJ { const unsigned e = row * 2048u + u.pn * 256 + bj * 128 + c8;
                stg<u32x4>(xb, e * 2u, pack8(ACC(bj, 0), ACC(bj, 1))); q += sumsq4(ACC(bj, 0)) + sumsq4(ACC(bj, 1));
                if constexpr (FINAL) { stg<f32x4>(out, e * 4u, ACC(bj, 0)); stg<f32x4>(out, e * 4u + 16u, ACC(bj, 1)); } }
            s[am] = q; }
        xwave_rowsum<1>(s, scr, wr, wc, fr);
        if (wc == 0) { EPI_AM { stg<float>(ssqx, ROWG(am) * 32u + u.pn * 4u, s[am]); } }
    }
};

struct EpiHeadNorm {
    static constexpr bool PERM = true, AFTER_DRAIN = false;
    const float* ssq8;
    const float* rstd1;
    const float* gg; bf16* dk; bf16* dv; int nk_tiles, rows_per_b, lg_rows_per_b; LAS float* scr;
    __device__ __forceinline__ void init(Acc& acc, const Unit&, int, int, int, int) const { acc_zero(acc); }
    __device__ __forceinline__ void operator()(Acc& acc, const Unit& u, int wr, int wc, int fr, int fq) const {
        EPI_HEAD(c8);
        const int pn = u.pn;
        float rs[8];
        if (ssq8) rstd_rows8(ssq8, row0, fq, rs); else { EPI_AM rs[am] = ldg<float>(rstd1, ROWG(am) * 4u); EPI_SB(); }
        EPI_AM { EPI_BJ { ACC(bj, 0) *= rs[am]; ACC(bj, 1) *= rs[am]; } }
        const bool isk = pn < nk_tiles;
        float s[16];
        EPI_AM { EPI_BJ { s[am * 2 + bj] = sumsq4(ACC(bj, 0)) + sumsq4(ACC(bj, 1)); } }
        xwave_rowsum<2>(s, scr, wr, wc, fr);
        const f32x4 g0 = isk ? ldg<f32x4>(gg, c8 * 4u) : (f32x4){1.f, 1.f, 1.f, 1.f}, g1 = isk ? ldg<f32x4>(gg, c8 * 4u + 16u) : (f32x4){1.f, 1.f, 1.f, 1.f};
        bf16* dst = isk ? dk : dv; const unsigned hp = isk ? pn : pn - nk_tiles;
        EPI_AM { const unsigned row = ROWG(am), b = row >> lg_rows_per_b, sp = row & (unsigned)(rows_per_b - 1);
            EPI_BJ { const float rh = isk ? rsq(s[am * 2 + bj] * (1.0f / 128.0f) + EPS) : 1.0f; const unsigned head = hp * 2 + bj;
                stg<u32x4>(dst, (((b * 4u + head) * rows_per_b + sp) * 128u + c8) * 2u, pack8(ACC(bj, 0) * rh * g0, ACC(bj, 1) * rh * g1)); } }
    }
};

struct EpiMlp1 {
    static constexpr bool PERM = true, AFTER_DRAIN = false;
    const float* ssqx; bf16* h;
    __device__ __forceinline__ void init(Acc& acc, const Unit&, int, int, int, int) const { acc_zero(acc); }
    __device__ __forceinline__ void operator()(Acc& acc, const Unit& u, int wr, int wc, int fr, int fq) const {
        EPI_HEAD(c8);
        float rs[8]; rstd_rows8(ssqx, row0, fq, rs);
        EPI_AM { const unsigned row = ROWG(am);
            EPI_BJ { f32x4 a = ACC(bj, 0) * rs[am], b = ACC(bj, 1) * rs[am];
#pragma unroll
                for (int e = 0; e < 4; ++e) { a[e] = fmaxf(a[e], 0.f); a[e] *= a[e]; b[e] = fmaxf(b[e], 0.f); b[e] *= b[e]; }
                stg<u32x4>(h, row * 16384u + (u.pn * 256 + bj * 128 + c8) * 2u, pack8(a, b)); } }
    }
};

namespace att {
typedef short bf16x8 __attribute__((ext_vector_type(8)));
typedef short s16x4 __attribute__((ext_vector_type(4)));
typedef float f32x16 __attribute__((ext_vector_type(16)));
constexpr int NW = 8, QBLK = 32, KVBLK = 64, QB = NW * QBLK, DV = 128;
constexpr int SHM_V = KVBLK * DV * 2;
constexpr float SQRT_D = 11.313708498984761f;
template <int MODE> struct Cfg { static constexpr int DK = MODE == 0 ? 192 : 128, SHM_K = KVBLK * DK * 2, NQF = DK / 16;
    static constexpr int OFF_K = 2 * SHM_V, OFF_WS = OFF_K + 2 * SHM_K, OFF_CK = OFF_WS + NW * 64 * 4, OFF_EXT = OFF_CK + 2 * 64 * 4, LDS_BYTES = OFF_EXT + 256 * 4;
    static constexpr bool SK = MODE != 3; };
static_assert(Cfg<0>::LDS_BYTES <= RING_BYTES, "attention LDS");
#define SBAR() __builtin_amdgcn_sched_barrier(0)
template <int DK> __device__ __forceinline__ int kswz(int row, int colB) { return row * (DK * 2) + (colB ^ ((row & 7) << 4)); }
__device__ __forceinline__ int v_st(int k, int c) { const int kk = (k & ~0xC) | ((k & 4) << 1) | ((k & 8) >> 1); return ((kk >> 3) * 4 + (c >> 5)) * 512 + ((kk & 7) * 32 + (c & 31)) * 2; }
__device__ __forceinline__ int v_rd_base(int lane) { return ((lane & 3) << 3) | (((lane >> 2) & 3) << 6) | (((lane >> 4) & 1) << 5) | (((lane >> 5) & 1) << 8); }
constexpr int v_rd_off(int d0, int ks, int half) { return d0 * 512 + ks * 4096 + half * 2048; }
__device__ __forceinline__ int crow(int r, int hi) { return (r & 3) + 8 * (r >> 2) + 4 * hi; }
__device__ __forceinline__ unsigned cvtpk(float lo, float hi) { unsigned r; asm volatile("v_cvt_pk_bf16_f32 %0, %1, %2" : "=v"(r) : "v"(lo), "v"(hi)); return r; }
__device__ __forceinline__ bf16x8 load8(const bf16* p) { return *reinterpret_cast<const bf16x8*>(p); }
__device__ __forceinline__ void mask_tile(f32x16& p0, f32x16& p1, int dq) {
    const float NEG = -__builtin_inff();
#pragma unroll
    for (int r = 0; r < 16; ++r) { const int c = (r & 3) + 8 * (r >> 2); if (dq - c < 0) p0[r] = NEG; if (dq - c - 32 < 0) p1[r] = NEG; }
}
template <int MODE> __device__ __forceinline__ void partialSM(f32x16& p0, f32x16& p1, float& m_reg, float& mn, float& alpha) {
    constexpr float SCALE = MODE == 0 ? 0.07216878364870322f : 0.08838834764831845f, THR = 8.f;
    float pmax = p0[0]; for (int r = 1; r < 16; ++r) pmax = fmaxf(pmax, p0[r]); for (int r = 0; r < 16; ++r) pmax = fmaxf(pmax, p1[r]);
    { auto rr = __builtin_amdgcn_permlane32_swap(__float_as_uint(pmax), __float_as_uint(pmax), false, false);
      pmax = fmaxf(__uint_as_float(rr[0]), __uint_as_float(rr[1])); }
    constexpr float C2 = 1.4426950408889634f * SCALE;
    if (__builtin_expect(__all((pmax - m_reg) * SCALE <= THR), 1)) { mn = m_reg; alpha = 1.f; }
    else { mn = fmaxf(m_reg, pmax); alpha = __builtin_amdgcn_exp2f((m_reg - mn) * C2); m_reg = mn; }
    const float mnL = -mn * C2;
    for (int r = 0; r < 16; ++r) p0[r] = fmaf(p0[r], C2, mnL); for (int r = 0; r < 16; ++r) p1[r] = fmaf(p1[r], C2, mnL);
    for (int r = 0; r < 16; ++r) p0[r] = __builtin_amdgcn_exp2f(p0[r]);
}
__device__ __forceinline__ void finishSM(f32x16& p0, f32x16& p1, float alpha, float& l_reg, bf16x8& pa0, bf16x8& pa1, bf16x8& pa2, bf16x8& pa3) {
    for (int r = 0; r < 16; ++r) p1[r] = __builtin_amdgcn_exp2f(p1[r]);
    float ps = 0; for (int r = 0; r < 16; ++r) ps += p0[r]; for (int r = 0; r < 16; ++r) ps += p1[r];
    { auto rr = __builtin_amdgcn_permlane32_swap(__float_as_uint(ps), __float_as_uint(ps), false, false);
      ps = __uint_as_float(rr[0]) + __uint_as_float(rr[1]); }
    l_reg = l_reg * alpha + ps;
#define PK4(P, B_, OUT) do { unsigned a0 = cvtpk(P[B_+0], P[B_+1]), a1 = cvtpk(P[B_+2], P[B_+3]);                          \
        unsigned b0 = cvtpk(P[B_+4], P[B_+5]), b1 = cvtpk(P[B_+6], P[B_+7]);                                             \
        auto r0 = __builtin_amdgcn_permlane32_swap(a0, b0, false, false); auto r1 = __builtin_amdgcn_permlane32_swap(a1, b1, false, false); \
        u32x4 w = {r0[0], r1[0], r0[1], r1[1]}; OUT = *reinterpret_cast<bf16x8*>(&w); } while (0)
    PK4(p0, 0, pa0); PK4(p0, 8, pa1); PK4(p1, 0, pa2); PK4(p1, 8, pa3);
#undef PK4
}
template <int MODE, int KB>
__device__ __forceinline__ void qkt(f32x16& p0, f32x16& p1, const char* K_lds, int r32, int hi, const bf16x8* qr, bool act) {
    constexpr int DK = Cfg<MODE>::DK, SHM_K = Cfg<MODE>::SHM_K;
    if (Cfg<MODE>::SK && !act) { const float NEG = -__builtin_inff();
#pragma unroll
        for (int r = 0; r < 16; ++r) { p0[r] = NEG; p1[r] = NEG; } return; }
    const char* kb[4];
#pragma unroll
    for (int dd = 0; dd < 4; ++dd) kb[dd] = K_lds + KB * SHM_K + kswz<DK>(r32, (dd * 16 + hi * 8) * 2);
#pragma unroll
    for (int d0 = 0; d0 < DK / 16; ++d0) { const char* a = kb[d0 & 3] + (d0 >> 2) * 128;
        bf16x8 b0 = *reinterpret_cast<const bf16x8*>(a);
        bf16x8 b1 = *reinterpret_cast<const bf16x8*>(a + 32 * DK * 2);
        p0 = __builtin_amdgcn_mfma_f32_32x32x16_bf16(b0, qr[d0], p0, 0, 0, 0);
        p1 = __builtin_amdgcn_mfma_f32_32x32x16_bf16(b1, qr[d0], p1, 0, 0, 0); }
}
template <int VB, bool SK>
__device__ __forceinline__ void pv_tile(f32x16* o, int vb0, bf16x8 pa0, bf16x8 pa1, bf16x8 pa2, bf16x8 pa3, bool act) {
    if (SK && !act) return;
#define TRRD(dst, off) asm volatile("ds_read_b64_tr_b16 %0, %1 offset:%2" : "=&v"(dst) : "v"(vb0), "i"(off) : "memory")
#define PV_D0(d0) do { s16x4 l0, l1, l2, l3, h0, h1, h2, h3; constexpr int b_ = VB * SHM_V + v_rd_off(d0, 0, 0); \
        TRRD(l0, b_); TRRD(h0, b_ + 2048); TRRD(l1, b_ + 4096); TRRD(h1, b_ + 6144); TRRD(l2, b_ + 8192); TRRD(h2, b_ + 10240); TRRD(l3, b_ + 12288); TRRD(h3, b_ + 14336); \
        asm volatile("s_waitcnt lgkmcnt(0)" ::: "memory"); SBAR();   \
        o[d0] = __builtin_amdgcn_mfma_f32_32x32x16_bf16(pa0, (bf16x8){l0[0], l0[1], l0[2], l0[3], h0[0], h0[1], h0[2], h0[3]}, o[d0], 0, 0, 0);   \
        o[d0] = __builtin_amdgcn_mfma_f32_32x32x16_bf16(pa1, (bf16x8){l1[0], l1[1], l1[2], l1[3], h1[0], h1[1], h1[2], h1[3]}, o[d0], 0, 0, 0);   \
        o[d0] = __builtin_amdgcn_mfma_f32_32x32x16_bf16(pa2, (bf16x8){l2[0], l2[1], l2[2], l2[3], h2[0], h2[1], h2[2], h2[3]}, o[d0], 0, 0, 0);   \
        o[d0] = __builtin_amdgcn_mfma_f32_32x32x16_bf16(pa3, (bf16x8){l3[0], l3[1], l3[2], l3[3], h3[0], h3[1], h3[2], h3[3]}, o[d0], 0, 0, 0); } while (0)
    PV_D0(0); PV_D0(1); PV_D0(2); PV_D0(3);
#undef PV_D0
#undef TRRD
}

struct Blk { const bf16* Q; const bf16* K; const bf16* V; bf16* O; int P0, ldo; const float* cum; const float* relb; };
template <int MODE> struct Stage { bf16x8 st_v0, st_v1, st_k0, st_k1, st_k2; float st_c; };
template <int MODE> __device__ __forceinline__ int blk_jlo(int P0) { return MODE == 2 ? (P0 >= 512 ? (P0 - 512) / KVBLK : 0) : 0; }
template <int MODE> __device__ __forceinline__ int blk_jhi(int P0, int skv) { return MODE == 3 ? skv / KVBLK : (P0 + QB - 1) / KVBLK + 1; }
#define VMW() asm volatile("s_waitcnt vmcnt(0)" ::: "memory")
#define KROW(p, k0, rr) ((p) + (size_t)((k0) + (rr)) * DK + sc)
#define VROW(p, k0, rr) ((p) + (size_t)((k0) + (rr)) * DV + sc)
#define SLOAD_H(B_, k0) do { S.st_v0 = load8(VROW((B_).V, k0, sr)); S.st_v1 = load8(VROW((B_).V, k0, 32 + sr));              \
                         S.st_k0 = load8(KROW((B_).K, k0, sr)); S.st_k1 = load8(KROW((B_).K, k0, 32 + sr));              \
                         if constexpr (MODE == 0) S.st_k2 = load8((B_).K + (size_t)((k0) + (tid >> 3)) * DK + 128 + (tid & 7) * 8);   \
                         if constexpr (MODE == 1) { if (tid < 64) S.st_c = (B_).cum[(k0) + tid] * SQRT_D; } } while (0)
#define SWRITE_HK(bf) do { *(bf16x8*)(K_lds + (bf) * SHM_K + kws) = S.st_k0; *(bf16x8*)(K_lds + (bf) * SHM_K + kws + 32 * DK * 2) = S.st_k1; \
                           if constexpr (MODE == 0) *(bf16x8*)(K_lds + (bf) * SHM_K + kws2) = S.st_k2;     \
                           if constexpr (MODE == 1) { if (tid < 64) ck_l[(bf) * 64 + tid] = S.st_c; } } while (0)
#define SWRITE_HV(bf) do { *(bf16x8*)(V_lds + (bf) * SHM_V + vst0) = S.st_v0; *(bf16x8*)(V_lds + (bf) * SHM_V + vst1) = S.st_v1; } while (0)
#define SWRITE_H(bf) do { SWRITE_HV(bf); SWRITE_HK(bf); } while (0)
template <int MODE>
__device__ __forceinline__ void attn_block(const Blk& cur, int skv, char* lds, const int wave_id) {
    constexpr int DK = Cfg<MODE>::DK, SHM_K = Cfg<MODE>::SHM_K, NQF = Cfg<MODE>::NQF; constexpr bool SK = Cfg<MODE>::SK;
    int l_; asm volatile("v_mbcnt_lo_u32_b32 %0, -1, 0\n\tv_mbcnt_hi_u32_b32 %0, -1, %0" : "=v"(l_));
    const int wid = wave_id, tid = wid * 64 + l_, lane = l_, r32 = lane & 31, hi = lane >> 5;
    const int j_lo = blk_jlo<MODE>(cur.P0), j_hi = blk_jhi<MODE>(cur.P0, skv);
    const int NT = j_hi - j_lo;
    const int qlo = cur.P0 + wid * QBLK, qm = qlo + r32 - 4 * hi;
    const int cq = qlo >> 6;
    char* V_lds = lds; char* K_lds = lds + Cfg<MODE>::OFF_K;
    float* ws = (float*)(lds + Cfg<MODE>::OFF_WS) + wid * 64; float* li_l = ws, * al_l = ws + 32;
    float* ck_l = (float*)(lds + Cfg<MODE>::OFF_CK); const float* ext_l = (const float*)(lds + Cfg<MODE>::OFF_EXT); (void)ck_l; (void)ext_l; (void)qm; (void)cq;
    float m_reg = -1e30f, l_reg = 0; f32x16 o[4] = {};
    const int sr = tid >> 4, sc = (tid & 15) * 8, vst0 = v_st(sr, sc), vst1 = v_st(32 + sr, sc), kws = kswz<DK>(sr, sc * 2), kws2 = kswz<DK>(tid >> 3, (128 + (tid & 7) * 8) * 2); (void)kws2;
    const int vb0 = (int)(uintptr_t)V_lds + v_rd_base(lane);
    float cqs = 0.f; if constexpr (MODE == 1) cqs = cur.cum[qlo + r32] * SQRT_D;
    const int extb = (qlo & 63) + r32 - 4 * hi + 4; (void)extb; (void)cqs;
    Stage<MODE> S; bf16x8 qr[NQF];
#define RESC(a) do { if (__any((a) < 1.f)) { if (hi == 0) al_l[r32] = (a); asm volatile("s_waitcnt lgkmcnt(0)" ::: "memory");              \
                     for (int d_ = 0; d_ < 4; ++d_) for (int r = 0; r < 16; ++r) o[d_][r] *= al_l[crow(r, hi)]; } } while (0)
#define KBASE(t) ((j_lo + (t)) * KVBLK)
#define ACT(t) (MODE == 0 ? (j_lo + (t)) <= cq : MODE == 1 ? KBASE(t) <= qlo + QBLK - 1 : MODE == 2 ? ((j_lo + (t)) <= cq && (j_lo + (t)) + 8 >= cq) : true)
#define MASKT(P0_, P1_, t) do { if constexpr (MODE == 1) { const int kb_ = KBASE(t); if (ACT(t) && kb_ + KVBLK - 1 > qlo) mask_tile(P0_, P1_, qm - kb_); } } while (0)
#define INITP(PX0, PX1, t, KB) do { if constexpr (MODE == 0 || MODE == 3) { PX0 = f32x16{}; PX1 = f32x16{}; }                                  \
        else if constexpr (MODE == 1) { _Pragma("unroll") for (int g_ = 0; g_ < 4; ++g_) { const f32x4 c0_ = *(const f32x4*)(ck_l + (KB) * 64 + 8 * g_ + 4 * hi), c1_ = *(const f32x4*)(ck_l + (KB) * 64 + 32 + 8 * g_ + 4 * hi); \
              _Pragma("unroll") for (int e_ = 0; e_ < 4; ++e_) { PX0[4 * g_ + e_] = cqs - c0_[e_]; PX1[4 * g_ + e_] = cqs - c1_[e_]; } } }          \
        else { const int d_ = cq - (j_lo + (t)); if (d_ >= 3 || d_ < 0) { const float cf_ = ext_l[191]; _Pragma("unroll") for (int r = 0; r < 16; ++r) { PX0[r] = cf_; PX1[r] = cf_; } }   \
               else { const float* eb_ = ext_l + 64 * d_ + extb; _Pragma("unroll") for (int r = 0; r < 16; ++r) { PX0[r] = eb_[59 - ((r & 3) + 8 * (r >> 2))]; PX1[r] = eb_[27 - ((r & 3) + 8 * (r >> 2))]; } } } } while (0)
#pragma unroll
    for (int d0 = 0; d0 < NQF; ++d0) qr[d0] = load8(cur.Q + (size_t)(wid * QBLK + r32) * DK + d0 * 16 + hi * 8);
    SLOAD_H(cur, KBASE(0));
    if constexpr (MODE == 2) { if (tid < 256) { int rel = tid - 63; rel = rel > 128 ? 128 : rel; ((float*)(lds + Cfg<MODE>::OFF_EXT))[tid] = cur.relb[rel + 128] * SQRT_D; } }
    VMW(); SWRITE_H(0); SBAR();
    if (NT > 1) SLOAD_H(cur, KBASE(1));
    __syncthreads();
#define STEP(t, B_) do { f32x16 p0, p1; float mn, al; bf16x8 pa0, pa1, pa2, pa3;                                                        \
        INITP(p0, p1, t, B_); qkt<MODE, B_>(p0, p1, K_lds, r32, hi, qr, ACT(t));                                              \
        MASKT(p0, p1, t); partialSM<MODE>(p0, p1, m_reg, mn, al); RESC(al); finishSM(p0, p1, al, l_reg, pa0, pa1, pa2, pa3); SBAR();   \
        if ((t) + 1 < NT) { VMW(); SWRITE_H(1 - (B_)); SBAR(); }                                                              \
        pv_tile<B_, SK>(o, vb0, pa0, pa1, pa2, pa3, ACT(t)); SBAR();                                                          \
        if ((t) + 2 < NT) { SLOAD_H(cur, KBASE((t) + 2)); SBAR(); }                                                           \
        __syncthreads(); } while (0)
    for (int t = 0; t < NT; t += 2) { STEP(t, 0); if (t + 1 < NT) STEP(t + 1, 1); }
    if (hi == 0) li_l[r32] = l_reg; asm volatile("s_waitcnt lgkmcnt(0)" ::: "memory");
    float rli[16];
#pragma unroll
    for (int r = 0; r < 16; ++r) rli[r] = __builtin_amdgcn_rcpf(li_l[crow(r, hi)]);
    bf16* Ow = cur.O + (size_t)(wid * QBLK) * cur.ldo;
#pragma unroll
    for (int r = 0; r < 16; ++r) { const int orow = crow(r, hi);
#pragma unroll
        for (int d0 = 0; d0 < 4; ++d0) { const float v = o[d0][r] * rli[r];
            const float vn = __shfl_xor(v, 1);
            if ((r32 & 1) == 0) *(unsigned*)(Ow + (size_t)orow * cur.ldo + d0 * 32 + r32) = cvtpk(v, vn); } }
    __syncthreads();
#undef RESC
#undef KBASE
#undef ACT
#undef MASKT
#undef INITP
#undef STEP
}
#undef KROW
#undef VROW
#undef VMW
#undef SLOAD_H
#undef SWRITE_HK
#undef SWRITE_HV
#undef SWRITE_H
#undef SBAR
}

#define XB_TMO      128
#define XB_XCNT(j)  (256  + 64 * (j))
#define XB_XSUB(j)  (1280 + 64 * (j))
#define XB_XGEN(j)  (2304 + 64 * (j))
#define XB_TOP      3328
#define XB_TOPGEN   3392
#define XCD_BAR_WORDS 3456
#define XB_SPIN_CAP (1u << 18)
__device__ __forceinline__ unsigned xb_ld(unsigned* p)              { return __hip_atomic_load(p, __ATOMIC_RELAXED, __HIP_MEMORY_SCOPE_AGENT); }
__device__ __forceinline__ unsigned xb_add(unsigned* p, unsigned v) { return __hip_atomic_fetch_add(p, v, __ATOMIC_RELAXED, __HIP_MEMORY_SCOPE_AGENT); }
__device__ __forceinline__ unsigned xb_xcc_id() { return (unsigned)__builtin_amdgcn_s_getreg((3 << 11) | 20) & 0xFu; }
#define XB_SPIN(cond, bar) do { unsigned _sp = 0; while (cond) { __builtin_amdgcn_s_sleep(1); \
    if ((++_sp & 255u) == 0u) { if (xb_ld(&(bar)[XB_TMO])) break; if (_sp > XB_SPIN_CAP) { atomicAdd(&(bar)[XB_TMO], 1u); break; } } } } while (0)
struct XcdBarrier { unsigned* bar; unsigned x; volatile LAS unsigned* st; };
__device__ __forceinline__ XcdBarrier xcd_barrier_post(unsigned* bar, volatile LAS unsigned* st) {
    XcdBarrier b; b.bar = bar; b.x = xb_xcc_id(); b.st = st;
    if (threadIdx.x == 0) (void)xb_add(&bar[XB_XCNT(b.x)], 1u);
    return b;
}
__device__ __forceinline__ void xcd_barrier_complete(unsigned* bar, unsigned x, unsigned& nloc, unsigned& nx) {
    const unsigned G = gridDim.x * gridDim.y * gridDim.z;
    unsigned sum, cnt, mine, sp = 0u;
    for (;;) {
        sum = 0u; cnt = 0u; mine = 0u;
#pragma unroll
        for (unsigned j = 0; j < 16; ++j) { const unsigned c = xb_ld(&bar[XB_XCNT(j)]); sum += c; cnt += (c > 0u) ? 1u : 0u; mine = (j == x) ? c : mine; }
        if (sum == G) break;
        __builtin_amdgcn_s_sleep(1);
        if ((++sp & 255u) == 0u) { if (xb_ld(&bar[XB_TMO])) break; if (sp > XB_SPIN_CAP) { atomicAdd(&bar[XB_TMO], 1u); break; } }
    }
    nloc = mine > 0u ? mine : 1u; nx = cnt > 0u ? cnt : 1u;
}
__device__ __forceinline__ void xcd_barrier(const XcdBarrier& b) {
    asm volatile("s_waitcnt vmcnt(0)" ::: "memory");
    __syncthreads();
    if (threadIdx.x == 0) {
        unsigned* bar = b.bar; asm volatile("" : "+s"(bar));
        __builtin_amdgcn_s_waitcnt(0);
        unsigned nloc = b.st[0], nx = b.st[1];
        if (nloc == 0u) { xcd_barrier_complete(bar, b.x, nloc, nx); b.st[0] = nloc; b.st[1] = nx; }
        const unsigned old = xb_add(&bar[XB_XSUB(b.x)], 1u);
        const unsigned gen = old / nloc;
        if (old + 1u == (gen + 1u) * nloc) {
            __builtin_amdgcn_fence(__ATOMIC_RELEASE, "agent");
            asm volatile("s_waitcnt vmcnt(0)" ::: "memory");
            const unsigned og = xb_add(&bar[XB_TOP], 1u);
            const unsigned tg = og / nx;
            if (og + 1u == (tg + 1u) * nx) xb_add(&bar[XB_TOPGEN], 1u);
            else XB_SPIN(xb_ld(&bar[XB_TOPGEN]) == tg, bar);
            __builtin_amdgcn_fence(__ATOMIC_ACQUIRE, "agent");
            xb_add(&bar[XB_XGEN(b.x)], 1u);
            asm volatile("s_waitcnt vmcnt(0)" ::: "memory");
        } else {
            XB_SPIN(xb_ld(&bar[XB_XGEN(b.x)]) == gen, bar);
            __builtin_amdgcn_fence(__ATOMIC_ACQUIRE, "agent");
            asm volatile("s_waitcnt vmcnt(0)" ::: "memory");
        }
    }
    __syncthreads();
}

constexpr int NWAVES = 8;
__device__ __forceinline__ float wave_sum(float v) {
#pragma unroll
    for (int o = 1; o < 64; o <<= 1) v += __shfl_xor(v, o);
    return v;
}
__device__ __forceinline__ int colmap_inproj(int n) { if (n < 832) return n; if (n < 840) return 3904 + (n - 832); if (n < 1024) return -1; if (n < 4096) return n - 192; return n - 184; }
__device__ __forceinline__ int colmap_uq(int n) { const int h = n >> 8, j = n & 255; if (j < 128) return h * 192 + j; if (j >= 192) return -1;
    const int p = j - 128, g = p >> 3, w = p & 7; return h * 192 + 128 + (w < 4 ? 4 * g + w : 32 + 4 * g + (w - 4)); }
template <int MAP> __device__ __forceinline__ void transpose_item(const float* W, int K, int Nsrc, const float* gk, bf16* WT, int nblk, LAS float* scr, int item, int lane) {
    const int kb = item / nblk, nb = item % nblk, k0 = 64 * kb, n0 = 64 * nb;
    const int krow = lane >> 4, nq = lane & 15, nd = n0 + 4 * nq; const int ns = MAP == 0 ? nd : MAP == 1 ? colmap_inproj(nd) : colmap_uq(nd);
    f32x4 v[16];
#pragma unroll
    for (int i = 0; i < 16; ++i) { v[i] = (f32x4){0.f, 0.f, 0.f, 0.f}; if (ns >= 0) v[i] = *(const f32x4*)(W + (size_t)(k0 + 4 * i + krow) * Nsrc + ns); }
#pragma unroll
    for (int i = 0; i < 16; ++i) { const int kk = 4 * i + krow; f32x4 t = v[i]; if (gk) t = t * gk[k0 + kk];
        LAS float* p = scr + kk * 65 + 4 * nq; p[0] = t[0]; p[1] = t[1]; p[2] = t[2]; p[3] = t[3]; }
    LDS_WAIT(); asm volatile("" ::: "memory");
    const int c = lane & 7;
#pragma unroll
    for (int j = 0; j < 8; ++j) { const int n = (lane >> 3) + 8 * j; const LAS float* s = scr + (8 * c) * 65 + n;
        u32x4 o; o.x = cvt_pk_bf16(s[0 * 65], s[1 * 65]); o.y = cvt_pk_bf16(s[2 * 65], s[3 * 65]); o.z = cvt_pk_bf16(s[4 * 65], s[5 * 65]); o.w = cvt_pk_bf16(s[6 * 65], s[7 * 65]);
        *(u32x4*)(WT + (size_t)(n0 + n) * K + k0 + 8 * c) = o; }
    LDS_WAIT(); asm volatile("" ::: "memory");
}
__device__ __forceinline__ float row_to_bf16(const float* xrow, bf16* orow, int lane) {
    f32x4 v[8]; float s = 0.f;
#pragma unroll
    for (int j = 0; j < 8; ++j) { v[j] = ((const f32x4*)xrow)[lane + 64 * j]; s += sumsq4(v[j]); }
#pragma unroll
    for (int j = 0; j < 8; ++j) { u32x2 w; w.x = cvt_pk_bf16(v[j][0], v[j][1]); w.y = cvt_pk_bf16(v[j][2], v[j][3]); ((u32x2*)orow)[lane + 64 * j] = w; }
    return wave_sum(s);
}

struct Args { const float* in[N_IN]; float* out; unsigned char* ws; int g_lo, g_hi; };
constexpr size_t in_stride(int k) {
    return k == IG_MIX ? 2048 : k == IW_IN ? (size_t)2048 * DIN_SRC : k == IG_CQ ? 512 : k == IW_UQ ? (size_t)512 * 1536 : k == IG_CKV ? 256 : k == IW_UKV ? (size_t)256 * 2048 :
           k == IG_MLAQ ? 192 : k == IG_MLAK ? 192 : k == IB_F ? 8 : k == IG_FOXQ ? 128 : k == IG_FOXK ? 128 : k == IRELB ? 8 * 257 : k == IG_CHQ ? 128 : k == IG_CHK ? 128 :
           k == IW_BR ? (size_t)3 * 1024 * 2048 : k == IW_OUT ? (size_t)2048 * 2048 : k == IG_CROSS ? 2048 : k == IG_MEM ? 2048 : k == IW_XQ ? (size_t)2048 * 512 :
           k == IW_XKV ? (size_t)2048 * 1024 : k == IG_XQ ? 128 : k == IG_XK ? 128 : k == IW_XO ? (size_t)512 * 2048 : k == IG_MLP ? 2048 : k == IW_1 ? (size_t)2048 * 8192 :
           k == IW_2 ? (size_t)8192 * 2048 : 0;
}
#define LIN(k, l) (args.in[k] + (size_t)(l) * in_stride(k))
#define CAS __attribute__((address_space(4)))
__device__ __forceinline__ Args load_args(size_t zoff) {
    const CAS Args* p = (const CAS Args*)((const CAS char*)__builtin_amdgcn_kernarg_segment_ptr() + zoff);
    Args a;
#pragma unroll
    for (int k = 0; k < N_IN; ++k) a.in[k] = (const float*)(const GAS float*)p->in[k];
    a.out = (float*)(GAS float*)p->out; a.ws = (unsigned char*)(GAS unsigned char*)p->ws; a.g_lo = p->g_lo; a.g_hi = p->g_hi;
    return a;
}

constexpr int I_IN = (2048 / 64) * (NIN / 64), I_UQ = (512 / 64) * (2048 / 64), I_UKV = (256 / 64) * (2048 / 64), I_BR1 = (1024 / 64) * (2048 / 64), I_OUT = (2048 / 64) * (2048 / 64),
              I_XQ = (2048 / 64) * (512 / 64), I_XKV = (2048 / 64) * (1024 / 64), I_XO = (512 / 64) * (2048 / 64), I_1 = (2048 / 64) * (8192 / 64), I_2 = (8192 / 64) * (2048 / 64);
constexpr int I_LAYER = I_IN + I_UQ + I_UKV + 3 * I_BR1 + I_OUT + I_XQ + I_XKV + I_XO + I_1 + I_2;
constexpr int I_SPLIT = (I_LAYER * 9 / 20) & ~7;
__device__ __forceinline__ void convert_item(const Args& args, unsigned char* ws, int l, int r, LAS float* scr, int lane) {
    unsigned char* wl = ws + WS_W + (size_t)l * W_LAYER;
    if (r < I_IN) { transpose_item<1>(LIN(IW_IN, l), 2048, DIN_SRC, LIN(IG_MIX, l), (bf16*)(wl + WO_IN), NIN / 64, scr, r, lane); return; } r -= I_IN;
    if (r < I_UQ) { transpose_item<2>(LIN(IW_UQ, l), 512, 1536, LIN(IG_CQ, l), (bf16*)(wl + WO_UQ), 2048 / 64, scr, r, lane); return; } r -= I_UQ;
    if (r < I_UKV) { transpose_item<0>(LIN(IW_UKV, l), 256, 2048, LIN(IG_CKV, l), (bf16*)(wl + WO_UKV), 2048 / 64, scr, r, lane); return; } r -= I_UKV;
    if (r < 3 * I_BR1) { const int z = r / I_BR1; transpose_item<0>(LIN(IW_BR, l) + (size_t)z * 1024 * 2048, 1024, 2048, nullptr, (bf16*)(wl + WO_BR) + (size_t)z * 2048 * 1024, 2048 / 64, scr, r % I_BR1, lane); return; } r -= 3 * I_BR1;
    if (r < I_OUT) { transpose_item<0>(LIN(IW_OUT, l), 2048, 2048, nullptr, (bf16*)(wl + WO_OUT), 2048 / 64, scr, r, lane); return; } r -= I_OUT;
    if (r < I_XQ) { transpose_item<0>(LIN(IW_XQ, l), 2048, 512, LIN(IG_CROSS, l), (bf16*)(wl + WO_XQ), 512 / 64, scr, r, lane); return; } r -= I_XQ;
    if (r < I_XKV) { transpose_item<0>(LIN(IW_XKV, l), 2048, 1024, LIN(IG_MEM, l), (bf16*)(wl + WO_XKV), 1024 / 64, scr, r, lane); return; } r -= I_XKV;
    if (r < I_XO) { transpose_item<0>(LIN(IW_XO, l), 512, 2048, nullptr, (bf16*)(wl + WO_XO), 2048 / 64, scr, r, lane); return; } r -= I_XO;
    if (r < I_1) { transpose_item<0>(LIN(IW_1, l), 2048, 8192, LIN(IG_MLP, l), (bf16*)(wl + WO_1), 8192 / 64, scr, r, lane); return; } r -= I_1;
    transpose_item<0>(LIN(IW_2, l), 8192, 2048, nullptr, (bf16*)(wl + WO_2), 2048 / 64, scr, r, lane);
}
__device__ __forceinline__ void convert_range(const Args& args, unsigned char* ws, int l, int lo, int hi, int widx, int nw, LAS unsigned char* lds, int lane, int wave) {
    LAS float* scr = (LAS float*)(lds + wave * 16640);
    for (int it = lo + widx; it < hi; it += nw) convert_item(args, ws, l, it, scr, lane);
}

__device__ __forceinline__ void prologue(const Args& args, LAS unsigned char* lds, int lane, int wave) {
    unsigned char* ws = args.ws;
    const int gw = blockIdx.x * NWAVES + wave, NGW = gridDim.x * NWAVES;
    for (int l = 0; l < NL; ++l) convert_range(args, ws, l, 0, I_LAYER, gw, NGW, lds, lane, wave);
    for (int m = gw; m < T; m += NGW) { const float s = row_to_bf16(args.in[IX] + (size_t)m * DM, (bf16*)(ws + WS_XB) + (size_t)m * DM, lane);
        if (lane < 8) ((float*)(ws + WS_SSQX))[(size_t)m * 8 + lane] = lane == 0 ? s : 0.f; }
    for (int m = gw; m < NBATCH * 256; m += NGW) { const float s = row_to_bf16(args.in[IMEM] + (size_t)m * DM, (bf16*)(ws + WS_MEMB) + (size_t)m * DM, lane);
        if (lane == 0) ((float*)(ws + WS_RSTDMEM))[m] = rsq(s * (1.0f / DM) + EPS); }
    for (int e = gw * 64 + lane; e < NL * 768; e += NGW * 64) { const int l = e / 768, k = (e % 768) >> 7, c = e & 127;
        ((float*)(ws + WS_GT))[e] = k == 0 ? LIN(IG_FOXQ, l)[c] : k == 1 ? LIN(IG_FOXK, l)[c] : k == 3 ? LIN(IG_CHQ, l)[c] : k == 4 ? LIN(IG_CHK, l)[c] : 1.0f; }
    for (int e = gw * 64 + lane; e < SEQ * 32; e += NGW * 64) { const int pos = e >> 5, i = e & 31;
        const float inv = exp2f(-(float)i * (13.287712379549449f / 32.0f)); const float ang = (float)pos * inv;
        ((float*)(ws + WS_COS))[e] = cosf(ang); ((float*)(ws + WS_SIN))[e] = sinf(ang); }
}

__device__ __forceinline__ void cumsum_phase(const float* logf, float* cum, int lane, int wave) {
    const int gw = blockIdx.x * NWAVES + wave;
    if (gw >= NBATCH * 8) return;
    const int b = gw >> 3, h = gw & 7;
    float v[32]; float run = 0.f;
#pragma unroll
    for (int j = 0; j < 32; ++j) { run += logf[((size_t)b * SEQ + lane * 32 + j) * 8 + h]; v[j] = run; }
    float incl = run;
#pragma unroll
    for (int o = 1; o < 64; o <<= 1) { const float t = __shfl_up(incl, o); if (lane >= o) incl += t; }
    const float excl = incl - run;
#pragma unroll
    for (int j = 0; j < 32; ++j) cum[((size_t)b * 8 + h) * SEQ + lane * 32 + j] = v[j] + excl;
}

struct AttnS { const bf16* Q; const bf16* K; const bf16* V; bf16* O; int mode, DK, NH, SK, ldo; const float* cum; const float* relb; };
__device__ __forceinline__ void attn_simple_unit(const AttnS& A, int b, int h, int qt, LAS unsigned char* lds, int tid) {
    const int DK = A.DK, DKP = DK + 1, KP = DK + 2;
    LAS float* qs = (LAS float*)lds;
    LAS bf16* Ks = (LAS bf16*)(lds + 64 * 193 * 4);
    LAS bf16* Vs = (LAS bf16*)(lds + 64 * 193 * 4 + 64 * 194 * 2);
    LAS float* Ps = (LAS float*)(lds + 64 * 193 * 4 + 64 * 194 * 2 + 64 * 130 * 2);
    const int r = tid >> 3, sub = tid & 7;
    const float scale = rsqrtf((float)DK);
    const size_t qbase = ((size_t)(b * A.NH + h) * SEQ + qt * 64) * DK, kvbase = (size_t)(b * A.NH + h) * A.SK;
    __syncthreads();
    for (int e = tid; e < 64 * DK; e += 512) { const int rr = e / DK, d = e % DK; qs[rr * DKP + d] = bf2f(A.Q[qbase + e]) * scale; }
    const int qpos = qt * 64 + r;
    float m_run = -3.0e38f, l_run = 0.f; float o[16];
#pragma unroll
    for (int d = 0; d < 16; ++d) o[d] = 0.f;
    int j_lo = 0, j_hi = qt + 1;
    if (A.mode == 2) j_lo = qt > 8 ? qt - 8 : 0;
    if (A.mode == 3) { j_lo = 0; j_hi = A.SK / 64; }
    const float cq = A.mode == 1 ? A.cum[(size_t)(b * 8 + h) * SEQ + qpos] : 0.f;
    for (int j = j_lo; j < j_hi; ++j) {
        __syncthreads();
        for (int e = tid; e < 64 * DK; e += 512) { const int kk = e / DK, d = e % DK; Ks[kk * KP + d] = A.K[(kvbase + j * 64 + kk) * DK + d]; }
        for (int e = tid; e < 64 * 128; e += 512) { const int kk = e >> 7, d = e & 127; Vs[kk * 130 + d] = A.V[(kvbase + j * 64 + kk) * 128 + d]; }
        __syncthreads();
        float sc[8]; float tmax = -3.0e38f;
#pragma unroll
        for (int kk = 0; kk < 8; ++kk) { const int key = sub + 8 * kk; float s = 0.f;
            for (int d = 0; d < DK; d += 2) { const unsigned w = *(const LAS unsigned*)(Ks + key * KP + d); s += qs[r * DKP + d] * bf_lo(w) + qs[r * DKP + d + 1] * bf_hi(w); }
            const int kpos = j * 64 + key; bool ok = true;
            if (A.mode == 1) { ok = kpos <= qpos; s += cq - A.cum[(size_t)(b * 8 + h) * SEQ + kpos]; }
            if (A.mode == 2) { int rel = qpos - kpos; rel = rel < -128 ? -128 : rel > 128 ? 128 : rel; s += A.relb[h * 257 + rel + 128]; }
            s = ok ? s : -1.0e30f; sc[kk] = s; tmax = fmaxf(tmax, s); }
        tmax = fmaxf(tmax, __shfl_xor(tmax, 1)); tmax = fmaxf(tmax, __shfl_xor(tmax, 2)); tmax = fmaxf(tmax, __shfl_xor(tmax, 4));
        const float m_new = fmaxf(m_run, tmax), alpha = __expf(m_run - m_new); float ps = 0.f;
#pragma unroll
        for (int kk = 0; kk < 8; ++kk) { const float p = __expf(sc[kk] - m_new); ps += p; Ps[r * 65 + sub + 8 * kk] = p; }
        ps += __shfl_xor(ps, 1); ps += __shfl_xor(ps, 2); ps += __shfl_xor(ps, 4);
        l_run = l_run * alpha + ps; m_run = m_new;
        __syncthreads();
#pragma unroll
        for (int d = 0; d < 16; ++d) o[d] *= alpha;
        for (int key = 0; key < 64; ++key) { const float p = Ps[r * 65 + key];
#pragma unroll
            for (int d = 0; d < 16; d += 2) { const unsigned w = *(const LAS unsigned*)(Vs + key * 130 + sub * 16 + d); o[d] += p * bf_lo(w); o[d + 1] += p * bf_hi(w); } }
    }
    const float il = 1.0f / l_run;
    bf16* op = A.O + (size_t)(b * SEQ + qt * 64 + r) * A.ldo + h * 128 + sub * 16;
    u32x4 w0, w1; w0.x = cvt_pk_bf16(o[0] * il, o[1] * il); w0.y = cvt_pk_bf16(o[2] * il, o[3] * il); w0.z = cvt_pk_bf16(o[4] * il, o[5] * il); w0.w = cvt_pk_bf16(o[6] * il, o[7] * il);
    w1.x = cvt_pk_bf16(o[8] * il, o[9] * il); w1.y = cvt_pk_bf16(o[10] * il, o[11] * il); w1.z = cvt_pk_bf16(o[12] * il, o[13] * il); w1.w = cvt_pk_bf16(o[14] * il, o[15] * il);
    *(u32x4*)op = w0; *(u32x4*)(op + 8) = w1;
}

constexpr int NPH = 10;
constexpr int NPHASE = 1 + NL * NPH;
__global__ void __launch_bounds__(NWAVES * 64, 2) fwd_kernel(Args args) {
    extern __shared__ __attribute__((aligned(16))) unsigned char lds_raw[];
    LAS unsigned char* lds = (LAS unsigned char*)lds_raw;
    volatile LAS unsigned* MISC = (volatile LAS unsigned*)(lds + MISC_OFF);
    const int tid0 = threadIdx.x, wave = __builtin_amdgcn_readfirstlane(tid0 >> 6);
    const int G = gridDim.x, bx = blockIdx.x, vcu = (G % 8 == 0) ? (bx % 8) * (G / 8) + bx / 8 : bx;
    unsigned char* const ws0 = args.ws;
    unsigned* ctl = (unsigned*)(ws0 + WS_CTL);
    for (int u = tid0; u < 256; u += NWAVES * 64) MISC[u] = 0u;
    __syncthreads();
#if MK_PER_PHASE
#define SEAM(g) do { } while (0)
#else
    XcdBarrier bar = xcd_barrier_post(ctl + 4096, MISC + 8);
#define SEAM(g) do { if ((g) + 1 < g_hi) xcd_barrier(bar); } while (0)
#endif
    const int g_lo = args.g_lo, g_hi = args.g_hi;
#ifndef PH_MASK
#define PH_MASK 0x7ff
#endif
#define IN(g) (g_lo <= (g) && (g) < g_hi)
#ifndef REP_PH
#define REP_PH -1
#endif
#ifndef REP_N
#define REP_N 1
#endif
#define REPS(p) for (int rep_ = 0; rep_ < ((p) == REP_PH ? REP_N : 1); ++rep_)
    LAS float* escr = (LAS float*)(lds + ESCR_OFF);

    if ((PH_MASK & 1) && IN(0)) { REPS(0) { prologue(args, lds, tid0 & 63, wave); if (REP_PH == 0) __syncthreads(); } SEAM(0); }

#define OPAQUE_PTRS() size_t zoff_ = 0; asm volatile("" : "+s"(zoff_)); const Args args = load_args(zoff_); unsigned char* ws = args.ws;     \
    int lane; asm volatile("v_mbcnt_lo_u32_b32 %0, -1, 0\n\tv_mbcnt_hi_u32_b32 %0, -1, %0" : "=v"(lane)); const int tid = wave * 64 + lane; (void)tid; unsigned char* wl = ws + WS_W + (size_t)l * W_LAYER; float* ssqx = (float*)(ws + WS_SSQX); bf16* xb = (bf16*)(ws + WS_XB); \
    const float* cosT = (const float*)(ws + WS_COS); const float* sinT = (const float*)(ws + WS_SIN); (void)wl; (void)ssqx; (void)xb; (void)cosT; (void)sinT
    for (int l = 0; l < NL; ++l) {
        const int gb = 1 + l * NPH;
        if ((PH_MASK & 2) && IN(gb + 0)) REPS(1) {
            OPAQUE_PTRS();
            pg8::Gemm g{xb, (const bf16*)(wl + WO_IN), T, NIN, 2048, 0, 0}; pg8::StaticOrder S; S.init(T, NIN, G, bx);
            EpiInProj E{ssqx, (bf16*)(ws + WS_CQ), (float*)(ws + WS_SSQCQ), (bf16*)(ws + WS_CKV), (float*)(ws + WS_SSQCKV), (float*)(ws + WS_KR), (float*)(ws + WS_SSQKR),
                        (float*)(ws + WS_LOGF), LIN(IB_F, l), (bf16*)(ws + WS_FQ), (const float*)(ws + WS_GT) + l * 768, (bf16*)(ws + WS_GATES), escr};
            pg8::gemm_phase<EpiInProj, pg8::StaticOrder, true, true>(lds, g, S, E, wave);
            SEAM(gb + 0);
        }
        if ((PH_MASK & 4) && IN(gb + 1)) REPS(2) {
            OPAQUE_PTRS();
#ifndef P1MASK
#define P1MASK 7
#endif
            if (P1MASK & 1) { pg8::Gemm g{(const bf16*)(ws + WS_CQ), (const bf16*)(wl + WO_UQ), T, 2048, 512, 0, 0}; pg8::StaticOrder S; S.init(T, 2048, G, bx);
              EpiQUp E{(const float*)(ws + WS_SSQCQ), LIN(IG_MLAQ, l), cosT, sinT, (bf16*)(ws + WS_MQ), escr};
              pg8::gemm_phase<EpiQUp, pg8::StaticOrder, true, true>(lds, g, S, E, wave); }
            if (P1MASK & 2) { pg8::Gemm g{(const bf16*)(ws + WS_CKV), (const bf16*)(wl + WO_UKV), T, 2048, 256, 0, 0}; pg8::StaticOrder S; S.init(T, 2048, G, bx);
              EpiKvUp E{(const float*)(ws + WS_SSQCKV), (const float*)(ws + WS_SSQKR), (const float*)(ws + WS_KR), LIN(IG_MLAK, l), cosT, sinT, (bf16*)(ws + WS_MK), (bf16*)(ws + WS_MV), escr + 2048};
              pg8::gemm_phase<EpiKvUp, pg8::StaticOrder, true, true>(lds, g, S, E, wave); }
            if (P1MASK & 4) cumsum_phase((const float*)(ws + WS_LOGF), (float*)(ws + WS_CUM), lane, wave);
            SEAM(gb + 1);
        }
        if ((PH_MASK & 8) && IN(gb + 2)) REPS(3) {
            OPAQUE_PTRS();
#if ATTN_SIMPLE
            for (int it = bx; it < 3 * NBATCH * 8 * 32; it += G) {
                const int br = it / (NBATCH * 8 * 32), r = it % (NBATCH * 8 * 32), b = r / (8 * 32), h = (r / 32) % 8, qt = 31 - (r % 32);
                AttnS A;
                if (br == 0) A = AttnS{(const bf16*)(ws + WS_MQ), (const bf16*)(ws + WS_MK), (const bf16*)(ws + WS_MV), (bf16*)(ws + WS_Y), 0, 192, 8, SEQ, 1024, nullptr, nullptr};
                else if (br == 1) A = AttnS{(const bf16*)(ws + WS_FQ), (const bf16*)(ws + WS_FK), (const bf16*)(ws + WS_FV), (bf16*)(ws + WS_Y) + (size_t)T * 1024, 1, 128, 8, SEQ, 1024, (const float*)(ws + WS_CUM), nullptr};
                else A = AttnS{(const bf16*)(ws + WS_CHQ), (const bf16*)(ws + WS_CHK), (const bf16*)(ws + WS_CHV), (bf16*)(ws + WS_Y) + (size_t)2 * T * 1024, 2, 128, 8, SEQ, 1024, nullptr, LIN(IRELB, l)};
                attn_simple_unit(A, b, h, qt, lds, tid);
            }
#else
            for (int c = vcu; c < 256; c += G) {
                const int bh = c >> 3, q = c & 7, b = bh >> 3, h = bh & 7;
#ifndef A2MASK
#define A2MASK 7
#endif
                if (A2MASK & 1) { const int qb = q; const att::Blk k{(const bf16*)(ws + WS_MQ) + ((size_t)bh * SEQ + qb * 256) * 192, (const bf16*)(ws + WS_MK) + (size_t)bh * SEQ * 192, (const bf16*)(ws + WS_MV) + (size_t)bh * SEQ * 128,
                      (bf16*)(ws + WS_Y) + ((size_t)b * SEQ + qb * 256) * 1024 + h * 128, qb * 256, 1024, nullptr, nullptr};
                  att::attn_block<0>(k, SEQ, (char*)lds_raw, wave); }
                if (A2MASK & 2) { const int qb = 7 - q; const att::Blk k{(const bf16*)(ws + WS_FQ) + ((size_t)bh * SEQ + qb * 256) * 128, (const bf16*)(ws + WS_FK) + (size_t)bh * SEQ * 128, (const bf16*)(ws + WS_FV) + (size_t)bh * SEQ * 128,
                      (bf16*)(ws + WS_Y) + (size_t)T * 1024 + ((size_t)b * SEQ + qb * 256) * 1024 + h * 128, qb * 256, 1024, (const float*)(ws + WS_CUM) + (size_t)bh * SEQ, nullptr};
                  att::attn_block<1>(k, SEQ, (char*)lds_raw, wave); }
                if (A2MASK & 4) { const int qb = q == 7 ? 0 : q == 6 ? 1 : 7 - q; const att::Blk k{(const bf16*)(ws + WS_CHQ) + ((size_t)bh * SEQ + qb * 256) * 128, (const bf16*)(ws + WS_CHK) + (size_t)bh * SEQ * 128, (const bf16*)(ws + WS_CHV) + (size_t)bh * SEQ * 128,
                      (bf16*)(ws + WS_Y) + (size_t)2 * T * 1024 + ((size_t)b * SEQ + qb * 256) * 1024 + h * 128, qb * 256, 1024, nullptr, LIN(IRELB, l) + h * 257};
                  att::attn_block<2>(k, SEQ, (char*)lds_raw, wave); }
            }
#endif
            __syncthreads();
            SEAM(gb + 2);
        }
        if ((PH_MASK & 16) && IN(gb + 3)) REPS(4) {
            OPAQUE_PTRS();
            pg8::Gemm g{(const bf16*)(ws + WS_Y), (const bf16*)(wl + WO_BR), T, 2048, 1024, (size_t)T * 1024 * 2, (size_t)2048 * 1024 * 2}; pg8::ZOrder<3> S; S.init(T, 2048, G, bx);
            EpiBr E{(const bf16*)(ws + WS_GATES), (bf16*)(ws + WS_MERGED)};
            pg8::gemm_phase<EpiBr, pg8::ZOrder<3>, true, true>(lds, g, S, E, wave);
            SEAM(gb + 3);
        }
        if ((PH_MASK & 32) && IN(gb + 4)) REPS(5) {
            OPAQUE_PTRS();
            pg8::Gemm g{(const bf16*)(ws + WS_MERGED), (const bf16*)(wl + WO_OUT), T, 2048, 2048, 0, 0}; pg8::StaticOrder S; S.init(T, 2048, G, bx);
            EpiResid<false> E{xb, ssqx, nullptr, escr};
            pg8::gemm_phase<EpiResid<false>, pg8::StaticOrder, true, true>(lds, g, S, E, wave);
            SEAM(gb + 4);
        }
        if ((PH_MASK & 64) && IN(gb + 5)) REPS(6) {
            OPAQUE_PTRS();
            { pg8::Gemm g{xb, (const bf16*)(wl + WO_XQ), T, 512, 2048, 0, 0}; pg8::StaticOrder S; S.init(T, 512, G, bx);
              EpiHeadNorm E{ssqx, nullptr, LIN(IG_XQ, l), (bf16*)(ws + WS_XQ), nullptr, 2, SEQ, 11, escr};
              pg8::gemm_phase<EpiHeadNorm, pg8::StaticOrder, true, true>(lds, g, S, E, wave); }
            { pg8::Gemm g{(const bf16*)(ws + WS_MEMB), (const bf16*)(wl + WO_XKV), NBATCH * 256, 1024, 2048, 0, 0}; pg8::StaticOrder S; S.init(NBATCH * 256, 1024, G, (bx + G - 64) % G);
              EpiHeadNorm E{nullptr, (const float*)(ws + WS_RSTDMEM), LIN(IG_XK, l), (bf16*)(ws + WS_XK), (bf16*)(ws + WS_XV), 2, 256, 8, escr + 2048};
              pg8::gemm_phase<EpiHeadNorm, pg8::StaticOrder, true, true>(lds, g, S, E, wave); }
            SEAM(gb + 5);
        }
        if ((PH_MASK & 128) && IN(gb + 6)) REPS(7) {
            OPAQUE_PTRS();
#if ATTN_SIMPLE
            for (int it = bx; it < NBATCH * 4 * 32; it += G) {
                const int b = it / (4 * 32), h = (it / 32) % 4, qt = it % 32;
                const AttnS A{(const bf16*)(ws + WS_XQ), (const bf16*)(ws + WS_XK), (const bf16*)(ws + WS_XV), (bf16*)(ws + WS_OX), 3, 128, 4, 256, 512, nullptr, nullptr};
                attn_simple_unit(A, b, h, qt, lds, tid);
            }
#else
            for (int c = vcu; c < 128; c += G) {
                const int bh = c >> 3, qb = c & 7, b = bh >> 2, h = bh & 3;
                const att::Blk k{(const bf16*)(ws + WS_XQ) + ((size_t)bh * SEQ + qb * 256) * 128, (const bf16*)(ws + WS_XK) + (size_t)bh * 256 * 128, (const bf16*)(ws + WS_XV) + (size_t)bh * 256 * 128,
                    (bf16*)(ws + WS_OX) + ((size_t)b * SEQ + qb * 256) * 512 + h * 128, qb * 256, 512, nullptr, nullptr};
                att::attn_block<3>(k, 256, (char*)lds_raw, wave);
            }
#endif
            __syncthreads();
            SEAM(gb + 6);
        }
        if ((PH_MASK & 256) && IN(gb + 7)) REPS(8) {
            OPAQUE_PTRS();
            pg8::Gemm g{(const bf16*)(ws + WS_OX), (const bf16*)(wl + WO_XO), T, 2048, 512, 0, 0}; pg8::StaticOrder S; S.init(T, 2048, G, bx);
            EpiResid<false> E{xb, ssqx, nullptr, escr};
            pg8::gemm_phase<EpiResid<false>, pg8::StaticOrder, true, true>(lds, g, S, E, wave);
            SEAM(gb + 7);
        }
        if ((PH_MASK & 512) && IN(gb + 8)) REPS(9) {
            OPAQUE_PTRS();
            pg8::Gemm g{xb, (const bf16*)(wl + WO_1), T, FF, 2048, 0, 0}; pg8::StaticOrder S; S.init(T, FF, G, bx);
            EpiMlp1 E{ssqx, (bf16*)(ws + WS_H)};
            pg8::gemm_phase<EpiMlp1, pg8::StaticOrder, true, true>(lds, g, S, E, wave);
            SEAM(gb + 8);
        }
        if ((PH_MASK & 1024) && IN(gb + 9)) REPS(10) {
            OPAQUE_PTRS();
            pg8::Gemm g{(const bf16*)(ws + WS_H), (const bf16*)(wl + WO_2), T, 2048, FF, 0, 0}; pg8::StaticOrder S; S.init(T, 2048, G, bx);
            if (l + 1 < NL) { EpiResid<false> E{xb, ssqx, nullptr, escr}; pg8::gemm_phase<EpiResid<false>, pg8::StaticOrder, true, true>(lds, g, S, E, wave); }
            else { EpiResid<true> E{xb, ssqx, args.out, escr}; pg8::gemm_phase<EpiResid<true>, pg8::StaticOrder, true, true>(lds, g, S, E, wave); }
            SEAM(gb + 9);
        }
    }
#undef IN
#undef SEAM
}

extern "C" void kernel_launch(void* const* d_in, const int* in_sizes, int n_in, void* d_out, int out_size, void* d_ws, size_t ws_size, hipStream_t stream) {
    static int grid = 0;
    if (grid == 0) {
        if (n_in != N_IN || in_sizes[0] != T * DM || out_size != T * DM || ws_size < WS_END) { fprintf(stderr, "kernel_launch: unexpected shapes (n_in %d, in0 %d, out %d, ws %zu < %zu)\n", n_in, n_in > 0 ? in_sizes[0] : -1, out_size, ws_size, (size_t)WS_END); grid = -1; return; }
        int dev = 0, cus = 0, per_cu = 0;
        if (hipGetDevice(&dev) != hipSuccess || hipDeviceGetAttribute(&cus, hipDeviceAttributeMultiprocessorCount, dev) != hipSuccess) { grid = -1; return; }
        if (hipFuncSetAttribute((const void*)fwd_kernel, hipFuncAttributeMaxDynamicSharedMemorySize, LDS_BYTES) != hipSuccess) { fprintf(stderr, "kernel_launch: hipFuncSetAttribute failed\n"); grid = -1; return; }
        if (hipOccupancyMaxActiveBlocksPerMultiprocessor(&per_cu, (const void*)fwd_kernel, NWAVES * 64, LDS_BYTES) != hipSuccess || per_cu < 1) fprintf(stderr, "kernel_launch: occupancy query reports %d\n", per_cu);
        (void)hipGetLastError();
        grid = cus;
    }
    if (grid < 0) return;
    if (hipMemsetAsync((char*)d_ws + WS_CTL, 0, CTL_ZERO_BYTES, stream) != hipSuccess) return;
    Args a{};
    for (int i = 0; i < N_IN; ++i) a.in[i] = (const float*)d_in[i];
    a.out = (float*)d_out; a.ws = (unsigned char*)d_ws;
#if MK_PER_PHASE
    for (int g = 0; g < NPHASE; ++g) { a.g_lo = g; a.g_hi = g + 1; hipLaunchKernelGGL(fwd_kernel, dim3(grid), dim3(NWAVES * 64), LDS_BYTES, stream, a); }
#else
    a.g_lo = 0; a.g_hi = NPHASE;
    hipLaunchKernelGGL(fwd_kernel, dim3(grid), dim3(NWAVES * 64), LDS_BYTES, stream, a);
#endif
    const hipError_t le = hipPeekAtLastError();
    if (le != hipSuccess) fprintf(stderr, "kernel_launch: launch failed: %s\n", hipGetErrorName(le));
}
```
